# Optimizing an MI355X kernel written in HIP

```python
import jax, jax.numpy as jnp
from jax import lax
import numpy as np

D_MODEL = 1024
BATCH = 4
SEQ = 4096
DEPTH = 4

N_HEADS_MLA = 8
QK_NOPE = 64
QK_ROPE = 32
V_HEAD = 64
Q_RANK = 384
KV_RANK = 256
ROPE_THETA = 10000.0
Q_BLOCK = 128
MLA_WIDTH = N_HEADS_MLA * V_HEAD
POOL_WINDOWS = (2, 4, 8, 16)
POOL_GROUPS = 4
POOL_GROUP = 128
POOL_WIDTH = POOL_GROUPS * POOL_GROUP
POOL_OUT_GROUP = D_MODEL // POOL_GROUPS
CONV_HEADS = 8
CONV_HEAD_DIM = 64
CONV_WIDTH = CONV_HEADS * CONV_HEAD_DIM
CONV_K = 3
N_BRANCH = 3
N_EXPERTS = 16
EXPERT_FF = 1024
EC_FACTOR = 2
EPS = 1e-6

IN_SPLITS = (Q_RANK, KV_RANK, QK_ROPE, POOL_WIDTH, CONV_WIDTH, CONV_WIDTH, CONV_WIDTH, N_BRANCH * D_MODEL)
IN_COLS = sum(IN_SPLITS)
IN_OFFSETS = tuple(int(v) for v in np.cumsum(IN_SPLITS)[:-1])

kernel_name = "hybrid_mla_pool_conv_ec_moe_encoder"


def rmsnorm(x, g):
    xf = x.astype(jnp.float32)
    y = xf * lax.rsqrt(jnp.mean(xf * xf, axis=-1, keepdims=True) + EPS)
    return (y * g.astype(jnp.float32)).astype(x.dtype)


def rope_tables(positions, dim):
    freqs = ROPE_THETA ** (-jnp.arange(0, dim, 2, dtype=jnp.float32) / dim)
    ang = positions.astype(jnp.float32)[..., None] * freqs
    return jnp.cos(ang), jnp.sin(ang)


def apply_rope(x, cos, sin):
    half = x.shape[-1] // 2
    xf = x.astype(jnp.float32)
    x1, x2 = xf[..., :half], xf[..., half:]
    return jnp.concatenate([x1 * cos - x2 * sin, x1 * sin + x2 * cos], axis=-1).astype(x.dtype)


def mla_branch(cq, ckv, kr, cos, sin, q_norm_g, w_uq, kv_norm_g, w_ukv, w_oa):
    B, S, _ = cq.shape
    H, DQK = N_HEADS_MLA, QK_NOPE + QK_ROPE
    q = (rmsnorm(cq, q_norm_g) @ w_uq).reshape(B, S, H, DQK)
    q_rope = apply_rope(q[..., QK_NOPE:], cos[:, :, None], sin[:, :, None])
    kv = (rmsnorm(ckv, kv_norm_g) @ w_ukv).reshape(B, S, H, QK_NOPE + V_HEAD)
    k_nope, v = kv[..., :QK_NOPE], kv[..., QK_NOPE:]
    k_rope = apply_rope(kr, cos, sin)
    q = jnp.concatenate([q[..., :QK_NOPE], q_rope], axis=-1) * (DQK ** -0.5)
    k = jnp.concatenate([k_nope, jnp.broadcast_to(k_rope[:, :, None], (B, S, H, QK_ROPE))], axis=-1)
    nb = S // Q_BLOCK
    qb = q.reshape(B, nb, Q_BLOCK, H, DQK).transpose(1, 0, 2, 3, 4)

    def attend(q_blk):
        s = jnp.einsum('bqhd,bkhd->bhqk', q_blk, k).astype(jnp.float32)
        p = jax.nn.softmax(s, axis=-1).astype(v.dtype)
        return jnp.einsum('bhqk,bkhd->bqhd', p, v)

    o = lax.map(attend, qb)
    o = o.transpose(1, 0, 2, 3, 4).reshape(B, S, MLA_WIDTH)
    return o @ w_oa


def pool_branch(u, w_pool, pool_scale):
    B, S, _ = u.shape
    ug = u.reshape(B, S, POOL_GROUPS, POOL_GROUP).astype(jnp.float32)
    cs = jnp.concatenate([jnp.zeros((B, 1, POOL_GROUPS, POOL_GROUP), jnp.float32),
                          jnp.cumsum(ug, axis=1)], axis=1)
    t = jnp.arange(S)
    outs = []
    for gi, w in enumerate(POOL_WINDOWS):
        lo = jnp.clip(t - w // 2, 0, S - 1)
        hi = jnp.clip(t + w // 2 - 1, 0, S - 1)
        cnt = (hi - lo + 1).astype(jnp.float32)[:, None]
        csg = cs[:, :, gi]
        mean = (csg[:, hi + 1] - csg[:, lo]) / cnt
        outs.append(mean - ug[:, :, gi])
    mixed = jnp.stack(outs, axis=2).astype(u.dtype)
    y = jnp.einsum('bsgc,gcd->bsgd', mixed, w_pool).reshape(B, S, D_MODEL)
    return y * pool_scale


def conv_branch(xin, b_gate, c_gate, conv_w, w_oc):
    S = xin.shape[1]
    z = c_gate * xin
    pad = CONV_K // 2
    zp = jnp.pad(z, ((0, 0), (pad, pad), (0, 0)))
    y = sum(conv_w[k] * zp[:, k:k + S] for k in range(CONV_K))
    return (b_gate * y) @ w_oc


def ec_moe(h, w_router, w_gate, w_up, w_down):
    B, S, D = h.shape
    cap = EC_FACTOR * S // N_EXPERTS
    logits = jnp.einsum('bsd,de->bse', h, w_router).astype(jnp.float32)
    aff = jax.nn.softmax(logits, axis=-1)
    top_val, top_idx = lax.top_k(aff.transpose(0, 2, 1), cap)
    xg = jax.vmap(lambda hb, ib: hb[ib])(h, top_idx)
    g = jnp.einsum('becd,edf->becf', xg, w_gate)
    u = jnp.einsum('becd,edf->becf', xg, w_up)
    y = jnp.einsum('becf,efd->becd', jax.nn.silu(g) * u, w_down) * top_val[..., None].astype(h.dtype)
    return jax.vmap(lambda yb, ib: jnp.zeros((S, D), yb.dtype).at[ib.reshape(-1)].add(yb.reshape(-1, D)))(y, top_idx)


def setup_inputs(seed: int = 0) -> dict:
    key = jax.random.key(seed)
    ks = jax.random.split(key, 24)
    f32 = jnp.float32
    D, L = D_MODEL, DEPTH

    def nrm(k, shape, scale):
        return jax.random.normal(k, shape, f32) * scale

    steps = jax.random.randint(ks[2], (BATCH, SEQ), 1, 3)
    positions = (jnp.cumsum(steps, axis=1) - steps[:, :1]).astype(jnp.int32)
    return {
        "x": nrm(ks[0], (BATCH, SEQ, D), 1.0),
        "c": nrm(ks[1], (BATCH, D), 1.0),
        "positions": positions,
        "w_mod": nrm(ks[3], (L, D, 6 * D), 0.5 * D ** -0.5),
        "b_mod": nrm(ks[4], (L, 6 * D), 0.01),
        "norm1_g": 1.0 + nrm(ks[5], (L, D), 0.05),
        "w_in": nrm(ks[6], (L, D, IN_COLS), D ** -0.5),
        "b_gate": nrm(ks[7], (L, N_BRANCH * D), 0.01),
        "q_norm_g": 1.0 + nrm(ks[8], (L, Q_RANK), 0.05),
        "w_uq": nrm(ks[9], (L, Q_RANK, N_HEADS_MLA * (QK_NOPE + QK_ROPE)), Q_RANK ** -0.5),
        "kv_norm_g": 1.0 + nrm(ks[10], (L, KV_RANK), 0.05),
        "w_ukv": nrm(ks[11], (L, KV_RANK, N_HEADS_MLA * (QK_NOPE + V_HEAD)), KV_RANK ** -0.5),
        "w_oa": nrm(ks[12], (L, MLA_WIDTH, D), MLA_WIDTH ** -0.5),
        "w_pool": nrm(ks[13], (L, POOL_GROUPS, POOL_GROUP, POOL_OUT_GROUP), POOL_GROUP ** -0.5),
        "pool_scale": 1.0 + nrm(ks[14], (L, D), 0.05),
        "conv_w": nrm(ks[15], (L, CONV_K, CONV_WIDTH), CONV_K ** -0.5),
        "w_oc": nrm(ks[16], (L, CONV_WIDTH, D), CONV_WIDTH ** -0.5),
        "w_out": nrm(ks[17], (L, D, D), D ** -0.5),
        "norm2_g": 1.0 + nrm(ks[18], (L, D), 0.05),
        "w_router": nrm(ks[19], (L, D, N_EXPERTS), D ** -0.5),
        "w_gate": nrm(ks[20], (L, N_EXPERTS, D, EXPERT_FF), D ** -0.5),
        "w_up": nrm(ks[21], (L, N_EXPERTS, D, EXPERT_FF), D ** -0.5),
        "w_down": nrm(ks[22], (L, N_EXPERTS, EXPERT_FF, D), EXPERT_FF ** -0.5),
        "final_g": 1.0 + nrm(ks[23], (D,), 0.05),
    }


def reference(x, c, positions, w_mod, b_mod, norm1_g, w_in, b_gate, q_norm_g, w_uq, kv_norm_g, w_ukv, w_oa,
              w_pool, pool_scale, conv_w, w_oc, w_out, norm2_g, w_router, w_gate, w_up, w_down, final_g):
    B, S, D = x.shape
    cos, sin = rope_tables(positions, QK_ROPE)
    c_act = jax.nn.silu(c)
    for l in range(DEPTH):
        mod = (c_act @ w_mod[l] + b_mod[l])[:, None, :]
        sh1, sc1, g1, sh2, sc2, g2 = jnp.split(mod, 6, axis=-1)
        h = rmsnorm(x, norm1_g[l]) * (1.0 + sc1) + sh1
        proj = h @ w_in[l]
        cq, ckv, kr, pu, cx, cb, cc, gl = jnp.split(proj, IN_OFFSETS, axis=-1)
        ya = mla_branch(cq, ckv, kr, cos, sin, q_norm_g[l], w_uq[l], kv_norm_g[l], w_ukv[l], w_oa[l])
        yb = pool_branch(pu, w_pool[l], pool_scale[l])
        yc = conv_branch(cx, cb, cc, conv_w[l], w_oc[l])
        gates = jax.nn.sigmoid((gl + b_gate[l]).astype(jnp.float32)).astype(x.dtype).reshape(B, S, N_BRANCH, D)
        merged = gates[:, :, 0] * ya + gates[:, :, 1] * yb + gates[:, :, 2] * yc
        x = x + g1 * (merged @ w_out[l])
        h2 = rmsnorm(x, norm2_g[l]) * (1.0 + sc2) + sh2
        x = x + g2 * ec_moe(h2, w_router[l], w_gate[l], w_up[l], w_down[l])
    return rmsnorm(x, final_g)
```

```cpp
#include <hip/hip_runtime.h>
#include <cstdio>
#include <cstdint>
#ifndef MK_PER_PHASE
#define MK_PER_PHASE 0
#endif
#ifndef NAIVE_GEMM_MASK
#define NAIVE_GEMM_MASK 0
#endif
#ifndef NAIVE_ATTN
#define NAIVE_ATTN 0
#endif
#ifndef ATTN_V2
#define ATTN_V2 0
#endif
#ifndef MERGE_FUSED
#define MERGE_FUSED 1
#endif
#ifndef ATTN_KBATCH
#define ATTN_KBATCH 0
#endif
#ifndef GATHER_FUSED
#define GATHER_FUSED 1
#endif
#ifndef ATTN_FASTPATH
#define ATTN_FASTPATH 1
#endif
#ifndef KMAX_ATOMICS
#define KMAX_ATOMICS 1
#endif
#ifndef ATTN_ONEBAR
#define ATTN_ONEBAR 1
#endif
#ifndef ATTN_ISTEP
#define ATTN_ISTEP 1
#endif
#ifndef ATTN_PRIO
#define ATTN_PRIO 0
#endif
#ifndef XB_WORK_UNTIL_LOCAL
#define XB_WORK_UNTIL_LOCAL 1
#endif

namespace pg8 {
#define PG8_LAS __attribute__((address_space(3)))
typedef unsigned short bf16_t;
typedef short bf16x8 __attribute__((ext_vector_type(8)));
typedef float f32x4 __attribute__((ext_vector_type(4)));
typedef unsigned u32x4 __attribute__((ext_vector_type(4)));
constexpr int BM = 256, BK = 64, HALF = 128, HTB = HALF * BK * 2  , STAGE_BYTES = 8 * HTB, NXCD = 8, WGM = 8;

__host__ __device__ __forceinline__ int lds_byte(int r, int c) { const int st = (r >> 4) * 2 + (c >> 5), rr = r & 15, cc = c & 31, ob = rr * 64 + cc * 2; return st * 1024 + (ob ^ (((ob >> 9) & 1) << 5)); }
__host__ __device__ __forceinline__ void stage_rc(int b, int& R, int& C) { const int st = b / 1024, sb = b % 1024, swz = sb ^ (((sb >> 9) & 1) << 5); R = (st >> 1) * 16 + swz / 64; C = (st & 1) * 32 + (swz % 64) / 2; }
__host__ __device__ __forceinline__ int perm32(int rho) { const int n = rho >> 4, i = rho & 15; return 8 * (i >> 2) + 4 * n + (i & 3); }

struct Unit { int pm, pn; };
struct Gemm { const bf16_t* A; const bf16_t* Bt; int M, N, K; };

struct StaticOrder {
    int nM, nN, nwg, G, c;
    __host__ __device__ void init(int M, int N, int G_, int c_) { nM = M / BM; nN = N / BM; nwg = nM * nN; G = G_; c = c_; }
    __host__ __device__ bool next(int i, Unit& u) const {
        const long L = (long)i * G + c; if (L >= nwg) return false;
        int wgid = (int)L; { const int q = nwg / NXCD, r = nwg % NXCD, xcd = wgid % NXCD, off = wgid / NXCD; wgid = (xcd < r ? xcd * (q + 1) : r * (q + 1) + (xcd - r) * q) + off; }
        const int nig = WGM * nN, gid = wgid / nig, fm = gid * WGM, gsz = (nM - fm) < WGM ? (nM - fm) : WGM;
        u.pm = fm + ((wgid % nig) % gsz); u.pn = (wgid % nig) / gsz; return true;
    }
    __device__ __forceinline__ void a_ready(const Unit&) const {}
    __device__ __forceinline__ void done(const Unit&) const {}
};

__device__ __forceinline__ unsigned cvt_pk_bf16(float lo, float hi) { unsigned r; asm volatile("v_cvt_pk_bf16_f32 %0, %1, %2" : "=v"(r) : "v"(lo), "v"(hi)); return r; }
#ifndef PG8_KREP
#define PG8_KREP 1
#endif
template <class Epi, class Sched, bool ALIGN_EPI = false, bool SP2 = false>
__device__ __forceinline__ void gemm_phase(PG8_LAS unsigned char* lds, const Gemm g, const Sched& S, const Epi& E) {
    int tid_ = threadIdx.x; asm volatile("" : "+v"(tid_));
    const int tid = tid_, wid = __builtin_amdgcn_readfirstlane(tid >> 6), lane = tid & 63, wr = wid >> 2, wc = wid & 3, fr = lane & 15, fq = lane >> 4;
    int K_ = g.K; asm volatile("" : "+s"(K_)); const int K = K_, nt = K / BK;
    unsigned voffA[2], voffB[2];
#pragma unroll
    for (int i = 0; i < 2; ++i) { int R, C; stage_rc(tid * 16 + i * 8192, R, C); const int Rb = Epi::PERM ? ((R & ~31) + perm32(R & 31)) : R;
        voffA[i] = (unsigned)(R * K + C) * 2u; voffB[i] = (unsigned)(Rb * K + C) * 2u; }
    const size_t kstep = (size_t)(BK * 2);
    const size_t hstep = (size_t)HALF * K * 2;
    const size_t tstep = 2 * hstep;
    const unsigned ldsw = (unsigned)wid * 1024u;
    const int aoff = lds_byte(wr * 64 + fr, fq * 8), boff = lds_byte(wc * 32 + fr, fq * 8);
#define PG8_SA(b, h) (((b) * 2 + (h)) * HTB)
#define PG8_SB(b, h) ((4 + (b) * 2 + (h)) * HTB)
#define PG8_STAGE(bufoff, gbase, voff) do { _Pragma("unroll") for (int _i = 0; _i < 2; ++_i) \
        __builtin_amdgcn_global_load_lds((const unsigned*)((const char*)(gbase) + (voff)[_i]), (PG8_LAS unsigned*)(lds + (bufoff) + ldsw + _i * 8192), 16, 0, 0); } while (0)
#define PG8_LDA(dst, b, h) do { _Pragma("unroll") for (int m = 0; m < 4; ++m) _Pragma("unroll") for (int k = 0; k < 2; ++k) dst[m][k] = *(const PG8_LAS bf16x8*)(lds + PG8_SA(b, h) + aoff + m * 2048 + k * 1024); } while (0)
#define PG8_LDB(dst, b, h) do { _Pragma("unroll") for (int n = 0; n < 2; ++n) _Pragma("unroll") for (int k = 0; k < 2; ++k) dst[n][k] = *(const PG8_LAS bf16x8*)(lds + PG8_SB(b, h) + boff + n * 2048 + k * 1024); } while (0)
#define PG8_MMA(ai, bj, At, Bt) do { __builtin_amdgcn_s_setprio(1); _Pragma("unroll") for (int m = 0; m < 4; ++m) _Pragma("unroll") for (int n = 0; n < 2; ++n) _Pragma("unroll") for (int k = 0; k < 2; ++k) \
        acc[ai][bj][m][n] = __builtin_amdgcn_mfma_f32_16x16x32_bf16(Bt[n][k], At[m][k], acc[ai][bj][m][n], 0, 0, 0); __builtin_amdgcn_s_setprio(0); } while (0)
#define PG8_WAIT_V(n) asm volatile("s_waitcnt vmcnt(" #n ")" ::: "memory")
#define PG8_WAIT_L(n) asm volatile("s_waitcnt lgkmcnt(" #n ")" ::: "memory")
#define PG8_BAR __builtin_amdgcn_s_barrier()
#define PG8_SCHED __builtin_amdgcn_sched_barrier(0)
    Unit cur, nxt; int ui = 0;
    if (!S.next(0, cur)) return;
    f32x4 acc[2][2][4][2];
#pragma unroll
    for (int a = 0; a < 2; ++a)
#pragma unroll
        for (int b = 0; b < 2; ++b)
#pragma unroll
            for (int m = 0; m < 4; ++m)
#pragma unroll
                for (int n = 0; n < 2; ++n) acc[a][b][m][n] = (f32x4){0.f, 0.f, 0.f, 0.f};
    bf16x8 At[4][2], B0[2][2], B1[2][2];
    const char* cA = (const char*)g.A + (size_t)cur.pm * tstep; const char* cB = (const char*)g.Bt + (size_t)cur.pn * tstep;
    S.a_ready(cur);
    if constexpr (SP2) {
        PG8_STAGE(PG8_SB(0, 0), cB, voffB); PG8_STAGE(PG8_SB(0, 1), cB + hstep, voffB); PG8_STAGE(PG8_SA(0, 0), cA, voffA); PG8_STAGE(PG8_SA(0, 1), cA + hstep, voffA);
        if (wr == 1) PG8_BAR;
        PG8_WAIT_V(2); PG8_BAR;
        PG8_STAGE(PG8_SB(1, 0), cB + kstep, voffB); PG8_STAGE(PG8_SA(1, 0), cA + kstep, voffA); PG8_STAGE(PG8_SB(1, 1), cB + hstep + kstep, voffB);
        PG8_WAIT_V(6); PG8_BAR;
    } else {
        PG8_STAGE(PG8_SB(0, 0), cB, voffB); PG8_STAGE(PG8_SA(0, 0), cA, voffA); PG8_STAGE(PG8_SB(0, 1), cB + hstep, voffB); PG8_STAGE(PG8_SA(0, 1), cA + hstep, voffA);
        if (wr == 1) PG8_BAR;
        PG8_WAIT_V(4); PG8_BAR;
        PG8_STAGE(PG8_SB(1, 0), cB + kstep, voffB); PG8_STAGE(PG8_SA(1, 0), cA + kstep, voffA); PG8_STAGE(PG8_SB(1, 1), cB + hstep + kstep, voffB);
        PG8_WAIT_V(6); PG8_BAR;
    }
    for (;;) {
        const bool has_next = S.next(ui + 1, nxt);
        const char* nA = has_next ? (const char*)g.A + (size_t)nxt.pm * tstep : cA; const char* nB = has_next ? (const char*)g.Bt + (size_t)nxt.pn * tstep : cB;
#pragma unroll 1
        for (int tt_ = 0; tt_ < PG8_KREP * nt; tt_ += 2) {
            const bool last = (tt_ == PG8_KREP * nt - 2); const int t = tt_ % nt; const int t2_ = (tt_ + 2) % nt;
            const char* a1 = cA + (size_t)(t + 1) * kstep;
            const char* a2 = last ? nA : cA + (size_t)t2_ * kstep; const char* b2 = last ? nB : cB + (size_t)t2_ * kstep;
            const char* a3 = a2 + kstep; const char* b3 = b2 + kstep;
            if (last && has_next) S.a_ready(nxt);
            if constexpr (SP2) {
            PG8_LDB(B0, 0, 0); PG8_LDB(B1, 0, 1); PG8_SCHED; PG8_LDA(At, 0, 0); PG8_STAGE(PG8_SA(1, 1), a1 + hstep, voffA);
            PG8_WAIT_V(8); PG8_WAIT_L(0); PG8_BAR; PG8_MMA(0, 0, At, B0); PG8_MMA(0, 1, At, B1); PG8_BAR; PG8_SCHED;
            PG8_LDA(At, 0, 1); PG8_STAGE(PG8_SB(0, 0), b2, voffB); PG8_STAGE(PG8_SB(0, 1), b2 + hstep, voffB); PG8_STAGE(PG8_SA(0, 0), a2, voffA);
            PG8_WAIT_V(8); PG8_WAIT_L(0); PG8_BAR; PG8_MMA(1, 0, At, B0); PG8_MMA(1, 1, At, B1); PG8_BAR; PG8_SCHED;
            PG8_LDB(B0, 1, 0); PG8_LDB(B1, 1, 1); PG8_SCHED; PG8_LDA(At, 1, 0); PG8_STAGE(PG8_SA(0, 1), a2 + hstep, voffA);
            PG8_WAIT_V(8); PG8_WAIT_L(0); PG8_BAR; PG8_MMA(0, 0, At, B0); PG8_MMA(0, 1, At, B1); PG8_BAR; PG8_SCHED;
            PG8_LDA(At, 1, 1); PG8_STAGE(PG8_SB(1, 0), b3, voffB); PG8_STAGE(PG8_SB(1, 1), b3 + hstep, voffB); PG8_STAGE(PG8_SA(1, 0), a3, voffA);
            PG8_WAIT_V(8); PG8_WAIT_L(0); PG8_BAR; PG8_MMA(1, 0, At, B0); PG8_MMA(1, 1, At, B1); PG8_BAR; PG8_SCHED;
            } else {
            PG8_LDB(B0, 0, 0); PG8_SCHED; PG8_LDA(At, 0, 0); PG8_STAGE(PG8_SA(1, 1), a1 + hstep, voffA);
            PG8_WAIT_L(8); PG8_BAR; PG8_WAIT_L(0); PG8_MMA(0, 0, At, B0); PG8_BAR; PG8_SCHED;
            PG8_LDB(B1, 0, 1); PG8_STAGE(PG8_SB(0, 0), b2, voffB);
            PG8_BAR; PG8_WAIT_L(0); PG8_MMA(0, 1, At, B1); PG8_BAR;
            PG8_LDA(At, 0, 1); PG8_STAGE(PG8_SA(0, 0), a2, voffA);
            PG8_BAR; PG8_WAIT_L(0); PG8_MMA(1, 0, At, B0); PG8_BAR; PG8_SCHED;
            PG8_STAGE(PG8_SB(0, 1), b2 + hstep, voffB);
            PG8_WAIT_V(6); PG8_BAR; PG8_MMA(1, 1, At, B1); PG8_BAR;
            PG8_LDB(B0, 1, 0); PG8_SCHED; PG8_LDA(At, 1, 0); PG8_STAGE(PG8_SA(0, 1), a2 + hstep, voffA);
            PG8_WAIT_L(8); PG8_BAR; PG8_WAIT_L(0); PG8_MMA(0, 0, At, B0); PG8_BAR; PG8_SCHED;
            PG8_LDB(B1, 1, 1); PG8_STAGE(PG8_SB(1, 0), b3, voffB);
            PG8_BAR; PG8_WAIT_L(0); PG8_MMA(0, 1, At, B1); PG8_BAR;
            PG8_LDA(At, 1, 1); PG8_STAGE(PG8_SA(1, 0), a3, voffA);
            PG8_BAR; PG8_WAIT_L(0); PG8_MMA(1, 0, At, B0); PG8_BAR; PG8_SCHED;
            PG8_STAGE(PG8_SB(1, 1), b3 + hstep, voffB);
            PG8_WAIT_V(6); PG8_BAR; PG8_MMA(1, 1, At, B1); PG8_BAR;
            }
        }
        if constexpr (ALIGN_EPI) { if (wr == 0) PG8_BAR; }
        if constexpr (!Epi::AFTER_DRAIN) { E(acc, cur, wr, wc, fr, fq); S.done(cur); }
        if (!has_next) break;
#pragma unroll
        for (int a = 0; a < 2; ++a)
#pragma unroll
            for (int b = 0; b < 2; ++b)
#pragma unroll
                for (int m = 0; m < 4; ++m)
#pragma unroll
                    for (int n = 0; n < 2; ++n) acc[a][b][m][n] = (f32x4){0.f, 0.f, 0.f, 0.f};
        cur = nxt; cA = nA; cB = nB; ++ui;
        if constexpr (ALIGN_EPI) { if (wr == 1) PG8_BAR; }
    }
    PG8_WAIT_V(0);
    if constexpr (!ALIGN_EPI) { if (wr == 0) PG8_BAR; }
    PG8_BAR;
    if constexpr (Epi::AFTER_DRAIN) { E.fused(acc, cur, wr, wc, fr, fq, lds, wid, lane); S.done(cur); }
#undef PG8_SA
#undef PG8_SB
#undef PG8_STAGE
#undef PG8_LDA
#undef PG8_LDB
#undef PG8_MMA
#undef PG8_WAIT_V
#undef PG8_WAIT_L
#undef PG8_BAR
#undef PG8_SCHED
}
template <class Epi, class Sched, bool ALIGN_EPI = false, bool SP2 = false>
__device__ __forceinline__ void gemm_phase_gather(PG8_LAS unsigned char* lds, const Gemm g, const Sched& S, const Epi& E, const int* __restrict__ rowidx) {
    int tid_ = threadIdx.x; asm volatile("" : "+v"(tid_));
    const int tid = tid_, wid = __builtin_amdgcn_readfirstlane(tid >> 6), lane = tid & 63, wr = wid >> 2, wc = wid & 3, fr = lane & 15, fq = lane >> 4;
    int K_ = g.K; asm volatile("" : "+s"(K_)); const int K = K_, nt = K / BK;
    static_assert(SP2, "gemm_phase_gather: SP2 loop only");
    unsigned voffA[2], voffB[2]; int rA[2]; unsigned cv0[2], cv1[2], nv0[2], nv1[2];
#pragma unroll
    for (int i = 0; i < 2; ++i) { int R, C; stage_rc(tid * 16 + i * 8192, R, C); const int Rb = Epi::PERM ? ((R & ~31) + perm32(R & 31)) : R;
        voffA[i] = (unsigned)C * 2u; rA[i] = R; voffB[i] = (unsigned)(Rb * K + C) * 2u; }
#define PG8_ROWOFF(dst0, dst1, u) do { _Pragma("unroll") for (int _i = 0; _i < 2; ++_i) { dst0[_i] = (unsigned)rowidx[(u).pm * 256 + rA[_i]] * (unsigned)(K * 2) + voffA[_i]; dst1[_i] = (unsigned)rowidx[(u).pm * 256 + 128 + rA[_i]] * (unsigned)(K * 2) + voffA[_i]; } } while (0)
    const size_t kstep = (size_t)(BK * 2);
    const size_t hstep = (size_t)HALF * K * 2;
    const size_t tstep = 2 * hstep;
    const unsigned ldsw = (unsigned)wid * 1024u;
    const int aoff = lds_byte(wr * 64 + fr, fq * 8), boff = lds_byte(wc * 32 + fr, fq * 8);
#define PG8_SA(b, h) (((b) * 2 + (h)) * HTB)
#define PG8_SB(b, h) ((4 + (b) * 2 + (h)) * HTB)
#define PG8_STAGE(bufoff, gbase, voff) do { _Pragma("unroll") for (int _i = 0; _i < 2; ++_i) \
        __builtin_amdgcn_global_load_lds((const unsigned*)((const char*)(gbase) + (voff)[_i]), (PG8_LAS unsigned*)(lds + (bufoff) + ldsw + _i * 8192), 16, 0, 0); } while (0)
#define PG8_LDA(dst, b, h) do { _Pragma("unroll") for (int m = 0; m < 4; ++m) _Pragma("unroll") for (int k = 0; k < 2; ++k) dst[m][k] = *(const PG8_LAS bf16x8*)(lds + PG8_SA(b, h) + aoff + m * 2048 + k * 1024); } while (0)
#define PG8_LDB(dst, b, h) do { _Pragma("unroll") for (int n = 0; n < 2; ++n) _Pragma("unroll") for (int k = 0; k < 2; ++k) dst[n][k] = *(const PG8_LAS bf16x8*)(lds + PG8_SB(b, h) + boff + n * 2048 + k * 1024); } while (0)
#define PG8_MMA(ai, bj, At, Bt) do { __builtin_amdgcn_s_setprio(1); _Pragma("unroll") for (int m = 0; m < 4; ++m) _Pragma("unroll") for (int n = 0; n < 2; ++n) _Pragma("unroll") for (int k = 0; k < 2; ++k) \
        acc[ai][bj][m][n] = __builtin_amdgcn_mfma_f32_16x16x32_bf16(Bt[n][k], At[m][k], acc[ai][bj][m][n], 0, 0, 0); __builtin_amdgcn_s_setprio(0); } while (0)
#define PG8_WAIT_V(n) asm volatile("s_waitcnt vmcnt(" #n ")" ::: "memory")
#define PG8_WAIT_L(n) asm volatile("s_waitcnt lgkmcnt(" #n ")" ::: "memory")
#define PG8_BAR __builtin_amdgcn_s_barrier()
#define PG8_SCHED __builtin_amdgcn_sched_barrier(0)
    Unit cur, nxt; int ui = 0;
    if (!S.next(0, cur)) return;
    f32x4 acc[2][2][4][2];
#pragma unroll
    for (int a = 0; a < 2; ++a)
#pragma unroll
        for (int b = 0; b < 2; ++b)
#pragma unroll
            for (int m = 0; m < 4; ++m)
#pragma unroll
                for (int n = 0; n < 2; ++n) acc[a][b][m][n] = (f32x4){0.f, 0.f, 0.f, 0.f};
    bf16x8 At[4][2], B0[2][2], B1[2][2];
    const char* cA = (const char*)g.A; const char* cB = (const char*)g.Bt + (size_t)cur.pn * tstep;
    PG8_ROWOFF(cv0, cv1, cur);
    S.a_ready(cur);
    if constexpr (SP2) {
        PG8_STAGE(PG8_SB(0, 0), cB, voffB); PG8_STAGE(PG8_SB(0, 1), cB + hstep, voffB); PG8_STAGE(PG8_SA(0, 0), cA, cv0); PG8_STAGE(PG8_SA(0, 1), cA, cv1);
        if (wr == 1) PG8_BAR;
        PG8_WAIT_V(2); PG8_BAR;
        PG8_STAGE(PG8_SB(1, 0), cB + kstep, voffB); PG8_STAGE(PG8_SA(1, 0), cA + kstep, cv0); PG8_STAGE(PG8_SB(1, 1), cB + hstep + kstep, voffB);
        PG8_WAIT_V(6); PG8_BAR;
    } else {
        PG8_STAGE(PG8_SB(0, 0), cB, voffB); PG8_STAGE(PG8_SA(0, 0), cA, voffA); PG8_STAGE(PG8_SB(0, 1), cB + hstep, voffB); PG8_STAGE(PG8_SA(0, 1), cA + hstep, voffA);
        if (wr == 1) PG8_BAR;
        PG8_WAIT_V(4); PG8_BAR;
        PG8_STAGE(PG8_SB(1, 0), cB + kstep, voffB); PG8_STAGE(PG8_SA(1, 0), cA + kstep, voffA); PG8_STAGE(PG8_SB(1, 1), cB + hstep + kstep, voffB);
        PG8_WAIT_V(6); PG8_BAR;
    }
    for (;;) {
        const bool has_next = S.next(ui + 1, nxt);
        const char* nA = cA; const char* nB = has_next ? (const char*)g.Bt + (size_t)nxt.pn * tstep : cB;
        if (has_next) PG8_ROWOFF(nv0, nv1, nxt); else { _Pragma("unroll") for (int _i = 0; _i < 2; ++_i) { nv0[_i] = cv0[_i]; nv1[_i] = cv1[_i]; } }
#pragma unroll 1
        for (int t = 0; t < nt; t += 2) {
            const bool last = (t == nt - 2);
            const char* a1 = cA + (size_t)(t + 1) * kstep;
            const char* a2 = last ? nA : cA + (size_t)(t + 2) * kstep; unsigned x0[2], x1[2]; _Pragma("unroll") for (int _i = 0; _i < 2; ++_i) { x0[_i] = last ? nv0[_i] : cv0[_i]; x1[_i] = last ? nv1[_i] : cv1[_i]; } const char* b2 = last ? nB : cB + (size_t)(t + 2) * kstep;
            const char* a3 = a2 + kstep; const char* b3 = b2 + kstep;
            if (last && has_next) S.a_ready(nxt);
            if constexpr (SP2) {
            PG8_LDB(B0, 0, 0); PG8_LDB(B1, 0, 1); PG8_SCHED; PG8_LDA(At, 0, 0); PG8_STAGE(PG8_SA(1, 1), a1, cv1);
            PG8_WAIT_V(8); PG8_WAIT_L(0); PG8_BAR; PG8_MMA(0, 0, At, B0); PG8_MMA(0, 1, At, B1); PG8_BAR; PG8_SCHED;
            PG8_LDA(At, 0, 1); PG8_STAGE(PG8_SB(0, 0), b2, voffB); PG8_STAGE(PG8_SB(0, 1), b2 + hstep, voffB); PG8_STAGE(PG8_SA(0, 0), a2, x0);
            PG8_WAIT_V(8); PG8_WAIT_L(0); PG8_BAR; PG8_MMA(1, 0, At, B0); PG8_MMA(1, 1, At, B1); PG8_BAR; PG8_SCHED;
            PG8_LDB(B0, 1, 0); PG8_LDB(B1, 1, 1); PG8_SCHED; PG8_LDA(At, 1, 0); PG8_STAGE(PG8_SA(0, 1), a2, x1);
            PG8_WAIT_V(8); PG8_WAIT_L(0); PG8_BAR; PG8_MMA(0, 0, At, B0); PG8_MMA(0, 1, At, B1); PG8_BAR; PG8_SCHED;
            PG8_LDA(At, 1, 1); PG8_STAGE(PG8_SB(1, 0), b3, voffB); PG8_STAGE(PG8_SB(1, 1), b3 + hstep, voffB); PG8_STAGE(PG8_SA(1, 0), a3, x0);
            PG8_WAIT_V(8); PG8_WAIT_L(0); PG8_BAR; PG8_MMA(1, 0, At, B0); PG8_MMA(1, 1, At, B1); PG8_BAR; PG8_SCHED;
            } else {
            PG8_LDB(B0, 0, 0); PG8_SCHED; PG8_LDA(At, 0, 0); PG8_STAGE(PG8_SA(1, 1), a1 + hstep, voffA);
            PG8_WAIT_L(8); PG8_BAR; PG8_WAIT_L(0); PG8_MMA(0, 0, At, B0); PG8_BAR; PG8_SCHED;
            PG8_LDB(B1, 0, 1); PG8_STAGE(PG8_SB(0, 0), b2, voffB);
            PG8_BAR; PG8_WAIT_L(0); PG8_MMA(0, 1, At, B1); PG8_BAR;
            PG8_LDA(At, 0, 1); PG8_STAGE(PG8_SA(0, 0), a2, voffA);
            PG8_BAR; PG8_WAIT_L(0); PG8_MMA(1, 0, At, B0); PG8_BAR; PG8_SCHED;
            PG8_STAGE(PG8_SB(0, 1), b2 + hstep, voffB);
            PG8_WAIT_V(6); PG8_BAR; PG8_MMA(1, 1, At, B1); PG8_BAR;
            PG8_LDB(B0, 1, 0); PG8_SCHED; PG8_LDA(At, 1, 0); PG8_STAGE(PG8_SA(0, 1), a2 + hstep, voffA);
            PG8_WAIT_L(8); PG8_BAR; PG8_WAIT_L(0); PG8_MMA(0, 0, At, B0); PG8_BAR; PG8_SCHED;
            PG8_LDB(B1, 1, 1); PG8_STAGE(PG8_SB(1, 0), b3, voffB);
            PG8_BAR; PG8_WAIT_L(0); PG8_MMA(0, 1, At, B1); PG8_BAR;
            PG8_LDA(At, 1, 1); PG8_STAGE(PG8_SA(1, 0), a3, voffA);
            PG8_BAR; PG8_WAIT_L(0); PG8_MMA(1, 0, At, B0); PG8_BAR; PG8_SCHED;
            PG8_STAGE(PG8_SB(1, 1), b3 + hstep, voffB);
            PG8_WAIT_V(6); PG8_BAR; PG8_MMA(1, 1, At, B1); PG8_BAR;
            }
        }
        if constexpr (ALIGN_EPI) { if (wr == 0) PG8_BAR; }
        if constexpr (!Epi::AFTER_DRAIN) { E(acc, cur, wr, wc, fr, fq); S.done(cur); }
        if (!has_next) break;
#pragma unroll
        for (int a = 0; a < 2; ++a)
#pragma unroll
            for (int b = 0; b < 2; ++b)
#pragma unroll
                for (int m = 0; m < 4; ++m)
#pragma unroll
                    for (int n = 0; n < 2; ++n) acc[a][b][m][n] = (f32x4){0.f, 0.f, 0.f, 0.f};
        cur = nxt; cA = nA; cB = nB; ++ui; _Pragma("unroll") for (int _i = 0; _i < 2; ++_i) { cv0[_i] = nv0[_i]; cv1[_i] = nv1[_i]; }
        if constexpr (ALIGN_EPI) { if (wr == 1) PG8_BAR; }
    }
    PG8_WAIT_V(0);
    if constexpr (!ALIGN_EPI) { if (wr == 0) PG8_BAR; }
    PG8_BAR;
    if constexpr (Epi::AFTER_DRAIN) { E.fused(acc, cur, wr, wc, fr, fq, lds, wid, lane); S.done(cur); }
#undef PG8_SA
#undef PG8_SB
#undef PG8_STAGE
#undef PG8_LDA
#undef PG8_LDB
#undef PG8_MMA
#undef PG8_WAIT_V
#undef PG8_WAIT_L
#undef PG8_BAR
#undef PG8_SCHED
#undef PG8_ROWOFF
}
template <class Epi, class Sched, bool ALIGN_EPI = false, bool SP2 = false>
__device__ __forceinline__ void gemm_phase_seg(PG8_LAS unsigned char* lds, const Gemm g, const Sched& S, const Epi& E) {
    int tid_ = threadIdx.x; asm volatile("" : "+v"(tid_));
    const int tid = tid_, wid = __builtin_amdgcn_readfirstlane(tid >> 6), lane = tid & 63, wr = wid >> 2, wc = wid & 3, fr = lane & 15, fq = lane >> 4;
    int K_ = g.K; asm volatile("" : "+s"(K_)); const int K = K_; int nt;
    unsigned voffA[2], voffB[2];
#pragma unroll
    for (int i = 0; i < 2; ++i) { int R, C; stage_rc(tid * 16 + i * 8192, R, C); const int Rb = Epi::PERM ? ((R & ~31) + perm32(R & 31)) : R;
        voffA[i] = (unsigned)(R * K + C) * 2u; voffB[i] = (unsigned)(Rb * K + C) * 2u; }
    const size_t kstep = (size_t)(BK * 2);
    const size_t hstep = (size_t)HALF * K * 2;
    const size_t tstep = 2 * hstep;
    const unsigned ldsw = (unsigned)wid * 1024u;
    const int aoff = lds_byte(wr * 64 + fr, fq * 8), boff = lds_byte(wc * 32 + fr, fq * 8);
#define PG8_SA(b, h) (((b) * 2 + (h)) * HTB)
#define PG8_SB(b, h) ((4 + (b) * 2 + (h)) * HTB)
#define PG8_STAGE(bufoff, gbase, voff) do { _Pragma("unroll") for (int _i = 0; _i < 2; ++_i) \
        __builtin_amdgcn_global_load_lds((const unsigned*)((const char*)(gbase) + (voff)[_i]), (PG8_LAS unsigned*)(lds + (bufoff) + ldsw + _i * 8192), 16, 0, 0); } while (0)
#define PG8_LDA(dst, b, h) do { _Pragma("unroll") for (int m = 0; m < 4; ++m) _Pragma("unroll") for (int k = 0; k < 2; ++k) dst[m][k] = *(const PG8_LAS bf16x8*)(lds + PG8_SA(b, h) + aoff + m * 2048 + k * 1024); } while (0)
#define PG8_LDB(dst, b, h) do { _Pragma("unroll") for (int n = 0; n < 2; ++n) _Pragma("unroll") for (int k = 0; k < 2; ++k) dst[n][k] = *(const PG8_LAS bf16x8*)(lds + PG8_SB(b, h) + boff + n * 2048 + k * 1024); } while (0)
#define PG8_MMA(ai, bj, At, Bt) do { __builtin_amdgcn_s_setprio(1); _Pragma("unroll") for (int m = 0; m < 4; ++m) _Pragma("unroll") for (int n = 0; n < 2; ++n) _Pragma("unroll") for (int k = 0; k < 2; ++k) \
        acc[ai][bj][m][n] = __builtin_amdgcn_mfma_f32_16x16x32_bf16(Bt[n][k], At[m][k], acc[ai][bj][m][n], 0, 0, 0); __builtin_amdgcn_s_setprio(0); } while (0)
#define PG8_WAIT_V(n) asm volatile("s_waitcnt vmcnt(" #n ")" ::: "memory")
#define PG8_WAIT_L(n) asm volatile("s_waitcnt lgkmcnt(" #n ")" ::: "memory")
#define PG8_BAR __builtin_amdgcn_s_barrier()
#define PG8_SCHED __builtin_amdgcn_sched_barrier(0)
    typename Sched::U cur, nxt; int ui = 0;
    if (!S.next(0, cur)) return;
    f32x4 acc[2][2][4][2];
#pragma unroll
    for (int a = 0; a < 2; ++a)
#pragma unroll
        for (int b = 0; b < 2; ++b)
#pragma unroll
            for (int m = 0; m < 4; ++m)
#pragma unroll
                for (int n = 0; n < 2; ++n) acc[a][b][m][n] = (f32x4){0.f, 0.f, 0.f, 0.f};
    bf16x8 At[4][2], B0[2][2], B1[2][2];
    const char* cA = S.baseA(cur); const char* cB = S.baseB(cur); nt = S.nt(cur); (void)tstep;
    S.a_ready(cur);
    if constexpr (SP2) {
        PG8_STAGE(PG8_SB(0, 0), cB, voffB); PG8_STAGE(PG8_SB(0, 1), cB + hstep, voffB); PG8_STAGE(PG8_SA(0, 0), cA, voffA); PG8_STAGE(PG8_SA(0, 1), cA + hstep, voffA);
        if (wr == 1) PG8_BAR;
        PG8_WAIT_V(2); PG8_BAR;
        PG8_STAGE(PG8_SB(1, 0), cB + kstep, voffB); PG8_STAGE(PG8_SA(1, 0), cA + kstep, voffA); PG8_STAGE(PG8_SB(1, 1), cB + hstep + kstep, voffB);
        PG8_WAIT_V(6); PG8_BAR;
    } else {
        PG8_STAGE(PG8_SB(0, 0), cB, voffB); PG8_STAGE(PG8_SA(0, 0), cA, voffA); PG8_STAGE(PG8_SB(0, 1), cB + hstep, voffB); PG8_STAGE(PG8_SA(0, 1), cA + hstep, voffA);
        if (wr == 1) PG8_BAR;
        PG8_WAIT_V(4); PG8_BAR;
        PG8_STAGE(PG8_SB(1, 0), cB + kstep, voffB); PG8_STAGE(PG8_SA(1, 0), cA + kstep, voffA); PG8_STAGE(PG8_SB(1, 1), cB + hstep + kstep, voffB);
        PG8_WAIT_V(6); PG8_BAR;
    }
    for (;;) {
        const bool has_next = S.next(ui + 1, nxt);
        const char* nA = has_next ? S.baseA(nxt) : cA; const char* nB = has_next ? S.baseB(nxt) : cB;
#pragma unroll 1
        for (int t = 0; t < nt; t += 2) {
            const bool last = (t == nt - 2);
            const char* a1 = cA + (size_t)(t + 1) * kstep;
            const char* a2 = last ? nA : cA + (size_t)(t + 2) * kstep; const char* b2 = last ? nB : cB + (size_t)(t + 2) * kstep;
            const char* a3 = a2 + kstep; const char* b3 = b2 + kstep;
            if (last && has_next) S.a_ready(nxt);
            if constexpr (SP2) {
            PG8_LDB(B0, 0, 0); PG8_LDB(B1, 0, 1); PG8_SCHED; PG8_LDA(At, 0, 0); PG8_STAGE(PG8_SA(1, 1), a1 + hstep, voffA);
            PG8_WAIT_V(8); PG8_WAIT_L(0); PG8_BAR; PG8_MMA(0, 0, At, B0); PG8_MMA(0, 1, At, B1); PG8_BAR; PG8_SCHED;
            PG8_LDA(At, 0, 1); PG8_STAGE(PG8_SB(0, 0), b2, voffB); PG8_STAGE(PG8_SB(0, 1), b2 + hstep, voffB); PG8_STAGE(PG8_SA(0, 0), a2, voffA);
            PG8_WAIT_V(8); PG8_WAIT_L(0); PG8_BAR; PG8_MMA(1, 0, At, B0); PG8_MMA(1, 1, At, B1); PG8_BAR; PG8_SCHED;
            PG8_LDB(B0, 1, 0); PG8_LDB(B1, 1, 1); PG8_SCHED; PG8_LDA(At, 1, 0); PG8_STAGE(PG8_SA(0, 1), a2 + hstep, voffA);
            PG8_WAIT_V(8); PG8_WAIT_L(0); PG8_BAR; PG8_MMA(0, 0, At, B0); PG8_MMA(0, 1, At, B1); PG8_BAR; PG8_SCHED;
            PG8_LDA(At, 1, 1); PG8_STAGE(PG8_SB(1, 0), b3, voffB); PG8_STAGE(PG8_SB(1, 1), b3 + hstep, voffB); PG8_STAGE(PG8_SA(1, 0), a3, voffA);
            PG8_WAIT_V(8); PG8_WAIT_L(0); PG8_BAR; PG8_MMA(1, 0, At, B0); PG8_MMA(1, 1, At, B1); PG8_BAR; PG8_SCHED;
            } else {
            PG8_LDB(B0, 0, 0); PG8_SCHED; PG8_LDA(At, 0, 0); PG8_STAGE(PG8_SA(1, 1), a1 + hstep, voffA);
            PG8_WAIT_L(8); PG8_BAR; PG8_WAIT_L(0); PG8_MMA(0, 0, At, B0); PG8_BAR; PG8_SCHED;
            PG8_LDB(B1, 0, 1); PG8_STAGE(PG8_SB(0, 0), b2, voffB);
            PG8_BAR; PG8_WAIT_L(0); PG8_MMA(0, 1, At, B1); PG8_BAR;
            PG8_LDA(At, 0, 1); PG8_STAGE(PG8_SA(0, 0), a2, voffA);
            PG8_BAR; PG8_WAIT_L(0); PG8_MMA(1, 0, At, B0); PG8_BAR; PG8_SCHED;
            PG8_STAGE(PG8_SB(0, 1), b2 + hstep, voffB);
            PG8_WAIT_V(6); PG8_BAR; PG8_MMA(1, 1, At, B1); PG8_BAR;
            PG8_LDB(B0, 1, 0); PG8_SCHED; PG8_LDA(At, 1, 0); PG8_STAGE(PG8_SA(0, 1), a2 + hstep, voffA);
            PG8_WAIT_L(8); PG8_BAR; PG8_WAIT_L(0); PG8_MMA(0, 0, At, B0); PG8_BAR; PG8_SCHED;
            PG8_LDB(B1, 1, 1); PG8_STAGE(PG8_SB(1, 0), b3, voffB);
            PG8_BAR; PG8_WAIT_L(0); PG8_MMA(0, 1, At, B1); PG8_BAR;
            PG8_LDA(At, 1, 1); PG8_STAGE(PG8_SA(1, 0), a3, voffA);
            PG8_BAR; PG8_WAIT_L(0); PG8_MMA(1, 0, At, B0); PG8_BAR; PG8_SCHED;
            PG8_STAGE(PG8_SB(1, 1), b3 + hstep, voffB);
            PG8_WAIT_V(6); PG8_BAR; PG8_MMA(1, 1, At, B1); PG8_BAR;
            }
        }
        if constexpr (ALIGN_EPI) { if (wr == 0) PG8_BAR; }
        if constexpr (!Epi::AFTER_DRAIN) { E(acc, cur, wr, wc, fr, fq); S.done(cur); }
        if (!has_next) break;
        if (!S.keep(cur)) {
#pragma unroll
        for (int a = 0; a < 2; ++a)
#pragma unroll
            for (int b = 0; b < 2; ++b)
#pragma unroll
                for (int m = 0; m < 4; ++m)
#pragma unroll
                    for (int n = 0; n < 2; ++n) acc[a][b][m][n] = (f32x4){0.f, 0.f, 0.f, 0.f};
        }
        cur = nxt; cA = nA; cB = nB; nt = S.nt(cur); ++ui;
        if constexpr (ALIGN_EPI) { if (wr == 1) PG8_BAR; }
    }
    PG8_WAIT_V(0);
    if constexpr (!ALIGN_EPI) { if (wr == 0) PG8_BAR; }
    PG8_BAR;
    if constexpr (Epi::AFTER_DRAIN) { E.fused(acc, cur, wr, wc, fr, fq, lds, wid, lane); S.done(cur); }
#undef PG8_SA
#undef PG8_SB
#undef PG8_STAGE
#undef PG8_LDA
#undef PG8_LDB
#undef PG8_MMA
#undef PG8_WAIT_V
#undef PG8_WAIT_L
#undef PG8_BAR
#undef PG8_SCHED
}
}

constexpr int NB = 4, S = 4096, T = NB * S, D = 1024, NL = 4;
constexpr int NH = 8, DQK = 96, QR = 384, KVR = 256;
constexpr int NIN_SRC = 5792, NIN = 5888;
constexpr int NE = 16, FF = 1024, CAP = 512;
constexpr float EPS = 1e-6f;
constexpr int NWAVES = 8;

constexpr size_t MiB = 1u << 20;
constexpr size_t WS_CTL = 0, CTL_ZERO_BYTES = 64 * 1024;
constexpr size_t WS_MOD = 1 * MiB;
constexpr size_t WS_COS = 2 * MiB, WS_SIN = 3 * MiB;
constexpr size_t WS_PART = 4 * MiB;
constexpr size_t WS_AFF = 5 * MiB;
constexpr size_t WS_SLOT = 6 * MiB;
constexpr size_t WS_KMAX = 7 * MiB, WS_IDX = 7 * MiB + 512 * 1024;
constexpr size_t WS_W = 8 * MiB;
constexpr size_t WO_IN = 0, WO_UQ = WO_IN + (size_t)NIN * D * 2, WO_UKV = WO_UQ + (size_t)768 * QR * 2, WO_OA = WO_UKV + (size_t)1024 * KVR * 2,
                 WO_POOL = WO_OA + (size_t)D * 512 * 2, WO_OC = WO_POOL + (size_t)D * 512 * 2, WO_OUT = WO_OC + (size_t)D * 512 * 2,
                 WO_GU = WO_OUT + (size_t)D * D * 2, WO_DN = WO_GU + (size_t)NE * 2048 * D * 2, WL_BYTES = WO_DN + (size_t)NE * D * FF * 2;
static_assert(WS_W + NL * WL_BYTES <= 464 * MiB, "weights fit");
constexpr size_t WS_X = 464 * MiB, WS_H = 528 * MiB;
constexpr size_t WS_CQ = 560 * MiB, WS_CKV = 572 * MiB, WS_KR = 580 * MiB, WS_U = 581 * MiB, WS_CV = 597 * MiB, WS_GT = 645 * MiB, WS_Q = 741 * MiB,
                 WS_KV = 765 * MiB, WS_MIX = 797 * MiB, WS_CY = 813 * MiB, WS_O = 829 * MiB, WS_MG = 845 * MiB, WS_END = 877 * MiB;
constexpr size_t WS_XG = 560 * MiB, WS_ACT = 624 * MiB, WS_Y = 688 * MiB;
constexpr int CW_BAR = 4096;

constexpr int LDS_BYTES = 147456;
constexpr int MISC_OFF = 131072 + 1024;
constexpr int LDS_BIAS = 131072 + 2048;

#define GAS __attribute__((address_space(1)))
#define LAS __attribute__((address_space(3)))
typedef unsigned short bf16;
typedef unsigned v4u __attribute__((ext_vector_type(4)));
typedef unsigned v2u __attribute__((ext_vector_type(2)));
using pg8::f32x4;
using pg8::bf16x8;
#define LDS_WAIT() asm volatile("s_waitcnt lgkmcnt(0)" ::: "memory")
#define VM_WAIT() asm volatile("s_waitcnt vmcnt(0)" ::: "memory")
__device__ __forceinline__ unsigned pk2(float lo, float hi) { return pg8::cvt_pk_bf16(lo, hi); }
__device__ __forceinline__ float bflo(unsigned w) { return __uint_as_float(w << 16); }
__device__ __forceinline__ float bfhi(unsigned w) { return __uint_as_float(w & 0xffff0000u); }
__device__ __forceinline__ v4u pack8(const f32x4& a, const f32x4& b) { v4u w; w.x = pk2(a[0], a[1]); w.y = pk2(a[2], a[3]); w.z = pk2(b[0], b[1]); w.w = pk2(b[2], b[3]); return w; }
__device__ __forceinline__ void unpack8(const v4u& w, f32x4& a, f32x4& b) { a = (f32x4){bflo(w.x), bfhi(w.x), bflo(w.y), bfhi(w.y)}; b = (f32x4){bflo(w.z), bfhi(w.z), bflo(w.w), bfhi(w.w)}; }
__device__ __forceinline__ float wave_sum(float v) {
#pragma unroll
    for (int o = 1; o < 64; o <<= 1) v += __shfl_xor(v, o);
    return v;
}
__device__ __forceinline__ float wave_max(float v) {
#pragma unroll
    for (int o = 1; o < 64; o <<= 1) v = fmaxf(v, __shfl_xor(v, o));
    return v;
}
__device__ __forceinline__ unsigned char* opaque(unsigned char* p) { size_t z = 0; asm volatile("" : "+s"(z)); return p + z; }
constexpr float QSCALE = 0.10206207261596575f * 1.4426950408889634f;
__device__ __forceinline__ int otid() { int t = threadIdx.x; asm volatile("" : "+v"(t)); return t; }
__device__ __forceinline__ float sigmoidf_(float x) { return fmaxf(__builtin_amdgcn_rcpf(1.0f + __expf(-x)), 1e-30f); }

#ifndef EPI_REP
#define EPI_REP 1
#endif
struct NoCarry { };
template <class F, int FENCE = 1, bool KREP_SITE = true> struct Epi8 {
    static constexpr bool PERM = true, AFTER_DRAIN = false;
    F f;
    __device__ __forceinline__ void operator()(const f32x4 (&acc)[2][2][4][2], const pg8::Unit& u, int wr, int wc, int fr, int fq) const {
        const int row0 = u.pm * 256 + wr * 64 + fr, col = u.pn * 256 + wc * 32 + 8 * fq;
        typename F::Carry carry{};
#pragma unroll
        for (int g0 = 0; g0 < 8; g0 += FENCE) {
            typename F::L ld[FENCE];
#pragma unroll
            for (int k = 0; k < FENCE; ++k) { const int ai = (g0 + k) >> 2, m = (g0 + k) & 3; ld[k] = f.pre(u, row0 + ai * 128 + m * 16, col); }
#pragma unroll
            for (int k = 0; k < FENCE; ++k) { const int ai = (g0 + k) >> 2, m = (g0 + k) & 3; constexpr float kr = KREP_SITE ? 1.0f / PG8_KREP : 1.0f;
                f.post(u, row0 + ai * 128 + m * 16, col, ld[k], acc[ai][0][m][0] * kr, acc[ai][0][m][1] * kr, acc[ai][1][m][0] * kr, acc[ai][1][m][1] * kr, carry); }
            asm volatile("" ::: "memory");
        }
        f.finish(u, wr, wc, carry);
    }
};

template <class Epi, class Sched>
__device__ __forceinline__ void naive_gemm_phase(LAS unsigned char* lds, const pg8::Gemm g, const Sched& Sd, const Epi& E) {
    const int tid = otid(), wid = tid >> 6, lane = tid & 63, wr = wid >> 2, wc = wid & 3, fr = lane & 15, fq = lane >> 4;
    const int K = g.K;
    LAS bf16* As = (LAS bf16*)lds; LAS bf16* Bs = (LAS bf16*)(lds + 256 * 72 * 2);
    pg8::Unit u;
    for (int ui = 0; Sd.next(ui, u); ++ui) {
        f32x4 acc[2][2][4][2];
#pragma unroll
        for (int a = 0; a < 2; ++a)
#pragma unroll
            for (int b = 0; b < 2; ++b)
#pragma unroll
                for (int m = 0; m < 4; ++m)
#pragma unroll
                    for (int n = 0; n < 2; ++n) acc[a][b][m][n] = (f32x4){0.f, 0.f, 0.f, 0.f};
        for (int k0 = 0; k0 < K; k0 += 64) {
            __syncthreads();
#pragma unroll
            for (int i = 0; i < 4; ++i) { const int id = tid + 512 * i, r = id >> 3, c8 = id & 7;
                *(LAS v4u*)(As + r * 72 + c8 * 8) = *(const v4u*)(g.A + (size_t)(u.pm * 256 + r) * K + k0 + c8 * 8);
                *(LAS v4u*)(Bs + r * 72 + c8 * 8) = *(const v4u*)(g.Bt + (size_t)(u.pn * 256 + r) * K + k0 + c8 * 8); }
            __syncthreads();
#pragma unroll 1
            for (int kk = 0; kk < 64; kk += 8) {
                v4u af[2][4];
#pragma unroll
                for (int ai = 0; ai < 2; ++ai)
#pragma unroll
                    for (int m = 0; m < 4; ++m) af[ai][m] = *(const LAS v4u*)(As + (128 * ai + 64 * wr + 16 * m + fr) * 72 + kk);
#pragma unroll
                for (int bj = 0; bj < 2; ++bj)
#pragma unroll
                    for (int n = 0; n < 2; ++n)
#pragma unroll
                        for (int i = 0; i < 4; ++i) {
                            const v4u bw = *(const LAS v4u*)(Bs + (128 * bj + 32 * wc + 8 * fq + 4 * n + i) * 72 + kk);
                            f32x4 b0, b1; unpack8(bw, b0, b1);
#pragma unroll
                            for (int ai = 0; ai < 2; ++ai)
#pragma unroll
                                for (int m = 0; m < 4; ++m) { f32x4 a0, a1; unpack8(af[ai][m], a0, a1);
                                    float s = acc[ai][bj][m][n][i];
                                    s += a0[0] * b0[0]; s += a0[1] * b0[1]; s += a0[2] * b0[2]; s += a0[3] * b0[3];
                                    s += a1[0] * b1[0]; s += a1[1] * b1[1]; s += a1[2] * b1[2]; s += a1[3] * b1[3];
                                    acc[ai][bj][m][n][i] = s; }
                        }
            }
        }
        E(acc, u, wr, wc, fr, fq);
    }
    __syncthreads();
}
#ifndef PG8_ALIGN
#define PG8_ALIGN true
#endif
#ifndef PG8_SP2
#define PG8_SP2 true
#endif
template <int SITE, class Epi, class Sched>
__device__ __forceinline__ void run_gemm(LAS unsigned char* lds, const pg8::Gemm g, const Sched& Sd, const Epi& E) {
    if constexpr ((NAIVE_GEMM_MASK >> SITE) & 1) naive_gemm_phase<Epi, Sched>(lds, g, Sd, E);
    else pg8::gemm_phase<Epi, Sched, true, PG8_SP2>(lds, g, Sd, E);
}

namespace att {
using s16x4 = __attribute__((ext_vector_type(4))) short;
using f32x16 = __attribute__((ext_vector_type(16))) float;
constexpr int NW = 8, QBLK = 32, KVBLK = 64;
constexpr float SCALE = 0.10206207261596575f;
constexpr float THR = 8.f;
constexpr int LDQ = 768, LDKV = 1024, LDKR = 32, LDO = 512;
constexpr int SHM_V = KVBLK * 64 * 2, SHM_K = KVBLK * 256, SHM_ATTN = 2 * SHM_V + 2 * SHM_K + NW * 64 * 4;
#define KSWZ(row, colB) ((row) * 256 + ((colB) ^ (((row) & 7) << 4)))
#define SBAR() __builtin_amdgcn_sched_barrier(0)
__device__ __forceinline__ int crow(int r, int hi) { return (r & 3) + 8 * (r >> 2) + 4 * hi; }
__device__ __forceinline__ unsigned cvtpk(float lo, float hi) { unsigned r; asm volatile("v_cvt_pk_bf16_f32 %0, %1, %2" : "=v"(r) : "v"(lo), "v"(hi)); return r; }

constexpr float THR2 = THR * 1.4426950408889634f;
template <bool FAST> __device__ __forceinline__ void partialSM(f32x16& p0, f32x16& p1, float& m_reg, float& mn, float& alpha) {
  if constexpr (!FAST) {
    float pmax = p0[0];
#pragma unroll
    for (int r = 1; r < 16; ++r) pmax = fmaxf(pmax, p0[r]);
#pragma unroll
    for (int r = 0; r < 16; ++r) pmax = fmaxf(pmax, p1[r]);
    { auto rr = __builtin_amdgcn_permlane32_swap(__float_as_uint(pmax), __float_as_uint(pmax), false, false);
      pmax = fmaxf(__uint_as_float(rr[0]), __uint_as_float(rr[1])); }
    if (__builtin_expect(__all(pmax - m_reg <= THR2), 1)) { mn = m_reg; alpha = 1.f; }
    else { mn = fmaxf(m_reg, pmax); alpha = __builtin_amdgcn_exp2f(m_reg - mn); m_reg = mn; }
#pragma unroll
    for (int r = 0; r < 16; ++r) p0[r] -= mn;
#pragma unroll
    for (int r = 0; r < 16; ++r) p1[r] -= mn;
  } else { alpha = 1.f; mn = 0.f; }
#pragma unroll
  for (int r = 0; r < 16; ++r) p0[r] = __builtin_amdgcn_exp2f(p0[r]);
}
template <bool FAST> __device__ __forceinline__ void finishSM(f32x16& p0, f32x16& p1, float alpha, float& l_reg, bf16x8& pa0, bf16x8& pa1, bf16x8& pa2, bf16x8& pa3) {
#pragma unroll
  for (int r = 0; r < 16; ++r) p1[r] = __builtin_amdgcn_exp2f(p1[r]);
  float ps = 0;
#pragma unroll
  for (int r = 0; r < 16; ++r) ps += p0[r];
#pragma unroll
  for (int r = 0; r < 16; ++r) ps += p1[r];
  { auto rr = __builtin_amdgcn_permlane32_swap(__float_as_uint(ps), __float_as_uint(ps), false, false);
    ps = __uint_as_float(rr[0]) + __uint_as_float(rr[1]); }
  if constexpr (FAST) l_reg += ps; else l_reg = l_reg * alpha + ps;
#define PK4(P, BASE, OUT) do { unsigned a0 = cvtpk(P[BASE + 0], P[BASE + 1]), a1 = cvtpk(P[BASE + 2], P[BASE + 3]);   \
    unsigned b0 = cvtpk(P[BASE + 4], P[BASE + 5]), b1 = cvtpk(P[BASE + 6], P[BASE + 7]);                              \
    auto r0 = __builtin_amdgcn_permlane32_swap(a0, b0, false, false); auto r1 = __builtin_amdgcn_permlane32_swap(a1, b1, false, false); \
    v4u w = {r0[0], r1[0], r0[1], r1[1]}; OUT = *reinterpret_cast<bf16x8*>(&w); } while (0)
  PK4(p0, 0, pa0); PK4(p0, 8, pa1); PK4(p1, 0, pa2); PK4(p1, 8, pa3);
#undef PK4
}
__device__ __forceinline__ void qkt(f32x16& p0, f32x16& p1, const LAS char* Ks, const bf16x8* qr, int r32, int hi) {
  p0 = f32x16{}; p1 = f32x16{};
#if ATTN_KBATCH
  bf16x8 kb0[6], kb1[6];
#pragma unroll
  for (int d0 = 0; d0 < 6; ++d0) { const int cb = (d0 * 16 + hi * 8) * 2; kb0[d0] = *(const LAS bf16x8*)(Ks + KSWZ(r32, cb)); kb1[d0] = *(const LAS bf16x8*)(Ks + KSWZ(32 + r32, cb)); }
  asm volatile("s_waitcnt lgkmcnt(0)" ::: "memory"); SBAR();
#pragma unroll
  for (int d0 = 0; d0 < 6; ++d0) { p0 = __builtin_amdgcn_mfma_f32_32x32x16_bf16(kb0[d0], qr[d0], p0, 0, 0, 0); p1 = __builtin_amdgcn_mfma_f32_32x32x16_bf16(kb1[d0], qr[d0], p1, 0, 0, 0); }
  SBAR();
#else
#pragma unroll
  for (int d0 = 0; d0 < 6; ++d0) { const int cb = (d0 * 16 + hi * 8) * 2;
    const bf16x8 b0 = *(const LAS bf16x8*)(Ks + KSWZ(r32, cb));
    const bf16x8 b1 = *(const LAS bf16x8*)(Ks + KSWZ(32 + r32, cb));
    p0 = __builtin_amdgcn_mfma_f32_32x32x16_bf16(b0, qr[d0], p0, 0, 0, 0);
    p1 = __builtin_amdgcn_mfma_f32_32x32x16_bf16(b1, qr[d0], p1, 0, 0, 0); }
#endif
}
__device__ __forceinline__ int v_st(int k, int c) { const int kk = (k & ~0xC) | ((k & 4) << 1) | ((k & 8) >> 1); return ((kk >> 3) * 2 + (c >> 5)) * 512 + ((kk & 7) * 32 + (c & 31)) * 2; }
__device__ __forceinline__ int v_rd_base(int lane) { return ((lane & 3) << 3) | (((lane >> 2) & 3) << 6) | (((lane >> 4) & 1) << 5) | (((lane >> 5) & 1) << 8); }
constexpr int v_rd_off(int d0, int ks, int half) { return d0 * 512 + ks * 2048 + half * 1024; }
template <int OFF> __device__ __forceinline__ s16x4 tr_read(int vb) {
  s16x4 r; asm volatile("ds_read_b64_tr_b16 %0, %1 offset:%2" : "=&v"(r) : "v"(vb), "i"(OFF) : "memory"); return r;
}
template <int D0> __device__ __forceinline__ void pv_one(f32x16& od, int vb, bf16x8 pa0, bf16x8 pa1, bf16x8 pa2, bf16x8 pa3) {
  const s16x4 l0 = tr_read<v_rd_off(D0, 0, 0)>(vb), h0 = tr_read<v_rd_off(D0, 0, 1)>(vb), l1 = tr_read<v_rd_off(D0, 1, 0)>(vb), h1 = tr_read<v_rd_off(D0, 1, 1)>(vb);
  const s16x4 l2 = tr_read<v_rd_off(D0, 2, 0)>(vb), h2 = tr_read<v_rd_off(D0, 2, 1)>(vb), l3 = tr_read<v_rd_off(D0, 3, 0)>(vb), h3 = tr_read<v_rd_off(D0, 3, 1)>(vb);
  asm volatile("s_waitcnt lgkmcnt(0)" ::: "memory"); SBAR();
#define PK(L, H) (bf16x8){L[0], L[1], L[2], L[3], H[0], H[1], H[2], H[3]}
  od = __builtin_amdgcn_mfma_f32_32x32x16_bf16(pa0, PK(l0, h0), od, 0, 0, 0);
  od = __builtin_amdgcn_mfma_f32_32x32x16_bf16(pa1, PK(l1, h1), od, 0, 0, 0);
  od = __builtin_amdgcn_mfma_f32_32x32x16_bf16(pa2, PK(l2, h2), od, 0, 0, 0);
  od = __builtin_amdgcn_mfma_f32_32x32x16_bf16(pa3, PK(l3, h3), od, 0, 0, 0);
#undef PK
}
__device__ __forceinline__ void pv_d0(f32x16* o, int vb, bf16x8 pa0, bf16x8 pa1, bf16x8 pa2, bf16x8 pa3) {
  pv_one<0>(o[0], vb, pa0, pa1, pa2, pa3); pv_one<1>(o[1], vb, pa0, pa1, pa2, pa3);
}

__device__ __forceinline__ void istep(f32x16& A0, f32x16& A1, f32x16& C0, f32x16& C1, f32x16* o, float& l_reg, const bf16x8* qr, const LAS char* Ks, const LAS char* KsN, const LAS char* Vs,
                                      bf16x8 (&kn)[6], int r32, int hi) {
  bf16x8 kf[12]; const f32x16 z = {};
  float ps; unsigned a0, a1, b0, b1, c0, c1, e0, e1; bf16x8 pa0, pa1, pa2, pa3;
#define KADDR(B, i) ((B) + KSWZ(((i) & 1) * 32 + r32, (((i) >> 1) * 16 + hi * 8) * 2))
#define LDK(i) kf[i] = *(const LAS bf16x8*)KADDR(Ks, i)
#define EX(P, a) do { P[a] = __builtin_amdgcn_exp2f(P[a]); asm volatile("" :: "v"(P[a])); } while (0)
#define MF(X, Y, Z) __builtin_amdgcn_mfma_f32_32x32x16_bf16(X, Y, Z, 0, 0, 0)
  s16x4 l00, h00, l10, h10, l01, h01, l11, h11, l02, h02, l12, h12, l03, h03, l13, h13;
#define TRB(D0, KS, HF) __builtin_amdgcn_ds_read_tr16_b64_v4i16((LAS s16x4*)(Vs + v_rd_off(D0, KS, HF)))
#define VRD(KS) do { l0##KS = TRB(0, KS, 0); h0##KS = TRB(0, KS, 1); l1##KS = TRB(1, KS, 0); h1##KS = TRB(1, KS, 1); } while (0)
#define SWP(OUT, x0, y0, x1, y1) do { auto r0_ = __builtin_amdgcn_permlane32_swap(x0, y0, false, false); auto r1_ = __builtin_amdgcn_permlane32_swap(x1, y1, false, false); \
    v4u w_ = {r0_[0], r1_[0], r0_[1], r1_[1]}; OUT = *reinterpret_cast<bf16x8*>(&w_); } while (0)
#pragma unroll
  for (int i = 0; i < 6; ++i) kf[i] = kn[i];
  LDK(6);  C0 = MF(kf[0], qr[0], z);   ps = A0[0] + A0[1]; ps += A0[2]; ps += A0[3]; EX(A1, 0); EX(A1, 1); SBAR();
  LDK(7);  C1 = MF(kf[1], qr[0], z);   ps += A0[4]; ps += A0[5]; ps += A0[6]; ps += A0[7]; EX(A1, 2); EX(A1, 3); SBAR();
  LDK(8);  C0 = MF(kf[2], qr[1], C0);  ps += A0[8]; ps += A0[9]; ps += A0[10]; ps += A0[11]; EX(A1, 4); EX(A1, 5); SBAR();
  LDK(9);  C1 = MF(kf[3], qr[1], C1);  ps += A0[12]; ps += A0[13]; ps += A0[14]; ps += A0[15]; EX(A1, 6); EX(A1, 7); SBAR();
  LDK(10); C0 = MF(kf[4], qr[2], C0);  a0 = cvtpk(A0[0], A0[1]); a1 = cvtpk(A0[2], A0[3]); b0 = cvtpk(A0[4], A0[5]); b1 = cvtpk(A0[6], A0[7]); EX(A1, 8); EX(A1, 9); SBAR();
  LDK(11); C1 = MF(kf[5], qr[2], C1);  c0 = cvtpk(A0[8], A0[9]); c1 = cvtpk(A0[10], A0[11]); e0 = cvtpk(A0[12], A0[13]); e1 = cvtpk(A0[14], A0[15]); EX(A1, 10); EX(A1, 11); SBAR();
           C0 = MF(kf[6], qr[3], C0);  SWP(pa0, a0, b0, a1, b1); SWP(pa1, c0, e0, c1, e1); EX(A1, 12); EX(A1, 13); SBAR();
           C1 = MF(kf[7], qr[3], C1);  EX(A1, 14); EX(A1, 15); a0 = cvtpk(A1[0], A1[1]); a1 = cvtpk(A1[2], A1[3]); b0 = cvtpk(A1[4], A1[5]); b1 = cvtpk(A1[6], A1[7]); SBAR();
  VRD(0);  C0 = MF(kf[8], qr[4], C0);  c0 = cvtpk(A1[8], A1[9]); c1 = cvtpk(A1[10], A1[11]); e0 = cvtpk(A1[12], A1[13]); e1 = cvtpk(A1[14], A1[15]); SWP(pa2, a0, b0, a1, b1); SBAR();
  VRD(1);  C1 = MF(kf[9], qr[4], C1);  SWP(pa3, c0, e0, c1, e1); ps += A1[0]; ps += A1[1]; ps += A1[2]; ps += A1[3]; SBAR();
  VRD(2);  C0 = MF(kf[10], qr[5], C0); ps += A1[4]; ps += A1[5]; ps += A1[6]; ps += A1[7]; ps += A1[8]; ps += A1[9]; SBAR();
  VRD(3);  C1 = MF(kf[11], qr[5], C1); ps += A1[10]; ps += A1[11]; ps += A1[12]; ps += A1[13]; ps += A1[14]; ps += A1[15]; SBAR();
#define PK(L, H) (bf16x8){L[0], L[1], L[2], L[3], H[0], H[1], H[2], H[3]}
  kn[0] = *(const LAS bf16x8*)KADDR(KsN, 0);
  o[0] = MF(pa0, PK(l00, h00), o[0]); EX(C0, 0);  EX(C0, 1);  SBAR();
  kn[1] = *(const LAS bf16x8*)KADDR(KsN, 1);
  o[1] = MF(pa0, PK(l10, h10), o[1]); EX(C0, 2);  EX(C0, 3);  SBAR();
  kn[2] = *(const LAS bf16x8*)KADDR(KsN, 2);
  o[0] = MF(pa1, PK(l01, h01), o[0]); EX(C0, 4);  EX(C0, 5);  SBAR();
  kn[3] = *(const LAS bf16x8*)KADDR(KsN, 3);
  o[1] = MF(pa1, PK(l11, h11), o[1]); EX(C0, 6);  EX(C0, 7);  SBAR();
  kn[4] = *(const LAS bf16x8*)KADDR(KsN, 4);
  o[0] = MF(pa2, PK(l02, h02), o[0]); EX(C0, 8);  EX(C0, 9);  SBAR();
  kn[5] = *(const LAS bf16x8*)KADDR(KsN, 5);
  o[1] = MF(pa2, PK(l12, h12), o[1]); EX(C0, 10); EX(C0, 11); SBAR();
  o[0] = MF(pa3, PK(l03, h03), o[0]); EX(C0, 12); EX(C0, 13); SBAR();
  o[1] = MF(pa3, PK(l13, h13), o[1]); EX(C0, 14); EX(C0, 15);
  { auto rr = __builtin_amdgcn_permlane32_swap(__float_as_uint(ps), __float_as_uint(ps), false, false); l_reg += __uint_as_float(rr[0]) + __uint_as_float(rr[1]); }
  SBAR();
#undef PK
#undef KADDR
#undef LDK
#undef EX
#undef MF
#undef SWP
#undef TRB
#undef VRD
}

template <bool FAST> __device__ __forceinline__ void attn_unit_t(const bf16* __restrict__ KV, const bf16* __restrict__ KR, bf16* __restrict__ O,
                                          long t0, long kb0, int h, LAS char* lds, const bf16x8 (&qr)[6]) {
  const int tid = otid(), wid = tid >> 6, lane = tid & 63, r32 = lane & 31, hi = lane >> 5;
  LAS char* V_lds = lds; LAS char* K_lds = lds + 2 * SHM_V;
  LAS float* ws = (LAS float*)(lds + 2 * SHM_V + 2 * SHM_K) + wid * 64; LAS float* li_l = ws; LAS float* al_l = ws + 32;
  float m_reg = -1e30f, l_reg = 0; f32x16 o[2] = {};
  const int sr = tid >> 4, kc = tid & 15; const bool kact = kc < 12, krope = kc >= 8;
  const bf16* kptr = krope ? (KR + (kb0 + sr) * LDKR + (kc - 8) * 8) : (KV + (kb0 + sr) * LDKV + h * 128 + kc * 8);
  const long kstr = krope ? LDKR : LDKV;
  const int vr = tid >> 3, vc = (tid & 7) * 8;
  const bf16* vptr = KV + (kb0 + vr) * LDKV + h * 128 + 64 + vc;
  const int vst = v_st(vr, vc), kst0 = KSWZ(sr, kc * 16), kst1 = KSWZ(32 + sr, kc * 16);
  const int vb0 = (int)(uintptr_t)V_lds + v_rd_base(lane);
  struct { bf16x8 vs, ks0, ks1; } sr_[2];
#define SLOAD(i, k0) do { sr_[i].vs = *reinterpret_cast<const bf16x8*>(vptr + (long)(k0) * LDKV); \
    if (kact) { sr_[i].ks0 = *reinterpret_cast<const bf16x8*>(kptr + (long)(k0) * kstr); sr_[i].ks1 = *reinterpret_cast<const bf16x8*>(kptr + (long)((k0) + 32) * kstr); } } while (0)
#define SWRITE(b, i) do { *(LAS bf16x8*)(V_lds + (b) * SHM_V + vst) = sr_[i].vs; \
    if (kact) { *(LAS bf16x8*)(K_lds + (b) * SHM_K + kst0) = sr_[i].ks0; *(LAS bf16x8*)(K_lds + (b) * SHM_K + kst1) = sr_[i].ks1; } } while (0)
#define SWAIT() asm volatile("s_waitcnt vmcnt(3)" ::: "memory")
#define RESC(a) do { if constexpr (!FAST) { if (__any((a) < 1.f)) { if (hi == 0) al_l[r32] = (a); asm volatile("s_waitcnt lgkmcnt(0)" ::: "memory"); \
    _Pragma("unroll") for (int d = 0; d < 2; ++d) _Pragma("unroll") for (int r = 0; r < 16; ++r) o[d][r] *= al_l[crow(r, hi)]; } } } while (0)
  f32x16 pA0, pA1, pB0, pB1; float mnA, mnB, alA, alB; bf16x8 pa0, pa1, pa2, pa3; constexpr int NT = S / KVBLK;
  SLOAD(0, 0); asm volatile("s_waitcnt vmcnt(0)" ::: "memory"); SWRITE(0, 0); __syncthreads();
  qkt(pA0, pA1, K_lds, qr, r32, hi); partialSM<FAST>(pA0, pA1, m_reg, mnA, alA);
  SLOAD(1, KVBLK); SLOAD(0, 2 * KVBLK);
  SWAIT(); SWRITE(1, 1); __syncthreads();
  for (int j = 1; j + 1 < NT; j += 2) {
    SBAR(); qkt(pB0, pB1, K_lds + SHM_K, qr, r32, hi);
    finishSM<FAST>(pA0, pA1, alA, l_reg, pa0, pa1, pa2, pa3); SBAR();
    SLOAD(1, (j + 2) * KVBLK); SBAR();
    pv_d0(o, vb0, pa0, pa1, pa2, pa3); partialSM<FAST>(pB0, pB1, m_reg, mnB, alB);
    __syncthreads(); SWAIT(); SWRITE(0, 0);
    RESC(alB); __syncthreads();
    SBAR(); qkt(pA0, pA1, K_lds, qr, r32, hi);
    finishSM<FAST>(pB0, pB1, alB, l_reg, pa0, pa1, pa2, pa3); SBAR();
    if (j + 3 < NT) SLOAD(0, (j + 3) * KVBLK); SBAR();
    pv_d0(o, vb0 + SHM_V, pa0, pa1, pa2, pa3); partialSM<FAST>(pA0, pA1, m_reg, mnA, alA);
    __syncthreads(); SWAIT(); SWRITE(1, 1);
    RESC(alA); __syncthreads();
  }
  SBAR(); qkt(pB0, pB1, K_lds + SHM_K, qr, r32, hi);
  finishSM<FAST>(pA0, pA1, alA, l_reg, pa0, pa1, pa2, pa3); SBAR();
  pv_d0(o, vb0, pa0, pa1, pa2, pa3); partialSM<FAST>(pB0, pB1, m_reg, mnB, alB);
  __syncthreads(); RESC(alB);
  finishSM<FAST>(pB0, pB1, alB, l_reg, pa0, pa1, pa2, pa3); SBAR();
  pv_d0(o, vb0 + SHM_V, pa0, pa1, pa2, pa3);
  if (hi == 0) li_l[r32] = l_reg; asm volatile("s_waitcnt lgkmcnt(0)" ::: "memory");
  float rli[16];
#pragma unroll
  for (int r = 0; r < 16; ++r) rli[r] = __builtin_amdgcn_rcpf(li_l[crow(r, hi)]);
  bf16* Ow = O + (t0 + wid * QBLK) * LDO + h * 64;
  { LAS bf16* stg = (LAS bf16*)(lds + 53248) + wid * 2048;
#pragma unroll
    for (int r = 0; r < 16; ++r) { const int orow = crow(r, hi);
#pragma unroll
      for (int d0 = 0; d0 < 2; ++d0) stg[orow * 64 + d0 * 32 + r32] = (bf16)(cvtpk(o[d0][r] * rli[r], 0.f) & 0xffffu); }
    asm volatile("s_waitcnt lgkmcnt(0)" ::: "memory");
#pragma unroll
    for (int i = 0; i < 4; ++i) { const int row = i * 8 + (lane >> 3), ch = lane & 7; const v4u v = *(const LAS v4u*)(stg + row * 64 + ch * 8); *(v4u*)(Ow + (long)row * LDO + ch * 8) = v; } }
#undef SLOAD
#undef SWRITE
#undef SWAIT
#undef RESC
  __syncthreads();
}


template <bool FAST> __device__ __forceinline__ void attn_unit_1b(const bf16* __restrict__ KV, const bf16* __restrict__ KR, bf16* __restrict__ O,
                                          long t0, long kb0, int h, LAS char* lds, const bf16x8 (&qr)[6]) {
  const int tid = otid(), wid = tid >> 6, lane = tid & 63, r32 = lane & 31, hi = lane >> 5;
  constexpr int KOFF = 0, VOFF = 3 * SHM_K, WSOFF = 3 * SHM_K + 3 * SHM_V, STGOFF = WSOFF + NW * 256;
  LAS float* ws = (LAS float*)(lds + WSOFF) + wid * 64; LAS float* li_l = ws; LAS float* al_l = ws + 32;
  float m_reg = -1e30f, l_reg = 0; f32x16 o[2] = {};
  const int sr = tid >> 4, kc = tid & 15; const bool kact = kc < 12, krope = kc >= 8;
  const bf16* kptr = krope ? (KR + (kb0 + sr) * LDKR + (kc - 8) * 8) : (KV + (kb0 + sr) * LDKV + h * 128 + kc * 8);
  const long kstr = krope ? LDKR : LDKV;
  const int vr = tid >> 3, vc = (tid & 7) * 8;
  const bf16* vptr = KV + (kb0 + vr) * LDKV + h * 128 + 64 + vc;
  const int vst = VOFF + v_st(vr, vc), kst0 = KOFF + KSWZ(sr, kc * 16), kst1 = KOFF + KSWZ(32 + sr, kc * 16);
  const int vrb = v_rd_base(lane), vb0 = (int)(uintptr_t)lds + VOFF + vrb;
  bf16x8 svs, sk0, sk1;
#define LOADK(t) do { if (kact) { sk0 = *reinterpret_cast<const bf16x8*>(kptr + (long)((t) * KVBLK) * kstr); sk1 = *reinterpret_cast<const bf16x8*>(kptr + (long)((t) * KVBLK + 32) * kstr); } } while (0)
#define LOADV(t) do { svs = *reinterpret_cast<const bf16x8*>(vptr + (long)((t) * KVBLK) * LDKV); } while (0)
#define WRITEK(slot) do { if (kact) { *(LAS bf16x8*)(lds + (slot) * SHM_K + kst0) = sk0; *(LAS bf16x8*)(lds + (slot) * SHM_K + kst1) = sk1; } } while (0)
#define WRITEV(slot) do { *(LAS bf16x8*)(lds + (slot) * SHM_V + vst) = svs; } while (0)
#define OBAR() asm volatile("s_waitcnt lgkmcnt(0)\n\ts_barrier" ::: "memory")
#define RESC(a) do { if constexpr (!FAST) { if (__any((a) < 1.f)) { if (hi == 0) al_l[r32] = (a); asm volatile("s_waitcnt lgkmcnt(0)" ::: "memory"); \
    _Pragma("unroll") for (int d = 0; d < 2; ++d) _Pragma("unroll") for (int r = 0; r < 16; ++r) o[d][r] *= al_l[crow(r, hi)]; } } } while (0)
  f32x16 pA0, pA1, pB0, pB1; float mnA, mnB, alA, alB; bf16x8 pa0, pa1, pa2, pa3; constexpr int NT = S / KVBLK;
  LOADK(0); LOADV(0); asm volatile("s_waitcnt vmcnt(0)" ::: "memory"); WRITEK(0); WRITEV(0);
  LOADK(1); asm volatile("s_waitcnt vmcnt(0)" ::: "memory"); WRITEK(1);
  LOADK(2); LOADV(1); OBAR();
  int kc_ = 0, kn_ = 1, kw_ = 2, vp_ = 2, vc_ = 0, vw_ = 1;
#define ROT() do { const int a_ = kc_; kc_ = kn_; kn_ = kw_; kw_ = a_; const int b_ = vp_; vp_ = vc_; vc_ = vw_; vw_ = b_; } while (0)
  qkt(pA0, pA1, lds + KOFF + kc_ * SHM_K, qr, r32, hi); partialSM<FAST>(pA0, pA1, m_reg, mnA, alA);
  WRITEK(kw_); WRITEV(vw_); LOADK(3); LOADV(2); OBAR(); ROT();
#if ATTN_ISTEP
  if constexpr (FAST) {
#if ATTN_PRIO
    if (wid >= 4) __builtin_amdgcn_s_setprio(1);
#endif
    bf16x8 kn[6];
#pragma unroll
    for (int i = 0; i < 6; ++i) kn[i] = *(const LAS bf16x8*)(lds + KOFF + kc_ * SHM_K + KSWZ((i & 1) * 32 + r32, ((i >> 1) * 16 + hi * 8) * 2));
#pragma unroll 1
    for (int j = 1; j + 1 < NT; j += 2) {
      if (j + 2 < NT) WRITEK(kw_); WRITEV(vw_);
      if (j + 3 < NT) LOADK(j + 3); if (j + 2 < NT) LOADV(j + 2);
      SBAR(); istep(pA0, pA1, pB0, pB1, o, l_reg, qr, lds + KOFF + kc_ * SHM_K, lds + KOFF + kn_ * SHM_K, lds + VOFF + vp_ * SHM_V + vrb, kn, r32, hi);
      OBAR(); ROT();
      if (j + 3 < NT) WRITEK(kw_); if (j + 2 < NT) WRITEV(vw_);
      if (j + 4 < NT) LOADK(j + 4); if (j + 3 < NT) LOADV(j + 3);
      SBAR(); istep(pB0, pB1, pA0, pA1, o, l_reg, qr, lds + KOFF + kc_ * SHM_K, lds + KOFF + kn_ * SHM_K, lds + VOFF + vp_ * SHM_V + vrb, kn, r32, hi);
      OBAR(); ROT();
    }
#if ATTN_PRIO
    __builtin_amdgcn_s_setprio(0);
#endif
  } else
#endif
#pragma unroll 1
  for (int j = 1; j + 1 < NT; j += 2) {
    SBAR(); qkt(pB0, pB1, lds + KOFF + kc_ * SHM_K, qr, r32, hi);
    finishSM<FAST>(pA0, pA1, alA, l_reg, pa0, pa1, pa2, pa3); SBAR();
    pv_d0(o, vb0 + vp_ * SHM_V, pa0, pa1, pa2, pa3); partialSM<FAST>(pB0, pB1, m_reg, mnB, alB);
    if (j + 2 < NT) WRITEK(kw_); WRITEV(vw_);
    if (j + 3 < NT) LOADK(j + 3); if (j + 2 < NT) LOADV(j + 2);
    RESC(alB); OBAR(); ROT();
    SBAR(); qkt(pA0, pA1, lds + KOFF + kc_ * SHM_K, qr, r32, hi);
    finishSM<FAST>(pB0, pB1, alB, l_reg, pa0, pa1, pa2, pa3); SBAR();
    pv_d0(o, vb0 + vp_ * SHM_V, pa0, pa1, pa2, pa3); partialSM<FAST>(pA0, pA1, m_reg, mnA, alA);
    if (j + 3 < NT) WRITEK(kw_); if (j + 2 < NT) WRITEV(vw_);
    if (j + 4 < NT) LOADK(j + 4); if (j + 3 < NT) LOADV(j + 3);
    RESC(alA); OBAR(); ROT();
  }
  SBAR(); qkt(pB0, pB1, lds + KOFF + kc_ * SHM_K, qr, r32, hi);
  finishSM<FAST>(pA0, pA1, alA, l_reg, pa0, pa1, pa2, pa3); SBAR();
  pv_d0(o, vb0 + vp_ * SHM_V, pa0, pa1, pa2, pa3); partialSM<FAST>(pB0, pB1, m_reg, mnB, alB);
  RESC(alB); ROT();
  finishSM<FAST>(pB0, pB1, alB, l_reg, pa0, pa1, pa2, pa3); SBAR();
  pv_d0(o, vb0 + vp_ * SHM_V, pa0, pa1, pa2, pa3);
  if (hi == 0) li_l[r32] = l_reg; asm volatile("s_waitcnt lgkmcnt(0)" ::: "memory");
  float rli[16];
#pragma unroll
  for (int r = 0; r < 16; ++r) rli[r] = __builtin_amdgcn_rcpf(li_l[crow(r, hi)]);
  bf16* Ow = O + (t0 + wid * QBLK) * LDO + h * 64;
  { LAS bf16* stg = (LAS bf16*)(lds + STGOFF) + wid * 2048;
#pragma unroll
    for (int r = 0; r < 16; ++r) { const int orow = crow(r, hi);
#pragma unroll
      for (int d0 = 0; d0 < 2; ++d0) stg[orow * 64 + d0 * 32 + r32] = (bf16)(cvtpk(o[d0][r] * rli[r], 0.f) & 0xffffu); }
    asm volatile("s_waitcnt lgkmcnt(0)" ::: "memory");
#pragma unroll
    for (int i = 0; i < 4; ++i) { const int row = i * 8 + (lane >> 3), ch = lane & 7; const v4u v = *(const LAS v4u*)(stg + row * 64 + ch * 8); *(v4u*)(Ow + (long)row * LDO + ch * 8) = v; } }
#undef LOADK
#undef LOADV
#undef WRITEK
#undef WRITEV
#undef RESC
#undef ROT
  asm volatile("s_waitcnt vmcnt(0) lgkmcnt(0)\n\ts_barrier" ::: "memory");
#undef OBAR
}

__device__ __forceinline__ void attn_unit(const bf16* __restrict__ Q, const bf16* __restrict__ KV, const bf16* __restrict__ KR, bf16* __restrict__ O,
                                          long t0, long kb0, int h, LAS char* lds, float kmax2) {
  const int tid = otid(), wid = tid >> 6, lane = tid & 63, r32 = lane & 31, hi = lane >> 5;
  bf16x8 qr[6];
  const bf16* Qw = Q + (t0 + wid * QBLK + r32) * LDQ + h * DQK + hi * 8;
#pragma unroll
  for (int d0 = 0; d0 < 6; ++d0) qr[d0] = *reinterpret_cast<const bf16x8*>(Qw + d0 * 16);
  float qn2 = 0.f;
#pragma unroll
  for (int d0 = 0; d0 < 6; ++d0) { const v4u w = *reinterpret_cast<const v4u*>(&qr[d0]); f32x4 a, b; unpack8(w, a, b); qn2 += (a[0] * a[0] + a[1] * a[1]) + (a[2] * a[2] + a[3] * a[3]) + (b[0] * b[0] + b[1] * b[1]) + (b[2] * b[2] + b[3] * b[3]); }
  qn2 += __shfl_xor(qn2, 32);
  const bool fast = ATTN_FASTPATH && __all(qn2 * kmax2 * 1.1f < 100.0f * 100.0f);
#if ATTN_ONEBAR
  if (fast) attn_unit_1b<true>(KV, KR, O, t0, kb0, h, lds, qr); else attn_unit_1b<false>(KV, KR, O, t0, kb0, h, lds, qr);
#else
  if (fast) attn_unit_t<true>(KV, KR, O, t0, kb0, h, lds, qr); else attn_unit_t<false>(KV, KR, O, t0, kb0, h, lds, qr);
#endif
}
#undef KSWZ
#undef SBAR
}

struct Args { const float* in[24]; float* out; unsigned char* ws; int p_lo, p_hi; };
enum { I_X = 0, I_C, I_POS, I_WMOD, I_BMOD, I_N1G, I_WIN, I_BGATE, I_QNG, I_WUQ, I_KVNG, I_WUKV, I_WOA, I_WPOOL, I_PSCALE, I_CONVW, I_WOC, I_WOUT, I_N2G, I_WROUTER, I_WGATE, I_WUP, I_WDOWN, I_FINALG };

__device__ __forceinline__ void conv_item(const float* src, int ldsrc, int c0, bf16* dst, int ldd, int dk0, int nblk, int pm, const float* scale, LAS float* scr, int item, int lane, const float* nscale = nullptr) {
    const int kb = item / nblk, nb = item % nblk, k0 = 64 * kb, n0 = 32 * nb;
    float lv[32];
#pragma unroll
    for (int i = 0; i < 32; ++i) { const int kk = 2 * i + (lane >> 5); lv[i] = src[(size_t)(k0 + kk) * ldsrc + c0 + n0 + (lane & 31)]; }
    const float ns = nscale ? nscale[n0 + (lane & 31)] : 1.0f;
#pragma unroll
    for (int i = 0; i < 32; ++i) { const int kk = 2 * i + (lane >> 5); float v = lv[i] * ns; if (scale) v *= scale[k0 + kk]; scr[kk * 33 + (lane & 31)] = v; }
    LDS_WAIT(); asm volatile("" ::: "memory");
    const bool perm = (pm == 1) || (pm == 2 && (nb % 3) == 2);
    const int c = lane & 7;
#pragma unroll
    for (int j = 0; j < 4; ++j) { const int n = (lane >> 3) + 8 * j; const int q = n >> 3, r = n & 7; const int sn = perm ? ((r < 4) ? 4 * q + r : 16 + 4 * q + (r - 4)) : n;
        const LAS float* s = scr + (8 * c) * 33 + sn;
        v4u o; o.x = pk2(s[0 * 33], s[1 * 33]); o.y = pk2(s[2 * 33], s[3 * 33]); o.z = pk2(s[4 * 33], s[5 * 33]); o.w = pk2(s[6 * 33], s[7 * 33]);
        *(v4u*)(dst + (size_t)(n0 + n) * ldd + dk0 + k0 + 8 * c) = o; }
    LDS_WAIT(); asm volatile("" ::: "memory");
}
#define SEG(src, ldsrc, c0, K, dst, ldd, dk0, rows, pm, scale) do { const int nblk_ = (rows) / 32, nit_ = ((K) / 64) * nblk_; \
    for (int it_ = (gw + NGW - rot) % NGW; it_ < nit_; it_ += NGW) conv_item(src, ldsrc, c0, dst, ldd, dk0, nblk_, pm, scale, scr, it_, lane); rot = (rot + nit_) % NGW; } while (0)

constexpr int MOE_GU_ITEMS = 16 * (NE * 2048 / 32), MOE_DN_ITEMS = 16 * (NE * 1024 / 32), MOE_ITEMS = MOE_GU_ITEMS + MOE_DN_ITEMS;
#ifndef CONV_SLOT_A
#define CONV_SLOT_A 7168
#endif
#ifndef CONV_SLOT_C
#define CONV_SLOT_C 2560
#endif
#ifndef CONV_SLOT_B
#define CONV_SLOT_B 6144
#endif
__device__ __forceinline__ void conv_moe_item(const Args& a, unsigned char* wl, int l, int idx, LAS float* scr, int lane) {
    if (idx < MOE_GU_ITEMS) { const int it = idx, kb = it / (NE * 64), nb = it % (NE * 64), e = nb >> 6, rb = nb & 63, pn = rb >> 3, half = (rb >> 2) & 1, sub = rb & 3;
        const float* src = (half ? a.in[I_WUP] : a.in[I_WGATE]) + ((size_t)l * NE + e) * D * FF;
        conv_item(src, FF, 128 * pn + 32 * sub, (bf16*)(wl + WO_GU) + ((size_t)e * 2048 + rb * 32) * D, D, 0, 1, 0, nullptr, scr, kb, lane); }
    else { const int it = idx - MOE_GU_ITEMS, kb = it / (NE * 32), nb = it % (NE * 32), e = nb >> 5, rb = nb & 31;
        conv_item(a.in[I_WDOWN] + ((size_t)l * NE + e) * FF * D, D, 32 * rb, (bf16*)(wl + WO_DN) + ((size_t)e * 1024 + rb * 32) * FF, FF, 0, 1, 0, nullptr, scr, kb, lane); }
}
struct ConvDesc { const float* src; bf16* dst; int ldsrc, ldd; };
__device__ __forceinline__ ConvDesc moe_desc(const Args& a, unsigned char* wl, int l, int idx) {
    ConvDesc d;
    if (idx < MOE_GU_ITEMS) { const int it = idx, kb = it / (NE * 64), nb = it % (NE * 64), e = nb >> 6, rb = nb & 63, pn = rb >> 3, half = (rb >> 2) & 1, sub = rb & 3;
        d.src = (half ? a.in[I_WUP] : a.in[I_WGATE]) + ((size_t)l * NE + e) * D * FF + (size_t)(64 * kb) * FF + 128 * pn + 32 * sub; d.ldsrc = FF;
        d.dst = (bf16*)(wl + WO_GU) + ((size_t)e * 2048 + rb * 32) * D + 64 * kb; d.ldd = D; }
    else { const int it = idx - MOE_GU_ITEMS, kb = it / (NE * 32), nb = it % (NE * 32), e = nb >> 5, rb = nb & 31;
        d.src = a.in[I_WDOWN] + ((size_t)l * NE + e) * FF * D + (size_t)(64 * kb) * D + 32 * rb; d.ldsrc = D;
        d.dst = (bf16*)(wl + WO_DN) + ((size_t)e * 1024 + rb * 32) * FF + 64 * kb; d.ldd = FF; }
    return d;
}
__device__ __forceinline__ void conv_load(const ConvDesc& d, float (&lv)[32], int lane) {
#pragma unroll
    for (int i = 0; i < 32; ++i) { const int kk = 2 * i + (lane >> 5); lv[i] = __builtin_nontemporal_load(d.src + (size_t)kk * d.ldsrc + (lane & 31)); }
}
__device__ __forceinline__ void conv_fin(const ConvDesc& d, const float (&lv)[32], LAS float* scr, int lane) {
#pragma unroll
    for (int i = 0; i < 32; ++i) { const int kk = 2 * i + (lane >> 5); scr[kk * 33 + (lane & 31)] = lv[i]; }
    LDS_WAIT(); asm volatile("" ::: "memory");
    const int c = lane & 7;
#pragma unroll
    for (int j = 0; j < 4; ++j) { const int n = (lane >> 3) + 8 * j; const LAS float* s = scr + (8 * c) * 33 + n;
        v4u o; o.x = pk2(s[0 * 33], s[1 * 33]); o.y = pk2(s[2 * 33], s[3 * 33]); o.z = pk2(s[4 * 33], s[5 * 33]); o.w = pk2(s[6 * 33], s[7 * 33]);
        __builtin_nontemporal_store(o, (v4u*)(d.dst + (size_t)n * d.ldd + 8 * c)); }
    LDS_WAIT(); asm volatile("" ::: "memory");
}
__device__ __forceinline__ void conv_moe_range(const Args& a, LAS unsigned char* lds, int l, int first, int count, int wg, int nwg) {
    const int tid = otid(), lane = tid & 63, wave = tid >> 6;
    LAS float* scr = (LAS float*)(lds + wave * 16384);
    unsigned char* ws = opaque(a.ws); unsigned char* wl = ws + WS_W + (size_t)l * WL_BYTES;
    const int stride = nwg * NWAVES; int i = wg * NWAVES + wave;
    if (i >= count) return;
    ConvDesc dc = moe_desc(a, wl, l, first + i); float lc[32]; conv_load(dc, lc, lane);
#pragma unroll 1
    for (;;) { const int in = i + stride; const bool more = in < count;
        ConvDesc dn = dc; float ln[32];
#pragma unroll
        for (int k = 0; k < 32; ++k) ln[k] = 0.f;
        if (more) { dn = moe_desc(a, wl, l, first + in); conv_load(dn, ln, lane); }
        conv_fin(dc, lc, scr, lane);
        if (!more) break;
        dc = dn; i = in;
#pragma unroll
        for (int k = 0; k < 32; ++k) lc[k] = ln[k]; }
}

constexpr int NONMOE_ITEMS = 192 + 16 + 128 + 2560 + 144 + 128 + 256 + 64 + 256 + 512;
__device__ __forceinline__ void nonmoe_item(const Args& a, unsigned char* ws, int l, int idx, LAS float* scr, int lane) {
    unsigned char* wl = ws + WS_W + (size_t)l * WL_BYTES;
    const float* win = a.in[I_WIN] + (size_t)l * D * NIN_SRC; bf16* WIN = (bf16*)(wl + WO_IN);
    const float* src; int ldsrc, c0, ldd, dk0 = 0, nblk, pm = 0, item; bf16* dst; const float* scale = nullptr; const float* nsc = nullptr;
    if (idx < 192)       { src = win; ldsrc = NIN_SRC; c0 = 0;   dst = WIN; ldd = D; nblk = 12; item = idx; }
    else if (idx < 208)  { src = win; ldsrc = NIN_SRC; c0 = 640; dst = WIN + (size_t)384 * D; ldd = D; nblk = 1; pm = 1; item = idx - 192; }
    else if (idx < 336)  { src = win; ldsrc = NIN_SRC; c0 = 384; dst = WIN + (size_t)512 * D; ldd = D; nblk = 8; item = idx - 208; }
    else if (idx < 2896) { src = win; ldsrc = NIN_SRC; c0 = 672; dst = WIN + (size_t)768 * D; ldd = D; nblk = 160; item = idx - 336; }
    else if (idx < 3040) { src = a.in[I_WUQ] + (size_t)l * QR * 768; ldsrc = 768; c0 = 0; dst = (bf16*)(wl + WO_UQ); ldd = QR; nblk = 24; pm = 2; scale = a.in[I_QNG] + l * QR; item = idx - 2896; }
    else if (idx < 3168) { src = a.in[I_WUKV] + (size_t)l * KVR * 1024; ldsrc = 1024; c0 = 0; dst = (bf16*)(wl + WO_UKV); ldd = KVR; nblk = 32; scale = a.in[I_KVNG] + l * KVR; item = idx - 3040; }
    else if (idx < 3424) { src = a.in[I_WOA] + (size_t)l * 512 * D; ldsrc = D; c0 = 0; dst = (bf16*)(wl + WO_OA); ldd = 512; nblk = 32; item = idx - 3168; }
    else if (idx < 3488) { const int g = (idx - 3424) >> 4; src = a.in[I_WPOOL] + ((size_t)l * 4 + g) * 128 * 256; ldsrc = 256; c0 = 0; dst = (bf16*)(wl + WO_POOL) + (size_t)(g * 256) * 512; ldd = 512; dk0 = g * 128; nblk = 8;
                           nsc = MERGE_FUSED ? a.in[I_PSCALE] + (size_t)l * D + g * 256 : (const float*)nullptr; item = (idx - 3424) & 15; }
    else if (idx < 3744) { src = a.in[I_WOC] + (size_t)l * 512 * D; ldsrc = D; c0 = 0; dst = (bf16*)(wl + WO_OC); ldd = 512; nblk = 32; item = idx - 3488; }
    else                 { src = a.in[I_WOUT] + (size_t)l * D * D; ldsrc = D; c0 = 0; dst = (bf16*)(wl + WO_OUT); ldd = D; nblk = 32; item = idx - 3744; }
    conv_item(src, ldsrc, c0, dst, ldd, dk0, nblk, pm, scale, scr, item, lane, nsc);
}
constexpr int NQ = 7, CW_Q = 8192;
__device__ __forceinline__ int q_count(int q, int G) { return (q & 1) ? NONMOE_ITEMS : MOE_ITEMS - ((G == 256) ? CONV_SLOT_A + CONV_SLOT_C + CONV_SLOT_B : 0); }
__device__ __forceinline__ bool conv_steal(const Args& a, LAS unsigned char* lds, volatile LAS unsigned* mw, int& qcur, int qmax, int G) {
    const int tid = otid(), lane = tid & 63, wave = tid >> 6;
    unsigned char* ws = opaque(a.ws); unsigned* ctl = (unsigned*)(ws + WS_CTL);
    while (qcur < qmax) {
        const int cnt = q_count(qcur, G);
        if (threadIdx.x == 0) mw[3] = __hip_atomic_fetch_add(ctl + CW_Q + 64 * qcur, 8u, __ATOMIC_RELAXED, __HIP_MEMORY_SCOPE_AGENT);
        __syncthreads();
        const unsigned base = mw[3];
        __syncthreads();
        if (base < (unsigned)cnt) { const int idx = (int)base + wave;
            if (idx < cnt) { LAS float* scr = (LAS float*)(lds + wave * 16384);
                if (qcur & 1) nonmoe_item(a, ws, (qcur + 1) >> 1, idx, scr, lane);
                else { const int l = qcur >> 1; conv_moe_item(a, ws + WS_W + (size_t)l * WL_BYTES, l, MOE_ITEMS - cnt + idx, scr, lane); } }
            return true; }
        ++qcur;
    }
    return false;
}
__device__ __forceinline__ void conv_drain(const Args& a, LAS unsigned char* lds, volatile LAS unsigned* mw, int& qcur, int qmax, int G) { while (conv_steal(a, lds, mw, qcur, qmax, G)) { } __syncthreads(); }

__device__ __forceinline__ void phase_prologue(const Args& a, LAS unsigned char* lds, int vcu, int G) {
    const int tid = otid(), lane = tid & 63, wave = tid >> 6;
    LAS float* scr = (LAS float*)(lds + wave * 16384);
    const int gw = vcu * NWAVES + wave, NGW = G * NWAVES; int rot = 0;
    unsigned char* ws = opaque(a.ws);
    for (int it = gw; it < NONMOE_ITEMS; it += NGW) nonmoe_item(a, ws, 0, it, scr, lane);
    const size_t gt = (size_t)vcu * 512 + tid, ngt = (size_t)G * 512;
    for (size_t i = gt; i < (size_t)NL * 96 * 128; i += ngt) { const int l = (int)(i / (96 * 128)), r = (int)(i % (96 * 128));
        *(v4u*)(ws + WS_W + (size_t)l * WL_BYTES + WO_IN + ((size_t)(416 + r / 128) * D + (r % 128) * 8) * 2) = (v4u){0u, 0u, 0u, 0u}; }
    for (size_t i = gt; i < (size_t)NL * 1024 * 64; i += ngt) { const int l = (int)(i / (1024 * 64)), r = (int)(i % (1024 * 64)), n = r >> 6, ch = r & 63;
        if ((ch >> 4) != (n >> 8)) *(v4u*)(ws + WS_W + (size_t)l * WL_BYTES + WO_POOL + ((size_t)n * 512 + ch * 8) * 2) = (v4u){0u, 0u, 0u, 0u}; }
    { float* COS = (float*)(ws + WS_COS); float* SIN = (float*)(ws + WS_SIN); const int* pos = (const int*)a.in[I_POS];
      for (size_t i = gt; i < (size_t)T * 16; i += ngt) { const int t = (int)(i >> 4), j = (int)(i & 15);
          const float freq = (float)pow(10000.0, -(double)(2 * j) / 32.0); const float ang = (float)pos[t] * freq;
          COS[i] = (float)cos((double)ang); SIN[i] = (float)sin((double)ang); } }
    __syncthreads();
    { LAS float* cact = (LAS float*)lds;
      LAS float* red = (LAS float*)(lds + 16384);
      for (int i = tid; i < NB * D; i += 512) { const float c = a.in[I_C][i]; cact[i] = c / (1.0f + __expf(-c)); }
      __syncthreads();
      for (int cb = blockIdx.x; cb < 256; cb += G) { const int l = cb >> 6, n0 = (cb & 63) * 96;
          const float* wm = a.in[I_WMOD] + (size_t)l * D * 6144 + n0;
          float acc0[4] = {0.f, 0.f, 0.f, 0.f}, acc1[4] = {0.f, 0.f, 0.f, 0.f};
          for (int k0 = wave * 128; k0 < wave * 128 + 128; k0 += 8) { float w0[8], w1[8];
#pragma unroll
              for (int kk = 0; kk < 8; ++kk) { w0[kk] = wm[(size_t)(k0 + kk) * 6144 + lane]; w1[kk] = lane < 32 ? wm[(size_t)(k0 + kk) * 6144 + 64 + lane] : 0.f; }
#pragma unroll
              for (int kk = 0; kk < 8; ++kk)
#pragma unroll
                  for (int b = 0; b < 4; ++b) { const float c = cact[b * D + k0 + kk]; acc0[b] += c * w0[kk]; acc1[b] += c * w1[kk]; } }
#pragma unroll
          for (int b = 0; b < 4; ++b) { red[(wave * 4 + b) * 96 + lane] = acc0[b]; if (lane < 32) red[(wave * 4 + b) * 96 + 64 + lane] = acc1[b]; }
          __syncthreads();
          if (tid < 384) { const int b = tid / 96, n = tid % 96; float s = a.in[I_BMOD][l * 6144 + n0 + n];
#pragma unroll
              for (int w = 0; w < 8; ++w) s += red[(w * 4 + b) * 96 + n];
              ((float*)(ws + WS_MOD))[((size_t)l * NB + b) * 6144 + n0 + n] = s; }
          __syncthreads(); } }
}
#undef SEG

__device__ __forceinline__ void phase_norm1(const Args& a, int l, int vcu, int G) {
    const int tid = otid(), lane = tid & 63, wave = tid >> 6;
    unsigned char* ws = opaque(a.ws);
    float* X = (float*)(ws + WS_X); bf16* H = (bf16*)(ws + WS_H); const bf16* Y = (const bf16*)(ws + WS_Y); const int* SLOT = (const int*)(ws + WS_SLOT); const float* AFF = (const float*)(ws + WS_AFF);
    const float* MOD = (const float*)(ws + WS_MOD);
    if (l < NL && blockIdx.x == 0 && tid < 128) __hip_atomic_store((unsigned*)(ws + WS_KMAX) + tid, 0u, __ATOMIC_RELAXED, __HIP_MEMORY_SCOPE_AGENT);
    const float* xsrc = (l == 0 ? a.in[I_X] : X);
    const int rpw = (T + G * NWAVES - 1) / (G * NWAVES);
    int t = (vcu * NWAVES + wave) * rpw; const int tend = min(t + rpw, T);
    f32x4 vn[4]; int svn = -1; float tvn = 0.f;
    f32x4 g2v[4], gg[4], s1v[4], h1v[4]; int bcur = -1;
    { const float* g = (l < NL) ? a.in[I_N1G] + l * D : a.in[I_FINALG];
#pragma unroll
      for (int j = 0; j < 4; ++j) gg[j] = ((const f32x4*)g)[lane + 64 * j]; }
    if (t < tend) {
#pragma unroll
        for (int j = 0; j < 4; ++j) vn[j] = ((const f32x4*)(xsrc + (size_t)t * D))[lane + 64 * j];
        if (l > 0 && lane < NE) { svn = SLOT[((t / S) * NE + lane) * S + t % S]; tvn = AFF[((t / S) * NE + lane) * S + t % S]; } }
    for (; t < tend; ++t) {
        const int b = t / S;
        f32x4 v[4]; const int sv = svn; const float tv = tvn;
#pragma unroll
        for (int j = 0; j < 4; ++j) v[j] = vn[j];
        unsigned long long mask = (l > 0) ? __ballot(sv >= 0) : 0ull;
        const bool any = mask != 0; bool two = false; v2u w0[4], w1[4]; float tv0 = 0.f, tv1 = 0.f;
        if (any) { const int e0 = __builtin_ctzll(mask); mask &= mask - 1; two = mask != 0; const int e1 = two ? __builtin_ctzll(mask) : e0; if (two) mask &= mask - 1;
            const int s0 = __shfl(sv, e0), s1 = __shfl(sv, e1); tv0 = __shfl(tv, e0); tv1 = __shfl(tv, e1);
            const bf16* y0 = Y + ((size_t)((b * NE + e0) * CAP + s0)) * D; const bf16* y1 = Y + ((size_t)((b * NE + e1) * CAP + s1)) * D;
#pragma unroll
            for (int j = 0; j < 4; ++j) { w0[j] = ((const v2u*)y0)[lane + 64 * j]; w1[j] = ((const v2u*)y1)[lane + 64 * j]; } }
        if (b != bcur) { bcur = b; const float* g2 = MOD + ((size_t)(l > 0 ? l - 1 : 0) * NB + b) * 6144 + 5 * D;
          const float* sh = MOD + ((size_t)(l < NL ? l : 0) * NB + b) * 6144; const float* sc = sh + D;
#pragma unroll
          for (int j = 0; j < 4; ++j) { g2v[j] = ((const f32x4*)g2)[lane + 64 * j]; s1v[j] = ((const f32x4*)sc)[lane + 64 * j] + 1.0f; h1v[j] = ((const f32x4*)sh)[lane + 64 * j]; } }
        asm volatile("" ::: "memory");
        if (t + 1 < tend) { const int tn = t + 1;
#pragma unroll
            for (int j = 0; j < 4; ++j) vn[j] = ((const f32x4*)(xsrc + (size_t)tn * D))[lane + 64 * j];
            if (l > 0 && lane < NE) { svn = SLOT[((tn / S) * NE + lane) * S + tn % S]; tvn = AFF[((tn / S) * NE + lane) * S + tn % S]; } }
        asm volatile("" ::: "memory");
        if (l > 0) {
            f32x4 acc[4];
#pragma unroll
            for (int j = 0; j < 4; ++j) acc[j] = (f32x4){0.f, 0.f, 0.f, 0.f};
            if (any) {
#pragma unroll
                for (int j = 0; j < 4; ++j) { acc[j] += (f32x4){bflo(w0[j].x), bfhi(w0[j].x), bflo(w0[j].y), bfhi(w0[j].y)} * tv0;
                    if (two) acc[j] += (f32x4){bflo(w1[j].x), bfhi(w1[j].x), bflo(w1[j].y), bfhi(w1[j].y)} * tv1; } }
            while (mask) {
                const int e0 = __builtin_ctzll(mask); mask &= mask - 1; const int s0 = __shfl(sv, e0); const float tve = __shfl(tv, e0);
                const bf16* y0 = Y + ((size_t)((b * NE + e0) * CAP + s0)) * D;
#pragma unroll
                for (int j = 0; j < 4; ++j) { const v2u w = ((const v2u*)y0)[lane + 64 * j]; acc[j] += (f32x4){bflo(w.x), bfhi(w.x), bflo(w.y), bfhi(w.y)} * tve; } }
#pragma unroll
            for (int j = 0; j < 4; ++j) v[j] += g2v[j] * acc[j];
            if (l < NL) {
#pragma unroll
                for (int j = 0; j < 4; ++j) ((f32x4*)(X + (size_t)t * D))[lane + 64 * j] = v[j]; }
        }
        float ssq = 0.f;
#pragma unroll
        for (int j = 0; j < 4; ++j) ssq += (v[j][0] * v[j][0] + v[j][1] * v[j][1]) + (v[j][2] * v[j][2] + v[j][3] * v[j][3]);
        const float rstd = 1.0f / sqrtf(wave_sum(ssq) * (1.0f / D) + EPS);
        if (l < NL) {
#pragma unroll
            for (int j = 0; j < 4; ++j) { const f32x4 o = v[j] * rstd * gg[j] * s1v[j] + h1v[j];
                ((v2u*)(H + (size_t)t * D))[lane + 64 * j] = (v2u){pk2(o[0], o[1]), pk2(o[2], o[3])}; }
        } else {
#pragma unroll
            for (int j = 0; j < 4; ++j) ((f32x4*)(a.out + (size_t)t * D))[lane + 64 * j] = v[j] * rstd * gg[j];
        }
    }
}

__device__ __forceinline__ void st8(bf16* p, const f32x4& x0, const f32x4& x1) { *(v4u*)p = pack8(x0, x1); }
__device__ __forceinline__ float ssq8(const f32x4& x0, const f32x4& x1) { return (x0[0] * x0[0] + x0[1] * x0[1]) + (x0[2] * x0[2] + x0[3] * x0[3]) + (x1[0] * x1[0] + x1[1] * x1[1]) + (x1[2] * x1[2] + x1[3] * x1[3]); }
__device__ __forceinline__ void row_part(float* p, float s) { s += __shfl_xor(s, 16); s += __shfl_xor(s, 32); if ((otid() & 63) < 16) *p = s; }
__device__ __forceinline__ void row_max_atomic(unsigned* p, float s) { if (!KMAX_ATOMICS) return; s += __shfl_xor(s, 16); s += __shfl_xor(s, 32); s = fmaxf(s, __shfl_xor(s, 1)); s = fmaxf(s, __shfl_xor(s, 2)); s = fmaxf(s, __shfl_xor(s, 4)); s = fmaxf(s, __shfl_xor(s, 8));
    if (KMAX_ATOMICS && (otid() & 63) == 0) atomicMax(p, __float_as_uint(s)); }
__device__ __forceinline__ void rope8(f32x4& x1, f32x4& x2, const float* cs, const float* sn, int qi) {
    const f32x4 c = *(const f32x4*)(cs + 4 * qi), s = *(const f32x4*)(sn + 4 * qi);
    const f32x4 o1 = x1 * c - x2 * s, o2 = x1 * s + x2 * c; x1 = o1; x2 = o2;
}
struct KCarry { float a = 0.f, b = 0.f; };
struct FProj { static constexpr bool IDEMPOTENT = true;
    bf16 *CQ, *CKV, *KR, *U, *CV, *GT; float* PART; const float *COS, *SIN; const LAS float* bgate; unsigned* KMAX;
    typedef KCarry Carry;
    struct L { f32x4 x0, x1, x2, x3; };
    __device__ __forceinline__ L pre(const pg8::Unit& u, int row, int col) const { L r; const f32x4 z = {0.f, 0.f, 0.f, 0.f}; r.x0 = z; r.x1 = z; r.x2 = z; r.x3 = z;
        if (u.pn >= 11) { const int c = col - 2816; r.x0 = *(const LAS f32x4*)(bgate + c); r.x1 = *(const LAS f32x4*)(bgate + c + 4); r.x2 = *(const LAS f32x4*)(bgate + c + 128); r.x3 = *(const LAS f32x4*)(bgate + c + 132); }
        else if (u.pn == 1 && col + 128 < 416) { const int qi = (col + 128 - 384) >> 3; r.x0 = *(const f32x4*)(COS + (size_t)row * 16 + 4 * qi); r.x1 = *(const f32x4*)(SIN + (size_t)row * 16 + 4 * qi); }
        return r; }
    __device__ __forceinline__ void post(const pg8::Unit& u, int row, int col, const L& ld, const f32x4& a0, const f32x4& a1, const f32x4& b0, const f32x4& b1, Carry& cy) const {
        const int pn = u.pn;
        if (pn >= 11) { const int c = col - 2816;
            f32x4 x0, x1, y0, y1;
#pragma unroll
            for (int i = 0; i < 4; ++i) { x0[i] = sigmoidf_(a0[i] + ld.x0[i]); x1[i] = sigmoidf_(a1[i] + ld.x1[i]); y0[i] = sigmoidf_(b0[i] + ld.x2[i]); y1[i] = sigmoidf_(b1[i] + ld.x3[i]); }
            st8(GT + (size_t)row * 3072 + c, x0, x1); st8(GT + (size_t)row * 3072 + c + 128, y0, y1);
        } else if (pn >= 5) { st8(CV + (size_t)row * 1536 + (col - 1280), a0, a1); st8(CV + (size_t)row * 1536 + (col - 1280) + 128, b0, b1);
        } else if (pn >= 3) { st8(U + (size_t)row * 512 + (col - 768), a0, a1); st8(U + (size_t)row * 512 + (col - 768) + 128, b0, b1);
        } else if (pn == 2) { st8(CKV + (size_t)row * KVR + (col - 512), a0, a1); st8(CKV + (size_t)row * KVR + (col - 512) + 128, b0, b1);
            row_part(PART + (size_t)row * 16 + 8 + ((col >> 5) & 3), ssq8(a0, a1) + ssq8(b0, b1));
        } else if (pn == 0) { st8(CQ + (size_t)row * QR + col, a0, a1); st8(CQ + (size_t)row * QR + col + 128, b0, b1);
            row_part(PART + (size_t)row * 16 + ((col >> 5) & 3), ssq8(a0, a1) + ssq8(b0, b1));
        } else { st8(CQ + (size_t)row * QR + col, a0, a1); row_part(PART + (size_t)row * 16 + 4 + ((col >> 5) & 3), ssq8(a0, a1));
            const int cb = col + 128;
            if (cb < 416) { const f32x4 o1 = b0 * ld.x0 - b1 * ld.x1, o2 = b0 * ld.x1 + b1 * ld.x0; st8(KR + (size_t)row * 32 + (cb - 384), o1, o2);
                float q = ssq8(b0, b1); q += __shfl_xor(q, 16); q += __shfl_xor(q, 32); cy.a = fmaxf(cy.a, q); }
        }
    }
    __device__ __forceinline__ void finish(const pg8::Unit& u, int wr, int wc, const Carry& cy) const {
        if (u.pn == 1 && wc == 0) { float q = cy.a; q = fmaxf(q, __shfl_xor(q, 1)); q = fmaxf(q, __shfl_xor(q, 2)); q = fmaxf(q, __shfl_xor(q, 4)); q = fmaxf(q, __shfl_xor(q, 8));
            if ((otid() & 63) == 0) ((float*)KMAX)[(((u.pm >> 4) * (NH * 2 + 1)) + NH * 2) * 32 + (u.pm & 15) * 2 + wr] = q; } }
};
struct FQ { static constexpr bool IDEMPOTENT = true;
    bf16* Q; const float *PART, *COS, *SIN;
    typedef NoCarry Carry;
    struct L { f32x4 p0, p1, c, s; };
    __device__ __forceinline__ L pre(const pg8::Unit& u, int row, int col) const { L r; r.p0 = *(const f32x4*)(PART + (size_t)row * 16); r.p1 = *(const f32x4*)(PART + (size_t)row * 16 + 4);
        const int qi = (col & 31) >> 3; r.c = *(const f32x4*)(COS + (size_t)row * 16 + 4 * qi); r.s = *(const f32x4*)(SIN + (size_t)row * 16 + 4 * qi); return r; }
    __device__ __forceinline__ void post(const pg8::Unit& u, int row, int col, const L& ld, const f32x4& a0, const f32x4& a1, const f32x4& b0, const f32x4& b1, Carry& cy) const {
        const float rstd = 1.0f / sqrtf((((ld.p0[0] + ld.p0[1]) + (ld.p0[2] + ld.p0[3])) + ((ld.p1[0] + ld.p1[1]) + (ld.p1[2] + ld.p1[3]))) * (1.0f / QR) + EPS);
        const float rq = rstd * QSCALE;
        f32x4 x0 = a0 * rq, x1 = a1 * rq, y0 = b0 * rq, y1 = b1 * rq;
        const int ga = col >> 5, gb = ga + 4;
        if (ga % 3 == 2) { const f32x4 o1 = x0 * ld.c - x1 * ld.s, o2 = x0 * ld.s + x1 * ld.c; x0 = o1; x1 = o2; }
        if (gb % 3 == 2) { const f32x4 o1 = y0 * ld.c - y1 * ld.s, o2 = y0 * ld.s + y1 * ld.c; y0 = o1; y1 = o2; }
        st8(Q + (size_t)row * 768 + col, x0, x1); st8(Q + (size_t)row * 768 + col + 128, y0, y1);
    }
    __device__ __forceinline__ void finish(const pg8::Unit&, int, int, const Carry&) const {}
};
struct FKV { static constexpr bool IDEMPOTENT = true;
    bf16* KV; const float* PART; unsigned* KMAX;
    typedef KCarry Carry;
    struct L { f32x4 p0; };
    __device__ __forceinline__ L pre(const pg8::Unit& u, int row, int col) const { L r; r.p0 = *(const f32x4*)(PART + (size_t)row * 16 + 8); return r; }
    __device__ __forceinline__ void post(const pg8::Unit& u, int row, int col, const L& ld, const f32x4& a0, const f32x4& a1, const f32x4& b0, const f32x4& b1, Carry& cy) const {
        const float rstd = 1.0f / sqrtf(((ld.p0[0] + ld.p0[1]) + (ld.p0[2] + ld.p0[3])) * (1.0f / KVR) + EPS);
        st8(KV + (size_t)row * 1024 + col, a0 * rstd, a1 * rstd); st8(KV + (size_t)row * 1024 + col + 128, b0 * rstd, b1 * rstd);
        const int wc = (col >> 5) & 7;
        if (wc < 2) { float qa = ssq8(a0, a1) * rstd * rstd, qb = ssq8(b0, b1) * rstd * rstd; qa += __shfl_xor(qa, 16); qa += __shfl_xor(qa, 32); qb += __shfl_xor(qb, 16); qb += __shfl_xor(qb, 32);
            cy.a = fmaxf(cy.a, qa); cy.b = fmaxf(cy.b, qb); }
    }
    __device__ __forceinline__ void finish(const pg8::Unit& u, int wr, int wc, const Carry& cy) const {
        if (wc < 2) { float qa = cy.a, qb = cy.b;
#pragma unroll
            for (int o = 1; o < 16; o <<= 1) { qa = fmaxf(qa, __shfl_xor(qa, o)); qb = fmaxf(qb, __shfl_xor(qb, o)); }
            if ((otid() & 63) == 0) { float* kn = (float*)KMAX + (size_t)(u.pm >> 4) * (NH * 2 + 1) * 32; const int sl = (u.pm & 15) * 2 + wr;
                kn[((u.pn * 2) * 2 + wc) * 32 + sl] = qa; kn[((u.pn * 2 + 1) * 2 + wc) * 32 + sl] = qb; } } }
};
template <int MODE> struct FMerge { static constexpr bool IDEMPOTENT = false;
    bf16* MG; const bf16* GT; const float* ps;
    static constexpr int goff = MODE == 0 ? 0 : (MODE == 1 ? 2048 : 1024);
    typedef NoCarry Carry;
    struct L { v4u ga, gb, ma, mb; };
    __device__ __forceinline__ L pre(const pg8::Unit& u, int row, int col) const { L r; r.ga = *(const v4u*)(GT + (size_t)row * 3072 + goff + col); r.gb = *(const v4u*)(GT + (size_t)row * 3072 + goff + col + 128);
        if (MODE != 0) { r.ma = *(const v4u*)(MG + (size_t)row * D + col); r.mb = *(const v4u*)(MG + (size_t)row * D + col + 128); } else { r.ma = r.ga; r.mb = r.gb; }
        return r; }
    __device__ __forceinline__ void one(int row, int c, const v4u& gw, const v4u& mw, const f32x4& v0, const f32x4& v1) const {
        f32x4 g0, g1; unpack8(gw, g0, g1);
        f32x4 r0 = g0 * v0, r1 = g1 * v1;
        if (MODE == 2) { r0 = r0 * *(const f32x4*)(ps + c); r1 = r1 * *(const f32x4*)(ps + c + 4); }
        if (MODE != 0) { f32x4 m0, m1; unpack8(mw, m0, m1); r0 += m0; r1 += m1; }
        st8(MG + (size_t)row * D + c, r0, r1);
    }
    __device__ __forceinline__ void post(const pg8::Unit& u, int row, int col, const L& ld, const f32x4& a0, const f32x4& a1, const f32x4& b0, const f32x4& b1, Carry& cy) const { one(row, col, ld.ga, ld.ma, a0, a1); one(row, col + 128, ld.gb, ld.mb, b0, b1); }
    __device__ __forceinline__ void finish(const pg8::Unit&, int, int, const Carry&) const {}
};
struct FOut { static constexpr bool IDEMPOTENT = false;
    const float* xin; float* X; const float* g1;
    typedef NoCarry Carry;
    struct L { f32x4 x0, x1, x2, x3; };
    __device__ __forceinline__ L pre(const pg8::Unit& u, int row, int col) const { L r; const float* xi = xin + (size_t)row * D + col;
        r.x0 = *(const f32x4*)xi; r.x1 = *(const f32x4*)(xi + 4); r.x2 = *(const f32x4*)(xi + 128); r.x3 = *(const f32x4*)(xi + 132); return r; }
    __device__ __forceinline__ void post(const pg8::Unit& u, int row, int col, const L& ld, const f32x4& a0, const f32x4& a1, const f32x4& b0, const f32x4& b1, Carry& cy) const {
        const float* g = g1 + (size_t)(row / S) * 6144 + col; float* xo = X + (size_t)row * D + col;
        *(f32x4*)xo = ld.x0 + *(const f32x4*)g * a0; *(f32x4*)(xo + 4) = ld.x1 + *(const f32x4*)(g + 4) * a1;
        *(f32x4*)(xo + 128) = ld.x2 + *(const f32x4*)(g + 128) * b0; *(f32x4*)(xo + 132) = ld.x3 + *(const f32x4*)(g + 132) * b1;
    }
    __device__ __forceinline__ void finish(const pg8::Unit&, int, int, const Carry&) const {}
};
struct FGu { static constexpr bool IDEMPOTENT = true;
    bf16* ACT;
    typedef NoCarry Carry;
    struct L { };
    __device__ __forceinline__ L pre(const pg8::Unit& u, int row, int col) const { return L{}; }
    __device__ __forceinline__ void post(const pg8::Unit& u, int row, int col, const L& ld, const f32x4& a0, const f32x4& a1, const f32x4& b0, const f32x4& b1, Carry& cy) const {
        const int oc = (u.pn & 7) * 128 + (col & 255);
        f32x4 r0, r1;
#pragma unroll
        for (int i = 0; i < 4; ++i) { r0[i] = a0[i] * __builtin_amdgcn_rcpf(1.0f + __expf(-a0[i])) * b0[i]; r1[i] = a1[i] * __builtin_amdgcn_rcpf(1.0f + __expf(-a1[i])) * b1[i]; }
        st8(ACT + (size_t)row * FF + oc, r0, r1);
    }
    __device__ __forceinline__ void finish(const pg8::Unit&, int, int, const Carry&) const {}
};
struct FDn { static constexpr bool IDEMPOTENT = true;
    bf16* Y;
    typedef NoCarry Carry;
    struct L { };
    __device__ __forceinline__ L pre(const pg8::Unit& u, int row, int col) const { return L{}; }
    __device__ __forceinline__ void post(const pg8::Unit& u, int row, int col, const L& ld, const f32x4& a0, const f32x4& a1, const f32x4& b0, const f32x4& b1, Carry& cy) const {
        const int oc = (u.pn & 3) * 256 + (col & 255);
        st8(Y + (size_t)row * D + oc, a0, a1); st8(Y + (size_t)row * D + oc + 128, b0, b1);
    }
    __device__ __forceinline__ void finish(const pg8::Unit&, int, int, const Carry&) const {}
};
struct MUnit { int pm, pn, seg; };
struct MergeSched {
    typedef MUnit U;
    pg8::StaticOrder so; const char *ws, *wl;
    __device__ __forceinline__ bool next(int i, MUnit& u) const { const int tile = i / 3; pg8::Unit t; if (!so.next(tile, t)) return false; u.pm = t.pm; u.pn = t.pn; u.seg = i - 3 * tile; return true; }
    __device__ __forceinline__ const char* baseA(const MUnit& u) const { const size_t off = u.seg == 0 ? WS_O : (u.seg == 1 ? WS_CY : WS_MIX); return ws + off + (size_t)u.pm * (256 * 512 * 2) + (u.seg == 2 ? u.pn * 256 : 0); }
    __device__ __forceinline__ const char* baseB(const MUnit& u) const { const size_t off = u.seg == 0 ? WO_OA : (u.seg == 1 ? WO_OC : WO_POOL); return wl + off + (size_t)u.pn * (256 * 512 * 2) + (u.seg == 2 ? u.pn * 256 : 0); }
    __device__ __forceinline__ int nt(const MUnit& u) const { return u.seg == 2 ? 2 : 8; }
    __device__ __forceinline__ bool keep(const MUnit& u) const { return u.seg != 2; }
    __device__ __forceinline__ void a_ready(const MUnit&) const {}
    __device__ __forceinline__ void done(const MUnit&) const {}
};
struct EMergeFused {
    static constexpr bool PERM = true, AFTER_DRAIN = false; static constexpr int MB = 2;
    bf16* MG; const bf16* GT;
    __device__ __forceinline__ static void ratio8(const v4u& nw, const v4u& dw, f32x4& r0, f32x4& r1) { f32x4 n0, n1, d0, d1; unpack8(nw, n0, n1); unpack8(dw, d0, d1);
#pragma unroll
        for (int i = 0; i < 4; ++i) { r0[i] = n0[i] * __builtin_amdgcn_rcpf(d0[i]); r1[i] = n1[i] * __builtin_amdgcn_rcpf(d1[i]); } }
    __device__ __forceinline__ void operator()(f32x4 (&acc)[2][2][4][2], const MUnit& u, int wr, int wc, int fr, int fq) const {
        const int row0 = u.pm * 256 + wr * 64 + fr, col = u.pn * 256 + wc * 32 + 8 * fq;
        const int noff = u.seg == 0 ? 0 : (u.seg == 1 ? 2048 : 1024), doff = u.seg == 0 ? 2048 : 1024;
#pragma unroll
        for (int g0 = 0; g0 < 8; g0 += MB) {
            v4u na[MB], nb[MB], da[MB], db[MB];
#pragma unroll
            for (int k = 0; k < MB; ++k) { const int ai = (g0 + k) >> 2, m = (g0 + k) & 3; const bf16* gp = GT + (size_t)(row0 + ai * 128 + m * 16) * 3072 + col;
                na[k] = *(const v4u*)(gp + noff); nb[k] = *(const v4u*)(gp + noff + 128);
                if (u.seg != 2) { da[k] = *(const v4u*)(gp + doff); db[k] = *(const v4u*)(gp + doff + 128); } else { da[k] = na[k]; db[k] = nb[k]; } }
#pragma unroll
            for (int k = 0; k < MB; ++k) { const int ai = (g0 + k) >> 2, m = (g0 + k) & 3;
                if (u.seg != 2) { f32x4 r0, r1; ratio8(na[k], da[k], r0, r1); acc[ai][0][m][0] *= r0; acc[ai][0][m][1] *= r1; ratio8(nb[k], db[k], r0, r1); acc[ai][1][m][0] *= r0; acc[ai][1][m][1] *= r1; }
                else { bf16* mp = MG + (size_t)(row0 + ai * 128 + m * 16) * D + col; f32x4 x0, x1; unpack8(na[k], x0, x1); st8(mp, acc[ai][0][m][0] * x0, acc[ai][0][m][1] * x1);
                    unpack8(nb[k], x0, x1); st8(mp + 128, acc[ai][1][m][0] * x0, acc[ai][1][m][1] * x1); } }
            asm volatile("" ::: "memory");
        }
    }
};
struct GuOrder { int G, c;
    __device__ __forceinline__ bool next(int i, pg8::Unit& u) const { const int L = i * G + c; if (L >= 1024) return false;
        const int x = L & 7, j = (L >> 3) & 31, r = L >> 8, sg = r * 8 + x, e = sg >> 1, bh = sg & 1, pmi = j & 3, pnl = j >> 2, b = 2 * bh + (pmi >> 1);
        u.pm = (b * NE + e) * 2 + (pmi & 1); u.pn = e * 8 + pnl; return true; }
    __device__ __forceinline__ void a_ready(const pg8::Unit&) const {}
    __device__ __forceinline__ void done(const pg8::Unit&) const {} };
struct DnOrder { int G, c;
    __device__ __forceinline__ bool next(int i, pg8::Unit& u) const { const int L = i * G + c; if (L >= 512) return false;
        const int x = L & 7, j = (L >> 3) & 31, r = L >> 8, e = r * 8 + x, pmi = j & 7, pnl = j >> 3;
        u.pm = ((pmi >> 1) * NE + e) * 2 + (pmi & 1); u.pn = e * 4 + pnl; return true; }
    __device__ __forceinline__ void a_ready(const pg8::Unit&) const {}
    __device__ __forceinline__ void done(const pg8::Unit&) const {} };

__device__ __forceinline__ void ld8f(const bf16* p, f32x4& x0, f32x4& x1) { unpack8(*(const v4u*)p, x0, x1); }
__device__ __forceinline__ void phase_prep_elem(const Args& a, int l, int vcu, int G) {
    unsigned char* ws = opaque(a.ws);
    const bf16* U = (const bf16*)(ws + WS_U); const bf16* CV = (const bf16*)(ws + WS_CV); bf16* MIX = (bf16*)(ws + WS_MIX); bf16* CY = (bf16*)(ws + WS_CY);
    const float* cw = a.in[I_CONVW] + (size_t)l * 3 * 512;
    const f32x4 z4 = {0.f, 0.f, 0.f, 0.f};
    for (size_t idx = (size_t)vcu * 512 + otid(); idx < (size_t)(T / 16) * 128; idx += (size_t)G * 512) {
        const int t0 = (int)(idx >> 7) * 16, ch = (int)(idx & 127), tt0 = t0 % S;
        if (ch < 64) {
            const int hw = 1 << (ch >> 4);
            const bf16* up = U + (size_t)(t0 - tt0) * 512 + ch * 8;
            f32x4 s0 = z4, s1 = z4;
#pragma unroll
            for (int k = 0; k < 16; ++k) { const int r = tt0 - hw + k; if (k < 2 * hw && r >= 0) { f32x4 x0, x1; ld8f(up + (size_t)r * 512, x0, x1); s0 += x0; s1 += x1; } }
#pragma unroll
            for (int i = 0; i < 16; ++i) { const int tt = tt0 + i;
                f32x4 c0, c1; ld8f(up + (size_t)tt * 512, c0, c1);
                const int lo = max(tt - hw, 0), hi = min(tt + hw - 1, S - 1); const float inv = 1.0f / (float)(hi - lo + 1);
                st8(MIX + (size_t)(t0 + i) * 512 + ch * 8, s0 * inv - c0, s1 * inv - c1);
                f32x4 p0 = z4, p1 = z4, m0 = z4, m1 = z4;
                if (tt + hw < S) ld8f(up + (size_t)(tt + hw) * 512, p0, p1);
                if (tt - hw >= 0) ld8f(up + (size_t)(tt - hw) * 512, m0, m1);
                s0 += p0 - m0; s1 += p1 - m1; }
        } else {
            const int c = (ch - 64) * 8; const bf16* p = CV + (size_t)t0 * 1536 + c;
            const f32x4 w00 = *(const f32x4*)(cw + c), w01 = *(const f32x4*)(cw + c + 4), w10 = *(const f32x4*)(cw + 512 + c), w11 = *(const f32x4*)(cw + 512 + c + 4),
                        w20 = *(const f32x4*)(cw + 1024 + c), w21 = *(const f32x4*)(cw + 1024 + c + 4);
            f32x4 zp0 = z4, zp1 = z4, zc0, zc1;
            if (tt0 > 0) { f32x4 x0, x1, y0, y1; ld8f(p - 1536, x0, x1); ld8f(p - 1536 + 1024, y0, y1); zp0 = x0 * y0; zp1 = x1 * y1; }
            { f32x4 x0, x1, y0, y1; ld8f(p, x0, x1); ld8f(p + 1024, y0, y1); zc0 = x0 * y0; zc1 = x1 * y1; }
#pragma unroll
            for (int i = 0; i < 16; ++i) { const bf16* pi = p + (size_t)i * 1536;
                f32x4 zn0 = z4, zn1 = z4;
                if (tt0 + i + 1 < S) { f32x4 x0, x1, y0, y1; ld8f(pi + 1536, x0, x1); ld8f(pi + 1536 + 1024, y0, y1); zn0 = x0 * y0; zn1 = x1 * y1; }
                f32x4 b0, b1; ld8f(pi + 512, b0, b1);
                st8(CY + (size_t)(t0 + i) * 512 + c, b0 * (w00 * zp0 + w10 * zc0 + w20 * zn0), b1 * (w01 * zp1 + w11 * zc1 + w21 * zn1));
                zp0 = zc0; zp1 = zc1; zc0 = zn0; zc1 = zn1; }
        }
    }
}

__device__ __forceinline__ float reduce16(const float (&p)[16], int lane) {
    float q8[8], q4[4], q2[2];
    { const bool up = lane & 32;
#pragma unroll
      for (int i = 0; i < 8; ++i) { float lo = p[i], hi = p[8 + i]; asm volatile("" : "+v"(lo), "+v"(hi)); const float keep = up ? hi : lo, send = up ? lo : hi; q8[i] = keep + __shfl_xor(send, 32); } }
    { const bool up = lane & 16;
#pragma unroll
      for (int i = 0; i < 4; ++i) { float lo = q8[i], hi = q8[4 + i]; asm volatile("" : "+v"(lo), "+v"(hi)); const float keep = up ? hi : lo, send = up ? lo : hi; q4[i] = keep + __shfl_xor(send, 16); } }
    { const bool up = lane & 8;
#pragma unroll
      for (int i = 0; i < 2; ++i) { float lo = q4[i], hi = q4[2 + i]; asm volatile("" : "+v"(lo), "+v"(hi)); const float keep = up ? hi : lo, send = up ? lo : hi; q2[i] = keep + __shfl_xor(send, 8); } }
    float lo = q2[0], hi = q2[1]; asm volatile("" : "+v"(lo), "+v"(hi));
    const bool up = lane & 4; const float keep = up ? hi : lo, send = up ? lo : hi;
    float q = keep + __shfl_xor(send, 4); q += __shfl_xor(q, 2); q += __shfl_xor(q, 1); return q;
}
__device__ __forceinline__ void phase_norm2(const Args& a, int l, LAS unsigned char* lds, int vcu, int G) {
    const int tid = otid(), lane = tid & 63, wave = tid >> 6;
    unsigned char* ws = opaque(a.ws);
    const float* X = (const float*)(ws + WS_X); bf16* H = (bf16*)(ws + WS_H); float* AFF = (float*)(ws + WS_AFF); const float* MOD = (const float*)(ws + WS_MOD);
    LAS float* wl = (LAS float*)lds;
    const float* wr = a.in[I_WROUTER] + (size_t)l * D * NE;
    { f32x4 wv[8];
#pragma unroll
      for (int k = 0; k < 8; ++k) wv[k] = ((const f32x4*)wr)[tid + 512 * k];
#pragma unroll
      for (int k = 0; k < 8; ++k) { const int i4 = tid + 512 * k, c = i4 >> 2, e0 = (i4 & 3) * 4;
#pragma unroll
          for (int q = 0; q < 4; ++q) wl[(e0 + q) * D + c] = wv[k][q]; } }
    __syncthreads();
    const float* g = a.in[I_N2G] + l * D;
    const int myexp = ((lane >> 5) & 1) * 8 + ((lane >> 4) & 1) * 4 + ((lane >> 3) & 1) * 2 + ((lane >> 2) & 1);
    const int rpw = (T + G * NWAVES - 1) / (G * NWAVES);
    int t = (vcu * NWAVES + wave) * rpw; const int tend = min(t + rpw, T);
    f32x4 gg[4], s1v[4], h1v[4]; int bcur = -1;
#pragma unroll
    for (int j = 0; j < 4; ++j) gg[j] = ((const f32x4*)g)[lane + 64 * j];
    f32x4 na[4], nb[4];
    if (t < tend) { const int tb = min(t + 1, tend - 1);
#pragma unroll
        for (int j = 0; j < 4; ++j) { na[j] = ((const f32x4*)(X + (size_t)t * D))[lane + 64 * j]; nb[j] = ((const f32x4*)(X + (size_t)tb * D))[lane + 64 * j]; } }
    for (; t < tend; t += 2) {
        const int b = t / S; const int t1 = min(t + 1, tend - 1);
        f32x4 va[4], vb[4];
#pragma unroll
        for (int j = 0; j < 4; ++j) { va[j] = na[j]; vb[j] = nb[j]; }
        if (b != bcur) { bcur = b; const float* sh = MOD + ((size_t)l * NB + b) * 6144 + 3 * D; const float* sc = sh + D;
#pragma unroll
            for (int j = 0; j < 4; ++j) { s1v[j] = ((const f32x4*)sc)[lane + 64 * j] + 1.0f; h1v[j] = ((const f32x4*)sh)[lane + 64 * j]; } }
        asm volatile("" ::: "memory");
        if (t + 2 < tend) { const int ta = t + 2, tb = min(t + 3, tend - 1);
#pragma unroll
            for (int j = 0; j < 4; ++j) { na[j] = ((const f32x4*)(X + (size_t)ta * D))[lane + 64 * j]; nb[j] = ((const f32x4*)(X + (size_t)tb * D))[lane + 64 * j]; } }
        asm volatile("" ::: "memory");
        float sa = 0.f, sb = 0.f;
#pragma unroll
        for (int j = 0; j < 4; ++j) { sa += (va[j][0] * va[j][0] + va[j][1] * va[j][1]) + (va[j][2] * va[j][2] + va[j][3] * va[j][3]); sb += (vb[j][0] * vb[j][0] + vb[j][1] * vb[j][1]) + (vb[j][2] * vb[j][2] + vb[j][3] * vb[j][3]); }
        const float ra = 1.0f / sqrtf(wave_sum(sa) * (1.0f / D) + EPS), rb = 1.0f / sqrtf(wave_sum(sb) * (1.0f / D) + EPS);
#pragma unroll
        for (int j = 0; j < 4; ++j) { va[j] = va[j] * ra * gg[j] * s1v[j] + h1v[j]; vb[j] = vb[j] * rb * gg[j] * s1v[j] + h1v[j];
            ((v2u*)(H + (size_t)t * D))[lane + 64 * j] = (v2u){pk2(va[j][0], va[j][1]), pk2(va[j][2], va[j][3])};
            ((v2u*)(H + (size_t)t1 * D))[lane + 64 * j] = (v2u){pk2(vb[j][0], vb[j][1]), pk2(vb[j][2], vb[j][3])}; }
        float pa[NE], pb[NE];
#pragma unroll
        for (int e = 0; e < NE; ++e) { float xa = 0.f, xb = 0.f;
#pragma unroll
            for (int j = 0; j < 4; ++j) { const f32x4 w = *(const LAS f32x4*)(wl + e * D + 4 * lane + 256 * j);
                xa += (va[j][0] * w[0] + va[j][1] * w[1]) + (va[j][2] * w[2] + va[j][3] * w[3]);
                xb += (vb[j][0] * w[0] + vb[j][1] * w[1]) + (vb[j][2] * w[2] + vb[j][3] * w[3]); }
            pa[e] = xa; pb[e] = xb;
            asm volatile("" : "+v"(pa[e]), "+v"(pb[e]) :: "memory"); }
        { const float lg = reduce16(pa, lane); float mx = lg;
#pragma unroll
          for (int o = 4; o < 64; o <<= 1) mx = fmaxf(mx, __shfl_xor(mx, o));
          const float ex = __expf(lg - mx); float sum = ex;
#pragma unroll
          for (int o = 4; o < 64; o <<= 1) sum += __shfl_xor(sum, o);
          if ((lane & 3) == 0) AFF[((size_t)b * NE + myexp) * S + t % S] = ex / sum; }
        { const float lg = reduce16(pb, lane); float mx = lg;
#pragma unroll
          for (int o = 4; o < 64; o <<= 1) mx = fmaxf(mx, __shfl_xor(mx, o));
          const float ex = __expf(lg - mx); float sum = ex;
#pragma unroll
          for (int o = 4; o < 64; o <<= 1) sum += __shfl_xor(sum, o);
          if ((lane & 3) == 0) AFF[((size_t)b * NE + myexp) * S + t1 % S] = ex / sum; }
    }
    __syncthreads();
}

__device__ __forceinline__ void phase_topk(const Args& a, LAS unsigned char* lds, int G) {
    const int tid = otid(), lane = tid & 63, wave = tid >> 6;
    unsigned char* ws = opaque(a.ws);
    const float* AFF = (const float*)(ws + WS_AFF); int* SLOT = (int*)(ws + WS_SLOT); int* IDXG = (int*)(ws + WS_IDX); const bf16* H = (const bf16*)(ws + WS_H); bf16* XG = (bf16*)(ws + WS_XG);
    LAS unsigned* hist = (LAS unsigned*)lds;
    LAS unsigned* sel = hist + 256;
    LAS unsigned* wtot = sel + 8;
    LAS int* idxl = (LAS int*)(wtot + 8);
    const int npart = GATHER_FUSED ? 1 : ((G % 4 == 0 && G >= 4) ? 4 : 1), part = blockIdx.x % npart;
    for (int pi = blockIdx.x / npart; pi < NB * NE; pi += G / npart) {
        const int b = pi / NE;
        const float* ap = AFF + (size_t)pi * S + tid * 8;
        const f32x4 v0 = *(const f32x4*)ap, v1 = *(const f32x4*)(ap + 4);
        unsigned key[8];
#pragma unroll
        for (int i = 0; i < 4; ++i) { key[i] = __float_as_uint(v0[i]); key[4 + i] = __float_as_uint(v1[i]); }
        unsigned prefix = 0, kk = CAP;
#pragma unroll 1
        for (int pass = 0; pass < 4; ++pass) { const int shift = 24 - 8 * pass;
            if (tid < 256) hist[tid] = 0u;
            __syncthreads();
#pragma unroll
            for (int i = 0; i < 8; ++i) { const bool m = (pass == 0) ? true : ((key[i] >> (shift + 8)) == prefix); if (m) __hip_atomic_fetch_add(&hist[(key[i] >> shift) & 255u], 1u, __ATOMIC_RELAXED, __HIP_MEMORY_SCOPE_WORKGROUP); }
            __syncthreads();
            if (wave == 0) { const unsigned c0 = hist[4 * lane], c1 = hist[4 * lane + 1], c2 = hist[4 * lane + 2], c3 = hist[4 * lane + 3]; const unsigned s = c0 + c1 + c2 + c3;
                unsigned suf = s;
#pragma unroll
                for (int o = 1; o < 64; o <<= 1) { const unsigned tv = __shfl_down(suf, o); if (lane + o < 64) suf += tv; }
                unsigned above = suf - s;
                const unsigned cs[4] = {c3, c2, c1, c0};
#pragma unroll
                for (int q = 0; q < 4; ++q) { if (above < kk && above + cs[q] >= kk) { sel[0] = (unsigned)(4 * lane + 3 - q); sel[1] = kk - above; } above += cs[q]; } }
            __syncthreads();
            prefix = (prefix << 8) | sel[0]; kk = sel[1];
            __syncthreads(); }
        unsigned ngt = 0, neq = 0;
#pragma unroll
        for (int i = 0; i < 8; ++i) { ngt += key[i] > prefix; neq += key[i] == prefix; }
        unsigned pk = ngt | (neq << 16), inc = pk;
#pragma unroll
        for (int o = 1; o < 64; o <<= 1) { const unsigned tv = __shfl_up(inc, o); if (lane >= o) inc += tv; }
        if (lane == 63) wtot[wave] = inc;
        __syncthreads();
        unsigned base = 0;
#pragma unroll
        for (int w = 0; w < 8; ++w) base += (w < wave) ? wtot[w] : 0u;
        const unsigned ex = base + inc - pk; unsigned gtb = ex & 0xffffu, eqb = ex >> 16;
#pragma unroll
        for (int i = 0; i < 8; ++i) { const bool gt = key[i] > prefix, eq = key[i] == prefix; const bool s = gt || (eq && eqb < kk);
            const int slot = (int)(gtb + (eqb < kk ? eqb : kk)); const int tt = tid * 8 + i;
            if (s) idxl[slot] = tt;
            if (part == 0) { SLOT[(size_t)pi * S + tt] = s ? slot : -1; if (s) IDXG[(size_t)pi * CAP + slot] = b * S + tt; }
            gtb += gt; eqb += eq; }
        __syncthreads();
#if !GATHER_FUSED
        const int per = CAP / npart;
        for (int si = wave * 4; si < per; si += NWAVES * 4) {
            v4u r0[4], r1[4];
#pragma unroll
            for (int k = 0; k < 4; ++k) { const int tt = idxl[part * per + si + k]; const v4u* src = (const v4u*)(H + ((size_t)b * S + tt) * D); r0[k] = src[lane]; r1[k] = src[lane + 64]; }
#pragma unroll
            for (int k = 0; k < 4; ++k) { v4u* dst = (v4u*)(XG + ((size_t)pi * CAP + part * per + si + k) * D); dst[lane] = r0[k]; dst[lane + 64] = r1[k]; } }
        __syncthreads();
#else
        (void)H; (void)XG; (void)lane;
#endif
    }
}

#if NAIVE_ATTN
__device__ __forceinline__ void phase_attn(const Args& a, LAS unsigned char* lds, int vcu, int G) {
    const int tid = otid(), lane = tid & 63, wave = tid >> 6;
    unsigned char* ws = opaque(a.ws);
    const bf16* Q = (const bf16*)(ws + WS_Q); const bf16* KV = (const bf16*)(ws + WS_KV); const bf16* KR = (const bf16*)(ws + WS_KR); bf16* O = (bf16*)(ws + WS_O);
    LAS float* pl = (LAS float*)(lds + wave * 16384);
    for (int row = vcu * NWAVES + wave; row < NB * NH * S; row += G * NWAVES) {
        const int b = row / (NH * S), h = (row / S) % NH, q = row % S; const size_t t = (size_t)b * S + q;
        float qf[DQK];
#pragma unroll
        for (int c = 0; c < 12; ++c) { f32x4 x0, x1; unpack8(*(const v4u*)(Q + t * 768 + h * 96 + c * 8), x0, x1);
#pragma unroll
            for (int i = 0; i < 4; ++i) { qf[c * 8 + i] = x0[i]; qf[c * 8 + 4 + i] = x1[i]; } }
        float mx = -1e30f;
        for (int jj = 0; jj < S / 64; ++jj) { const int key = jj * 64 + lane; const size_t kt = (size_t)b * S + key; float s = 0.f;
#pragma unroll
            for (int c = 0; c < 12; ++c) { f32x4 x0, x1; const bf16* kp = (c < 8) ? (KV + kt * 1024 + h * 128 + c * 8) : (KR + kt * 32 + (c - 8) * 8); unpack8(*(const v4u*)kp, x0, x1);
#pragma unroll
                for (int i = 0; i < 4; ++i) { s += qf[c * 8 + i] * x0[i]; s += qf[c * 8 + 4 + i] * x1[i]; } }
            pl[key] = s; mx = fmaxf(mx, s); }
        mx = wave_max(mx);
        float sum = 0.f;
        for (int jj = 0; jj < S / 64; ++jj) { const int key = jj * 64 + lane; const float e = exp2f(pl[key] - mx); pl[key] = e; sum += e; }
        sum = wave_sum(sum);
        LDS_WAIT();
        float o = 0.f; const bf16* vp = KV + (size_t)b * S * 1024 + h * 128 + 64 + lane;
        for (int key = 0; key < S; ++key) o += pl[key] * __uint_as_float((unsigned)vp[(size_t)key * 1024] << 16);
        O[t * 512 + h * 64 + lane] = (bf16)(pk2(o / sum, 0.f) & 0xffffu);
    }
    __syncthreads();
}
#else
__device__ __forceinline__ void phase_attn(const Args& a, LAS unsigned char* lds, int vcu, int G) {
    unsigned char* ws = opaque(a.ws);
    const bf16* Q = (const bf16*)(ws + WS_Q); const bf16* KV = (const bf16*)(ws + WS_KV); const bf16* KR = (const bf16*)(ws + WS_KR); bf16* O = (bf16*)(ws + WS_O);
    for (int i = 0;; ++i) { const int L = i * G + (int)blockIdx.x; if (L >= NB * NH * (S / 256)) break;
        const int x = L & 7, j = (L >> 3) & 31, r = L >> 8, bh = x * 4 + r * 2 + (j >> 4), qb = j & 15, b = bh >> 3, h = bh & 7;
        float kmax2;
        { const float* kn = (const float*)(ws + WS_KMAX) + (size_t)b * (NH * 2 + 1) * 32; const int ln = otid() & 31;
          float m0 = kn[(h * 2) * 32 + ln], m1 = kn[(h * 2 + 1) * 32 + ln], m2 = kn[(NH * 2) * 32 + ln];
#pragma unroll
          for (int o = 1; o < 32; o <<= 1) { m0 = fmaxf(m0, __shfl_xor(m0, o)); m1 = fmaxf(m1, __shfl_xor(m1, o)); m2 = fmaxf(m2, __shfl_xor(m2, o)); }
          kmax2 = m0 + m1 + m2; }
        att::attn_unit(Q, KV, KR, O, (long)b * S + qb * 256, (long)b * S, h, (LAS char*)lds, kmax2); }
}
#endif

#define L1_INV() do { VM_WAIT(); __builtin_amdgcn_fence(__ATOMIC_ACQUIRE, "agent"); VM_WAIT(); __syncthreads(); } while (0)
#define XB_TMO      128
#define XB_XCNT(j)  (256  + 64 * (j))
#define XB_XSUB(j)  (1280 + 64 * (j))
#define XB_XGEN(j)  (2304 + 64 * (j))
#define XB_TOP      3328
#define XB_TOPGEN   3392
#define XCD_BAR_WORDS 3456
#define XB_SPIN_CAP (1u << 20)

__device__ __forceinline__ unsigned xb_ld(unsigned* p)              { return __hip_atomic_load(p, __ATOMIC_RELAXED, __HIP_MEMORY_SCOPE_AGENT); }
__device__ __forceinline__ unsigned xb_add(unsigned* p, unsigned v) { return __hip_atomic_fetch_add(p, v, __ATOMIC_RELAXED, __HIP_MEMORY_SCOPE_AGENT); }
__device__ __forceinline__ unsigned xb_xcc_id() { return (unsigned)__builtin_amdgcn_s_getreg((3 << 11) | 20) & 0xFu; }
#define XB_SPIN(cond, bar) do { unsigned _sp = 0; while (cond) { __builtin_amdgcn_s_sleep(1); \
    if ((++_sp & 255u) == 0u) { if (xb_ld(&(bar)[XB_TMO])) break; if (_sp > XB_SPIN_CAP) { atomicAdd(&(bar)[XB_TMO], 1u); break; } } } } while (0)

struct XcdBarrier {
    unsigned* bar; unsigned x;
    volatile LAS unsigned* st;
};

__device__ __forceinline__ XcdBarrier xcd_barrier_post(unsigned* bar, volatile LAS unsigned* st) {
    XcdBarrier b; b.bar = bar; b.x = xb_xcc_id(); b.st = st;
    if (threadIdx.x == 0) (void)xb_add(&bar[XB_XCNT(b.x)], 1u);
    return b;
}
__device__ __forceinline__ void xcd_barrier_complete(unsigned* bar, unsigned x, unsigned& nloc, unsigned& nx) {
    const unsigned G = gridDim.x * gridDim.y * gridDim.z;
    unsigned sum, cnt, mine, sp = 0u;
    for (;;) {
        sum = 0u; cnt = 0u; mine = 0u;
#pragma unroll
        for (unsigned j = 0; j < 16; ++j) { const unsigned c = xb_ld(&bar[XB_XCNT(j)]); sum += c; cnt += (c > 0u) ? 1u : 0u; mine = (j == x) ? c : mine; }
        if (sum == G) break;
        __builtin_amdgcn_s_sleep(1);
        if ((++sp & 255u) == 0u) { if (xb_ld(&bar[XB_TMO])) break; if (sp > XB_SPIN_CAP) { atomicAdd(&bar[XB_TMO], 1u); break; } }
    }
    nloc = mine > 0u ? mine : 1u; nx = cnt > 0u ? cnt : 1u;
}

__device__ __forceinline__ void xcd_barrier(const XcdBarrier& b) {
    asm volatile("s_waitcnt vmcnt(0)" ::: "memory");
    __syncthreads();
    if (threadIdx.x == 0) {
        unsigned* bar = b.bar;
        __builtin_amdgcn_s_waitcnt(0);
        unsigned nloc = b.st[0], nx = b.st[1];
        if (nloc == 0u) { xcd_barrier_complete(bar, b.x, nloc, nx); b.st[0] = nloc; b.st[1] = nx; }
        const unsigned old = xb_add(&bar[XB_XSUB(b.x)], 1u);
        const unsigned gen = old / nloc;
        if (old + 1u == (gen + 1u) * nloc) {
            __builtin_amdgcn_fence(__ATOMIC_RELEASE, "agent");
            asm volatile("s_waitcnt vmcnt(0)" ::: "memory");
            const unsigned og = xb_add(&bar[XB_TOP], 1u);
            const unsigned tg = og / nx;
            if (og + 1u == (tg + 1u) * nx) xb_add(&bar[XB_TOPGEN], 1u);
            else XB_SPIN(xb_ld(&bar[XB_TOPGEN]) == tg, bar);
            __builtin_amdgcn_fence(__ATOMIC_ACQUIRE, "agent");
            xb_add(&bar[XB_XGEN(b.x)], 1u);
            asm volatile("s_waitcnt vmcnt(0)" ::: "memory");
        } else {
            XB_SPIN(xb_ld(&bar[XB_XGEN(b.x)]) == gen, bar);
            __builtin_amdgcn_fence(__ATOMIC_ACQUIRE, "agent");
            asm volatile("s_waitcnt vmcnt(0)" ::: "memory");
        }
    }
    __syncthreads();
}

template <class Work> __device__ __forceinline__ void xcd_barrier_work(const XcdBarrier& b, volatile LAS unsigned* mw, Work&& work) {
    asm volatile("s_waitcnt vmcnt(0)" ::: "memory");
    __syncthreads();
    if (threadIdx.x == 0) {
        unsigned* bar = b.bar;
        __builtin_amdgcn_s_waitcnt(0);
        unsigned nloc = b.st[0], nx = b.st[1];
        if (nloc == 0u) { xcd_barrier_complete(bar, b.x, nloc, nx); b.st[0] = nloc; b.st[1] = nx; }
        const unsigned old = xb_add(&bar[XB_XSUB(b.x)], 1u);
        const unsigned gen = old / nloc;
        if (old + 1u == (gen + 1u) * nloc) {
            __builtin_amdgcn_fence(__ATOMIC_RELEASE, "agent");
            asm volatile("s_waitcnt vmcnt(0)" ::: "memory");
            const unsigned og = xb_add(&bar[XB_TOP], 1u);
            const unsigned tg = og / nx;
            if (og + 1u == (tg + 1u) * nx) xb_add(&bar[XB_TOPGEN], 1u);
            else XB_SPIN(xb_ld(&bar[XB_TOPGEN]) == tg, bar);
            __builtin_amdgcn_fence(__ATOMIC_ACQUIRE, "agent");
            xb_add(&bar[XB_XGEN(b.x)], 1u);
            asm volatile("s_waitcnt vmcnt(0)" ::: "memory");
            mw[0] = 1u;
        } else { mw[0] = 0u; mw[1] = gen; }
    }
    __syncthreads();
    if (mw[0] == 0u) {
        const unsigned gen = mw[1]; unsigned sp = 0u;
        for (;;) {
            if (threadIdx.x == 0) { unsigned r = (xb_ld(&b.bar[XB_XGEN(b.x)]) != gen) ? 1u : 0u;
                if (!r && ((++sp & 255u) == 0u)) { if (xb_ld(&b.bar[XB_TMO])) r = 1u; else if (sp > XB_SPIN_CAP) { atomicAdd(&b.bar[XB_TMO], 1u); r = 1u; } }
                if (!r && XB_WORK_UNTIL_LOCAL && xb_ld(&b.bar[XB_XSUB(b.x)]) >= (gen + 1u) * b.st[0]) r = 2u;
                mw[2] = r; }
            __syncthreads();
            const unsigned rel = mw[2];
            __syncthreads();
            if (rel == 1u) break;
            if (rel == 2u || !work()) __builtin_amdgcn_s_sleep(1);
        }
        if (threadIdx.x == 0) { __builtin_amdgcn_fence(__ATOMIC_ACQUIRE, "agent"); asm volatile("s_waitcnt vmcnt(0)" ::: "memory"); }
    }
    __syncthreads();
}


__global__ void __launch_bounds__(NWAVES * 64, 2) fwd(Args args) {
    extern __shared__ __attribute__((aligned(16))) unsigned char lds_raw[];
    LAS unsigned char* lds = (LAS unsigned char*)lds_raw;
    volatile LAS unsigned* MISC = (volatile LAS unsigned*)(lds + MISC_OFF);
    const int tid = threadIdx.x;
    const int G = gridDim.x; const int bx = blockIdx.x; const int vcu = (G % 8 == 0) ? (bx % 8) * (G / 8) + bx / 8 : bx;
    if (tid < 32) MISC[tid] = 0u;
    __syncthreads();
    unsigned char* ws0 = args.ws;
    unsigned* ctl = (unsigned*)(ws0 + WS_CTL);
    XcdBarrier bar; bar.bar = ctl + CW_BAR; bar.x = 0; bar.st = nullptr;
#if !MK_PER_PHASE
    bar = xcd_barrier_post(ctl + CW_BAR, MISC + 8);
#endif
    const int lo = args.p_lo, hi = args.p_hi;
    int qcur = 0;
#ifndef EPF
#define EPF 4
#endif
#ifndef PHASE_MASK
#define PHASE_MASK 0xFFF
#endif
#define IN(k) (lo <= (k) && (k) < hi)
#define PM(b) ((PHASE_MASK >> (b)) & 1)
#ifndef REPEAT_MASK
#define REPEAT_MASK 0
#endif
#define NREP(b) (((REPEAT_MASK >> (b)) & 1) ? 2 : 1)
#define REPBAR(b) do { if (rep_ + 1 < NREP(b)) xcd_barrier(bar); } while (0)
#if MK_PER_PHASE
#define SEAM(k) do { } while (0)
#else
#ifndef EXTRA_BARRIERS
#define EXTRA_BARRIERS 0
#endif
#define SEAM(k) do { if (IN(k) && IN((k) + 1)) { xcd_barrier_work(bar, MISC + 16, [&]() { return conv_steal(args, lds, MISC + 16, qcur, NQ, G); }); _Pragma("unroll 1") for (int xb_ = 0; xb_ < EXTRA_BARRIERS; ++xb_) xcd_barrier(bar); } } while (0)
#endif
    if (PM(10) && IN(0)) { _Pragma("unroll 1") for (int rep_ = 0; rep_ < NREP(10); ++rep_) { phase_prologue(args, lds, vcu, G); REPBAR(10); } }
    SEAM(0);
#pragma unroll 1
    for (int l = 0; l < NL; ++l) {
        const int pb = 1 + 10 * l;
        if (PM(0) && IN(pb + 0)) phase_norm1(args, l, vcu, G);
        if (l > 0) conv_drain(args, lds, MISC + 16, qcur, 2 * l, G);
        SEAM(pb + 0);
        if (PM(1) && IN(pb + 1)) { _Pragma("unroll 1") for (int rep_ = 0; rep_ < NREP(1); ++rep_) {
            unsigned char* ws = opaque(args.ws); unsigned char* wl = ws + WS_W + (size_t)l * WL_BYTES;
            { const float* bg = args.in[I_BGATE] + (size_t)l * 3072; for (int i = otid(); i < 768; i += NWAVES * 64) *(LAS f32x4*)(lds + LDS_BIAS + i * 16) = ((const f32x4*)bg)[i]; }
            __syncthreads();
            pg8::Gemm g{(const bf16*)(ws + WS_H), (const bf16*)(wl + WO_IN), T, NIN, D}; pg8::StaticOrder So; So.init(T, NIN, G, bx);
            Epi8<FProj, EPF> E{FProj{(bf16*)(ws + WS_CQ), (bf16*)(ws + WS_CKV), (bf16*)(ws + WS_KR), (bf16*)(ws + WS_U), (bf16*)(ws + WS_CV), (bf16*)(ws + WS_GT),
                                (float*)(ws + WS_PART), (const float*)(ws + WS_COS), (const float*)(ws + WS_SIN), (const LAS float*)(lds + LDS_BIAS), (unsigned*)(ws + WS_KMAX)}};
            run_gemm<0>(lds, g, So, E);
            if (CONV_SLOT_A > 0 && bx >= 192 && G == 256) { __syncthreads(); conv_moe_range(args, lds, l, 0, CONV_SLOT_A, bx - 192, 64); }
         REPBAR(1); } }
        SEAM(pb + 1);
        if (PM(2) && IN(pb + 2)) { _Pragma("unroll 1") for (int rep_ = 0; rep_ < NREP(2); ++rep_) {
            unsigned char* ws = opaque(args.ws); unsigned char* wl = ws + WS_W + (size_t)l * WL_BYTES;
#ifndef PREP_PARTS
#define PREP_PARTS 7
#endif
            if (PREP_PARTS & 1) { pg8::Gemm g{(const bf16*)(ws + WS_CQ), (const bf16*)(wl + WO_UQ), T, 768, QR}; pg8::StaticOrder So; So.init(T, 768, G, bx);
              Epi8<FQ, EPF> E{FQ{(bf16*)(ws + WS_Q), (const float*)(ws + WS_PART), (const float*)(ws + WS_COS), (const float*)(ws + WS_SIN)}};
              run_gemm<1>(lds, g, So, E); }
            if (CONV_SLOT_C > 0 && bx >= 192 && G == 256) { __syncthreads(); conv_moe_range(args, lds, l, CONV_SLOT_A, CONV_SLOT_C, bx - 192, 64); __syncthreads(); }
            if (PREP_PARTS & 2) { pg8::Gemm g{(const bf16*)(ws + WS_CKV), (const bf16*)(wl + WO_UKV), T, 1024, KVR}; pg8::StaticOrder So; So.init(T, 1024, G, bx);
              Epi8<FKV, EPF> E{FKV{(bf16*)(ws + WS_KV), (const float*)(ws + WS_PART), (unsigned*)(ws + WS_KMAX)}};
              run_gemm<2>(lds, g, So, E); }
            if (PREP_PARTS & 4) phase_prep_elem(args, l, vcu, G);
         REPBAR(2); } }
        SEAM(pb + 2);
        if (PM(3) && IN(pb + 3)) { _Pragma("unroll 1") for (int rep_ = 0; rep_ < NREP(3); ++rep_) { phase_attn(args, lds, vcu, G); REPBAR(3); } }
        SEAM(pb + 3);
        if (PM(4) && IN(pb + 4)) { _Pragma("unroll 1") for (int rep_ = 0; rep_ < NREP(4); ++rep_) {
            unsigned char* ws = opaque(args.ws); unsigned char* wl = ws + WS_W + (size_t)l * WL_BYTES;
#if MERGE_FUSED
            { pg8::Gemm g{(const bf16*)(ws + WS_O), (const bf16*)(wl + WO_OA), T, D, 512};
              MergeSched Sm; Sm.so.init(T, D, G, bx); Sm.ws = (const char*)ws; Sm.wl = (const char*)wl;
              EMergeFused E{(bf16*)(ws + WS_MG), (const bf16*)(ws + WS_GT)};
              pg8::gemm_phase_seg<EMergeFused, MergeSched, true, true>(lds, g, Sm, E); }
#else
            pg8::StaticOrder So; So.init(T, D, G, bx);
            { pg8::Gemm g{(const bf16*)(ws + WS_O), (const bf16*)(wl + WO_OA), T, D, 512};
              Epi8<FMerge<0>, EPF> E{FMerge<0>{(bf16*)(ws + WS_MG), (const bf16*)(ws + WS_GT), nullptr}}; run_gemm<3>(lds, g, So, E); } L1_INV();
            { pg8::Gemm g{(const bf16*)(ws + WS_CY), (const bf16*)(wl + WO_OC), T, D, 512};
              Epi8<FMerge<1>, EPF> E{FMerge<1>{(bf16*)(ws + WS_MG), (const bf16*)(ws + WS_GT), nullptr}}; run_gemm<4>(lds, g, So, E); } L1_INV();
            { pg8::Gemm g{(const bf16*)(ws + WS_MIX), (const bf16*)(wl + WO_POOL), T, D, 512};
              Epi8<FMerge<2>, EPF> E{FMerge<2>{(bf16*)(ws + WS_MG), (const bf16*)(ws + WS_GT), args.in[I_PSCALE] + (size_t)l * D}}; run_gemm<5>(lds, g, So, E); }
#endif
         REPBAR(4); } }
        SEAM(pb + 4);
        if (PM(5) && IN(pb + 5)) {
            unsigned char* ws = opaque(args.ws); unsigned char* wl = ws + WS_W + (size_t)l * WL_BYTES; const float* MOD = (const float*)(ws + WS_MOD);
            pg8::Gemm g{(const bf16*)(ws + WS_MG), (const bf16*)(wl + WO_OUT), T, D, D}; pg8::StaticOrder So; So.init(T, D, G, bx);
            Epi8<FOut, EPF> E{FOut{l == 0 ? args.in[I_X] : (const float*)(ws + WS_X), (float*)(ws + WS_X), MOD + (size_t)l * NB * 6144 + 2 * D}};
            run_gemm<6>(lds, g, So, E);
        }
        SEAM(pb + 5);
        if (PM(6) && IN(pb + 6)) { _Pragma("unroll 1") for (int rep_ = 0; rep_ < NREP(6); ++rep_) { phase_norm2(args, l, lds, vcu, G); REPBAR(6); } }
        SEAM(pb + 6);
        if (PM(7) && IN(pb + 7)) { _Pragma("unroll 1") for (int rep_ = 0; rep_ < NREP(7); ++rep_) { phase_topk(args, lds, G);
            if (CONV_SLOT_B > 0 && bx >= 64 && G == 256) conv_moe_range(args, lds, l, CONV_SLOT_A + CONV_SLOT_C, CONV_SLOT_B, bx - 64, 192);
         REPBAR(7); } }
        conv_drain(args, lds, MISC + 16, qcur, 2 * l + 1, G);
        SEAM(pb + 7);
        if (PM(8) && IN(pb + 8)) { _Pragma("unroll 1") for (int rep_ = 0; rep_ < NREP(8); ++rep_) {
            unsigned char* ws = opaque(args.ws); unsigned char* wl = ws + WS_W + (size_t)l * WL_BYTES;
#if GATHER_FUSED
            pg8::Gemm g{(const bf16*)(ws + WS_H), (const bf16*)(wl + WO_GU), NB * NE * CAP, NE * 2048, D}; GuOrder So{G, bx};
            Epi8<FGu, EPF, false> E{FGu{(bf16*)(ws + WS_ACT)}}; pg8::gemm_phase_gather<Epi8<FGu, EPF, false>, GuOrder, true, true>(lds, g, So, E, (const int*)(ws + WS_IDX));
#else
            pg8::Gemm g{(const bf16*)(ws + WS_XG), (const bf16*)(wl + WO_GU), NB * NE * CAP, NE * 2048, D}; GuOrder So{G, bx};
            Epi8<FGu, EPF> E{FGu{(bf16*)(ws + WS_ACT)}}; run_gemm<7>(lds, g, So, E);
#endif
         REPBAR(8); } }
        SEAM(pb + 8);
        if (PM(9) && IN(pb + 9)) { _Pragma("unroll 1") for (int rep_ = 0; rep_ < NREP(9); ++rep_) {
            unsigned char* ws = opaque(args.ws); unsigned char* wl = ws + WS_W + (size_t)l * WL_BYTES;
            pg8::Gemm g{(const bf16*)(ws + WS_ACT), (const bf16*)(wl + WO_DN), NB * NE * CAP, NE * 1024, FF}; DnOrder So{G, bx};
            Epi8<FDn, EPF> E{FDn{(bf16*)(ws + WS_Y)}}; run_gemm<8>(lds, g, So, E);
         REPBAR(9); } }
        SEAM(pb + 9);
    }
    if (PM(11) && IN(41)) phase_norm1(args, NL, vcu, G);
#undef IN
#undef SEAM
}

extern "C" void kernel_launch(void* const* d_in, const int* in_sizes, int n_in, void* d_out, int out_size, void* d_ws, size_t ws_size, hipStream_t stream) {
    static int grid = 0;
    if (grid == 0) {
        if (n_in != 24 || out_size != T * D || ws_size < WS_END) { fprintf(stderr, "kernel_launch: unexpected shapes: n_in %d out %d ws %zu (need %zu)\n", n_in, out_size, ws_size, (size_t)WS_END); grid = -1; return; }
        int dev = 0, cus = 0, per_cu = 0;
        if (hipGetDevice(&dev) != hipSuccess || hipDeviceGetAttribute(&cus, hipDeviceAttributeMultiprocessorCount, dev) != hipSuccess) { grid = -1; return; }
        if (hipFuncSetAttribute((const void*)fwd, hipFuncAttributeMaxDynamicSharedMemorySize, LDS_BYTES) != hipSuccess) { fprintf(stderr, "kernel_launch: hipFuncSetAttribute failed\n"); grid = -1; return; }
        if (hipOccupancyMaxActiveBlocksPerMultiprocessor(&per_cu, (const void*)fwd, NWAVES * 64, LDS_BYTES) != hipSuccess || per_cu < 1) fprintf(stderr, "kernel_launch: occupancy query reports %d\n", per_cu);
        (void)hipGetLastError();
        grid = cus;
    }
    if (grid < 0) return;
    if (hipMemsetAsync((char*)d_ws + WS_CTL, 0, CTL_ZERO_BYTES, stream) != hipSuccess) return;
    Args a{};
    for (int i = 0; i < 24; ++i) a.in[i] = (const float*)d_in[i];
    a.out = (float*)d_out; a.ws = (unsigned char*)d_ws;
#if MK_PER_PHASE
    for (int p = 0; p < 42; ++p) { a.p_lo = p; a.p_hi = p + 1; hipLaunchKernelGGL(fwd, dim3(grid), dim3(NWAVES * 64), LDS_BYTES, stream, a); }
#else
    a.p_lo = 0; a.p_hi = 42;
    hipLaunchKernelGGL(fwd, dim3(grid), dim3(NWAVES * 64), LDS_BYTES, stream, a);
#endif
    const hipError_t le = hipPeekAtLastError();
    if (le != hipSuccess) fprintf(stderr, "kernel_launch: launch failed: %s\n", hipGetErrorName(le));
}
```

```cpp
#include <hip/hip_runtime.h>
#include <cstdio>
#include <cstdint>
#ifndef MK_PER_PHASE
#define MK_PER_PHASE 0
#endif
#ifndef NAIVE_GEMM_MASK
#define NAIVE_GEMM_MASK 0
#endif
#ifndef NAIVE_ATTN
#define NAIVE_ATTN 0
#endif
#ifndef ATTN_V2
#define ATTN_V2 0
#endif
#ifndef MERGE_FUSED
#define MERGE_FUSED 1
#endif
#ifndef ATTN_KBATCH
#define ATTN_KBATCH 0
#endif
#ifndef GATHER_FUSED
#define GATHER_FUSED 1
#endif
#ifndef ATTN_FASTPATH
#define ATTN_FASTPATH 1
#endif
#ifndef KMAX_ATOMICS
#define KMAX_ATOMICS 1
#endif
#ifndef ATTN_ONEBAR
#define ATTN_ONEBAR 1
#endif
#ifndef ATTN_ISTEP
#define ATTN_ISTEP 1
#endif
#ifndef ATTN_PRIO
#define ATTN_PRIO 0
#endif
#ifndef XB_WORK_UNTIL_LOCAL
#define XB_WORK_UNTIL_LOCAL 0
#endif

namespace pg8 {
#define PG8_LAS __attribute__((address_space(3)))
typedef unsigned short bf16_t;
typedef short bf16x8 __attribute__((ext_vector_type(8)));
typedef float f32x4 __attribute__((ext_vector_type(4)));
typedef unsigned u32x4 __attribute__((ext_vector_type(4)));
constexpr int BM = 256, BK = 64, HALF = 128, HTB = HALF * BK * 2  , STAGE_BYTES = 8 * HTB, NXCD = 8, WGM = 8;

__host__ __device__ __forceinline__ int lds_byte(int r, int c) { const int st = (r >> 4) * 2 + (c >> 5), rr = r & 15, cc = c & 31, ob = rr * 64 + cc * 2; return st * 1024 + (ob ^ (((ob >> 9) & 1) << 5)); }
__host__ __device__ __forceinline__ void stage_rc(int b, int& R, int& C) { const int st = b / 1024, sb = b % 1024, swz = sb ^ (((sb >> 9) & 1) << 5); R = (st >> 1) * 16 + swz / 64; C = (st & 1) * 32 + (swz % 64) / 2; }
__host__ __device__ __forceinline__ int perm32(int rho) { const int n = rho >> 4, i = rho & 15; return 8 * (i >> 2) + 4 * n + (i & 3); }

struct Unit { int pm, pn; };
struct Gemm { const bf16_t* A; const bf16_t* Bt; int M, N, K; };

struct StaticOrder {
    int nM, nN, nwg, G, c;
    __host__ __device__ void init(int M, int N, int G_, int c_) { nM = M / BM; nN = N / BM; nwg = nM * nN; G = G_; c = c_; }
    __host__ __device__ bool next(int i, Unit& u) const {
        const long L = (long)i * G + c; if (L >= nwg) return false;
        int wgid = (int)L; { const int q = nwg / NXCD, r = nwg % NXCD, xcd = wgid % NXCD, off = wgid / NXCD; wgid = (xcd < r ? xcd * (q + 1) : r * (q + 1) + (xcd - r) * q) + off; }
        const int nig = WGM * nN, gid = wgid / nig, fm = gid * WGM, gsz = (nM - fm) < WGM ? (nM - fm) : WGM;
        u.pm = fm + ((wgid % nig) % gsz); u.pn = (wgid % nig) / gsz; return true;
    }
    __device__ __forceinline__ void a_ready(const Unit&) const {}
    __device__ __forceinline__ void done(const Unit&) const {}
};

__device__ __forceinline__ unsigned cvt_pk_bf16(float lo, float hi) { unsigned r; asm volatile("v_cvt_pk_bf16_f32 %0, %1, %2" : "=v"(r) : "v"(lo), "v"(hi)); return r; }
#ifndef PG8_KREP
#define PG8_KREP 1
#endif
template <class Epi, class Sched, bool ALIGN_EPI = false, bool SP2 = false>
__device__ __forceinline__ void gemm_phase(PG8_LAS unsigned char* lds, const Gemm g, const Sched& S, const Epi& E) {
    int tid_ = threadIdx.x; asm volatile("" : "+v"(tid_));
    const int tid = tid_, wid = __builtin_amdgcn_readfirstlane(tid >> 6), lane = tid & 63, wr = wid >> 2, wc = wid & 3, fr = lane & 15, fq = lane >> 4;
    int K_ = g.K; asm volatile("" : "+s"(K_)); const int K = K_, nt = K / BK;
    unsigned voffA[2], voffB[2];
#pragma unroll
    for (int i = 0; i < 2; ++i) { int R, C; stage_rc(tid * 16 + i * 8192, R, C); const int Rb = Epi::PERM ? ((R & ~31) + perm32(R & 31)) : R;
        voffA[i] = (unsigned)(R * K + C) * 2u; voffB[i] = (unsigned)(Rb * K + C) * 2u; }
    const size_t kstep = (size_t)(BK * 2);
    const size_t hstep = (size_t)HALF * K * 2;
    const size_t tstep = 2 * hstep;
    const unsigned ldsw = (unsigned)wid * 1024u;
    const int aoff = lds_byte(wr * 64 + fr, fq * 8), boff = lds_byte(wc * 32 + fr, fq * 8);
#define PG8_SA(b, h) (((b) * 2 + (h)) * HTB)
#define PG8_SB(b, h) ((4 + (b) * 2 + (h)) * HTB)
#define PG8_STAGE(bufoff, gbase, voff) do { _Pragma("unroll") for (int _i = 0; _i < 2; ++_i) \
        __builtin_amdgcn_global_load_lds((const unsigned*)((const char*)(gbase) + (voff)[_i]), (PG8_LAS unsigned*)(lds + (bufoff) + ldsw + _i * 8192), 16, 0, 0); } while (0)
#define PG8_LDA(dst, b, h) do { _Pragma("unroll") for (int m = 0; m < 4; ++m) _Pragma("unroll") for (int k = 0; k < 2; ++k) dst[m][k] = *(const PG8_LAS bf16x8*)(lds + PG8_SA(b, h) + aoff + m * 2048 + k * 1024); } while (0)
#define PG8_LDB(dst, b, h) do { _Pragma("unroll") for (int n = 0; n < 2; ++n) _Pragma("unroll") for (int k = 0; k < 2; ++k) dst[n][k] = *(const PG8_LAS bf16x8*)(lds + PG8_SB(b, h) + boff + n * 2048 + k * 1024); } while (0)
#define PG8_MMA(ai, bj, At, Bt) do { __builtin_amdgcn_s_setprio(1); _Pragma("unroll") for (int m = 0; m < 4; ++m) _Pragma("unroll") for (int n = 0; n < 2; ++n) _Pragma("unroll") for (int k = 0; k < 2; ++k) \
        acc[ai][bj][m][n] = __builtin_amdgcn_mfma_f32_16x16x32_bf16(Bt[n][k], At[m][k], acc[ai][bj][m][n], 0, 0, 0); __builtin_amdgcn_s_setprio(0); } while (0)
#define PG8_WAIT_V(n) asm volatile("s_waitcnt vmcnt(" #n ")" ::: "memory")
#define PG8_WAIT_L(n) asm volatile("s_waitcnt lgkmcnt(" #n ")" ::: "memory")
#define PG8_BAR __builtin_amdgcn_s_barrier()
#define PG8_SCHED __builtin_amdgcn_sched_barrier(0)
    Unit cur, nxt; int ui = 0;
    if (!S.next(0, cur)) return;
    f32x4 acc[2][2][4][2];
#pragma unroll
    for (int a = 0; a < 2; ++a)
#pragma unroll
        for (int b = 0; b < 2; ++b)
#pragma unroll
            for (int m = 0; m < 4; ++m)
#pragma unroll
                for (int n = 0; n < 2; ++n) acc[a][b][m][n] = (f32x4){0.f, 0.f, 0.f, 0.f};
    bf16x8 At[4][2], B0[2][2], B1[2][2];
    const char* cA = (const char*)g.A + (size_t)cur.pm * tstep; const char* cB = (const char*)g.Bt + (size_t)cur.pn * tstep;
    S.a_ready(cur);
    if constexpr (SP2) {
        PG8_STAGE(PG8_SB(0, 0), cB, voffB); PG8_STAGE(PG8_SB(0, 1), cB + hstep, voffB); PG8_STAGE(PG8_SA(0, 0), cA, voffA); PG8_STAGE(PG8_SA(0, 1), cA + hstep, voffA);
        if (wr == 1) PG8_BAR;
        PG8_WAIT_V(2); PG8_BAR;
        PG8_STAGE(PG8_SB(1, 0), cB + kstep, voffB); PG8_STAGE(PG8_SA(1, 0), cA + kstep, voffA); PG8_STAGE(PG8_SB(1, 1), cB + hstep + kstep, voffB);
        PG8_WAIT_V(6); PG8_BAR;
    } else {
        PG8_STAGE(PG8_SB(0, 0), cB, voffB); PG8_STAGE(PG8_SA(0, 0), cA, voffA); PG8_STAGE(PG8_SB(0, 1), cB + hstep, voffB); PG8_STAGE(PG8_SA(0, 1), cA + hstep, voffA);
        if (wr == 1) PG8_BAR;
        PG8_WAIT_V(4); PG8_BAR;
        PG8_STAGE(PG8_SB(1, 0), cB + kstep, voffB); PG8_STAGE(PG8_SA(1, 0), cA + kstep, voffA); PG8_STAGE(PG8_SB(1, 1), cB + hstep + kstep, voffB);
        PG8_WAIT_V(6); PG8_BAR;
    }
    for (;;) {
        const bool has_next = S.next(ui + 1, nxt);
        const char* nA = has_next ? (const char*)g.A + (size_t)nxt.pm * tstep : cA; const char* nB = has_next ? (const char*)g.Bt + (size_t)nxt.pn * tstep : cB;
#pragma unroll 1
        for (int tt_ = 0; tt_ < PG8_KREP * nt; tt_ += 2) {
            const bool last = (tt_ == PG8_KREP * nt - 2); const int t = tt_ % nt; const int t2_ = (tt_ + 2) % nt;
            const char* a1 = cA + (size_t)(t + 1) * kstep;
            const char* a2 = last ? nA : cA + (size_t)t2_ * kstep; const char* b2 = last ? nB : cB + (size_t)t2_ * kstep;
            const char* a3 = a2 + kstep; const char* b3 = b2 + kstep;
            if (last && has_next) S.a_ready(nxt);
            if constexpr (SP2) {
            PG8_LDB(B0, 0, 0); PG8_LDB(B1, 0, 1); PG8_SCHED; PG8_LDA(At, 0, 0); PG8_STAGE(PG8_SA(1, 1), a1 + hstep, voffA);
            PG8_WAIT_V(8); PG8_WAIT_L(0); PG8_BAR; PG8_MMA(0, 0, At, B0); PG8_MMA(0, 1, At, B1); PG8_BAR; PG8_SCHED;
            PG8_LDA(At, 0, 1); PG8_STAGE(PG8_SB(0, 0), b2, voffB); PG8_STAGE(PG8_SB(0, 1), b2 + hstep, voffB); PG8_STAGE(PG8_SA(0, 0), a2, voffA);
            PG8_WAIT_V(8); PG8_WAIT_L(0); PG8_BAR; PG8_MMA(1, 0, At, B0); PG8_MMA(1, 1, At, B1); PG8_BAR; PG8_SCHED;
            PG8_LDB(B0, 1, 0); PG8_LDB(B1, 1, 1); PG8_SCHED; PG8_LDA(At, 1, 0); PG8_STAGE(PG8_SA(0, 1), a2 + hstep, voffA);
            PG8_WAIT_V(8); PG8_WAIT_L(0); PG8_BAR; PG8_MMA(0, 0, At, B0); PG8_MMA(0, 1, At, B1); PG8_BAR; PG8_SCHED;
            PG8_LDA(At, 1, 1); PG8_STAGE(PG8_SB(1, 0), b3, voffB); PG8_STAGE(PG8_SB(1, 1), b3 + hstep, voffB); PG8_STAGE(PG8_SA(1, 0), a3, voffA);
            PG8_WAIT_V(8); PG8_WAIT_L(0); PG8_BAR; PG8_MMA(1, 0, At, B0); PG8_MMA(1, 1, At, B1); PG8_BAR; PG8_SCHED;
            } else {
            PG8_LDB(B0, 0, 0); PG8_SCHED; PG8_LDA(At, 0, 0); PG8_STAGE(PG8_SA(1, 1), a1 + hstep, voffA);
            PG8_WAIT_L(8); PG8_BAR; PG8_WAIT_L(0); PG8_MMA(0, 0, At, B0); PG8_BAR; PG8_SCHED;
            PG8_LDB(B1, 0, 1); PG8_STAGE(PG8_SB(0, 0), b2, voffB);
            PG8_BAR; PG8_WAIT_L(0); PG8_MMA(0, 1, At, B1); PG8_BAR;
            PG8_LDA(At, 0, 1); PG8_STAGE(PG8_SA(0, 0), a2, voffA);
            PG8_BAR; PG8_WAIT_L(0); PG8_MMA(1, 0, At, B0); PG8_BAR; PG8_SCHED;
            PG8_STAGE(PG8_SB(0, 1), b2 + hstep, voffB);
            PG8_WAIT_V(6); PG8_BAR; PG8_MMA(1, 1, At, B1); PG8_BAR;
            PG8_LDB(B0, 1, 0); PG8_SCHED; PG8_LDA(At, 1, 0); PG8_STAGE(PG8_SA(0, 1), a2 + hstep, voffA);
            PG8_WAIT_L(8); PG8_BAR; PG8_WAIT_L(0); PG8_MMA(0, 0, At, B0); PG8_BAR; PG8_SCHED;
            PG8_LDB(B1, 1, 1); PG8_STAGE(PG8_SB(1, 0), b3, voffB);
            PG8_BAR; PG8_WAIT_L(0); PG8_MMA(0, 1, At, B1); PG8_BAR;
            PG8_LDA(At, 1, 1); PG8_STAGE(PG8_SA(1, 0), a3, voffA);
            PG8_BAR; PG8_WAIT_L(0); PG8_MMA(1, 0, At, B0); PG8_BAR; PG8_SCHED;
            PG8_STAGE(PG8_SB(1, 1), b3 + hstep, voffB);
            PG8_WAIT_V(6); PG8_BAR; PG8_MMA(1, 1, At, B1); PG8_BAR;
            }
        }
        if constexpr (ALIGN_EPI) { if (wr == 0) PG8_BAR; }
        if constexpr (!Epi::AFTER_DRAIN) { E(acc, cur, wr, wc, fr, fq); S.done(cur); }
        if (!has_next) break;
#pragma unroll
        for (int a = 0; a < 2; ++a)
#pragma unroll
            for (int b = 0; b < 2; ++b)
#pragma unroll
                for (int m = 0; m < 4; ++m)
#pragma unroll
                    for (int n = 0; n < 2; ++n) acc[a][b][m][n] = (f32x4){0.f, 0.f, 0.f, 0.f};
        cur = nxt; cA = nA; cB = nB; ++ui;
        if constexpr (ALIGN_EPI) { if (wr == 1) PG8_BAR; }
    }
    PG8_WAIT_V(0);
    if constexpr (!ALIGN_EPI) { if (wr == 0) PG8_BAR; }
    PG8_BAR;
    if constexpr (Epi::AFTER_DRAIN) { E.fused(acc, cur, wr, wc, fr, fq, lds, wid, lane); S.done(cur); }
#undef PG8_SA
#undef PG8_SB
#undef PG8_STAGE
#undef PG8_LDA
#undef PG8_LDB
#undef PG8_MMA
#undef PG8_WAIT_V
#undef PG8_WAIT_L
#undef PG8_BAR
#undef PG8_SCHED
}
template <class Epi, class Sched, bool ALIGN_EPI = false, bool SP2 = false>
__device__ __forceinline__ void gemm_phase_gather(PG8_LAS unsigned char* lds, const Gemm g, const Sched& S, const Epi& E, const int* __restrict__ rowidx) {
    int tid_ = threadIdx.x; asm volatile("" : "+v"(tid_));
    const int tid = tid_, wid = __builtin_amdgcn_readfirstlane(tid >> 6), lane = tid & 63, wr = wid >> 2, wc = wid & 3, fr = lane & 15, fq = lane >> 4;
    int K_ = g.K; asm volatile("" : "+s"(K_)); const int K = K_, nt = K / BK;
    static_assert(SP2, "gemm_phase_gather: SP2 loop only");
    unsigned voffA[2], voffB[2]; int rA[2]; unsigned cv0[2], cv1[2], nv0[2], nv1[2];
#pragma unroll
    for (int i = 0; i < 2; ++i) { int R, C; stage_rc(tid * 16 + i * 8192, R, C); const int Rb = Epi::PERM ? ((R & ~31) + perm32(R & 31)) : R;
        voffA[i] = (unsigned)C * 2u; rA[i] = R; voffB[i] = (unsigned)(Rb * K + C) * 2u; }
#define PG8_ROWOFF(dst0, dst1, u) do { _Pragma("unroll") for (int _i = 0; _i < 2; ++_i) { dst0[_i] = (unsigned)rowidx[(u).pm * 256 + rA[_i]] * (unsigned)(K * 2) + voffA[_i]; dst1[_i] = (unsigned)rowidx[(u).pm * 256 + 128 + rA[_i]] * (unsigned)(K * 2) + voffA[_i]; } } while (0)
    const size_t kstep = (size_t)(BK * 2);
    const size_t hstep = (size_t)HALF * K * 2;
    const size_t tstep = 2 * hstep;
    const unsigned ldsw = (unsigned)wid * 1024u;
    const int aoff = lds_byte(wr * 64 + fr, fq * 8), boff = lds_byte(wc * 32 + fr, fq * 8);
#define PG8_SA(b, h) (((b) * 2 + (h)) * HTB)
#define PG8_SB(b, h) ((4 + (b) * 2 + (h)) * HTB)
#define PG8_STAGE(bufoff, gbase, voff) do { _Pragma("unroll") for (int _i = 0; _i < 2; ++_i) \
        __builtin_amdgcn_global_load_lds((const unsigned*)((const char*)(gbase) + (voff)[_i]), (PG8_LAS unsigned*)(lds + (bufoff) + ldsw + _i * 8192), 16, 0, 0); } while (0)
#define PG8_LDA(dst, b, h) do { _Pragma("unroll") for (int m = 0; m < 4; ++m) _Pragma("unroll") for (int k = 0; k < 2; ++k) dst[m][k] = *(const PG8_LAS bf16x8*)(lds + PG8_SA(b, h) + aoff + m * 2048 + k * 1024); } while (0)
#define PG8_LDB(dst, b, h) do { _Pragma("unroll") for (int n = 0; n < 2; ++n) _Pragma("unroll") for (int k = 0; k < 2; ++k) dst[n][k] = *(const PG8_LAS bf16x8*)(lds + PG8_SB(b, h) + boff + n * 2048 + k * 1024); } while (0)
#define PG8_MMA(ai, bj, At, Bt) do { __builtin_amdgcn_s_setprio(1); _Pragma("unroll") for (int m = 0; m < 4; ++m) _Pragma("unroll") for (int n = 0; n < 2; ++n) _Pragma("unroll") for (int k = 0; k < 2; ++k) \
        acc[ai][bj][m][n] = __builtin_amdgcn_mfma_f32_16x16x32_bf16(Bt[n][k], At[m][k], acc[ai][bj][m][n], 0, 0, 0); __builtin_amdgcn_s_setprio(0); } while (0)
#define PG8_WAIT_V(n) asm volatile("s_waitcnt vmcnt(" #n ")" ::: "memory")
#define PG8_WAIT_L(n) asm volatile("s_waitcnt lgkmcnt(" #n ")" ::: "memory")
#define PG8_BAR __builtin_amdgcn_s_barrier()
#define PG8_SCHED __builtin_amdgcn_sched_barrier(0)
    Unit cur, nxt; int ui = 0;
    if (!S.next(0, cur)) return;
    f32x4 acc[2][2][4][2];
#pragma unroll
    for (int a = 0; a < 2; ++a)
#pragma unroll
        for (int b = 0; b < 2; ++b)
#pragma unroll
            for (int m = 0; m < 4; ++m)
#pragma unroll
                for (int n = 0; n < 2; ++n) acc[a][b][m][n] = (f32x4){0.f, 0.f, 0.f, 0.f};
    bf16x8 At[4][2], B0[2][2], B1[2][2];
    const char* cA = (const char*)g.A; const char* cB = (const char*)g.Bt + (size_t)cur.pn * tstep;
    PG8_ROWOFF(cv0, cv1, cur);
    S.a_ready(cur);
    if constexpr (SP2) {
        PG8_STAGE(PG8_SB(0, 0), cB, voffB); PG8_STAGE(PG8_SB(0, 1), cB + hstep, voffB); PG8_STAGE(PG8_SA(0, 0), cA, cv0); PG8_STAGE(PG8_SA(0, 1), cA, cv1);
        if (wr == 1) PG8_BAR;
        PG8_WAIT_V(2); PG8_BAR;
        PG8_STAGE(PG8_SB(1, 0), cB + kstep, voffB); PG8_STAGE(PG8_SA(1, 0), cA + kstep, cv0); PG8_STAGE(PG8_SB(1, 1), cB + hstep + kstep, voffB);
        PG8_WAIT_V(6); PG8_BAR;
    } else {
        PG8_STAGE(PG8_SB(0, 0), cB, voffB); PG8_STAGE(PG8_SA(0, 0), cA, voffA); PG8_STAGE(PG8_SB(0, 1), cB + hstep, voffB); PG8_STAGE(PG8_SA(0, 1), cA + hstep, voffA);
        if (wr == 1) PG8_BAR;
        PG8_WAIT_V(4); PG8_BAR;
        PG8_STAGE(PG8_SB(1, 0), cB + kstep, voffB); PG8_STAGE(PG8_SA(1, 0), cA + kstep, voffA); PG8_STAGE(PG8_SB(1, 1), cB + hstep + kstep, voffB);
        PG8_WAIT_V(6); PG8_BAR;
    }
    for (;;) {
        const bool has_next = S.next(ui + 1, nxt);
        const char* nA = cA; const char* nB = has_next ? (const char*)g.Bt + (size_t)nxt.pn * tstep : cB;
        if (has_next) PG8_ROWOFF(nv0, nv1, nxt); else { _Pragma("unroll") for (int _i = 0; _i < 2; ++_i) { nv0[_i] = cv0[_i]; nv1[_i] = cv1[_i]; } }
#pragma unroll 1
        for (int t = 0; t < nt; t += 2) {
            const bool last = (t == nt - 2);
            const char* a1 = cA + (size_t)(t + 1) * kstep;
            const char* a2 = last ? nA : cA + (size_t)(t + 2) * kstep; unsigned x0[2], x1[2]; _Pragma("unroll") for (int _i = 0; _i < 2; ++_i) { x0[_i] = last ? nv0[_i] : cv0[_i]; x1[_i] = last ? nv1[_i] : cv1[_i]; } const char* b2 = last ? nB : cB + (size_t)(t + 2) * kstep;
            const char* a3 = a2 + kstep; const char* b3 = b2 + kstep;
            if (last && has_next) S.a_ready(nxt);
            if constexpr (SP2) {
            PG8_LDB(B0, 0, 0); PG8_LDB(B1, 0, 1); PG8_SCHED; PG8_LDA(At, 0, 0); PG8_STAGE(PG8_SA(1, 1), a1, cv1);
            PG8_WAIT_V(8); PG8_WAIT_L(0); PG8_BAR; PG8_MMA(0, 0, At, B0); PG8_MMA(0, 1, At, B1); PG8_BAR; PG8_SCHED;
            PG8_LDA(At, 0, 1); PG8_STAGE(PG8_SB(0, 0), b2, voffB); PG8_STAGE(PG8_SB(0, 1), b2 + hstep, voffB); PG8_STAGE(PG8_SA(0, 0), a2, x0);
            PG8_WAIT_V(8); PG8_WAIT_L(0); PG8_BAR; PG8_MMA(1, 0, At, B0); PG8_MMA(1, 1, At, B1); PG8_BAR; PG8_SCHED;
            PG8_LDB(B0, 1, 0); PG8_LDB(B1, 1, 1); PG8_SCHED; PG8_LDA(At, 1, 0); PG8_STAGE(PG8_SA(0, 1), a2, x1);
            PG8_WAIT_V(8); PG8_WAIT_L(0); PG8_BAR; PG8_MMA(0, 0, At, B0); PG8_MMA(0, 1, At, B1); PG8_BAR; PG8_SCHED;
            PG8_LDA(At, 1, 1); PG8_STAGE(PG8_SB(1, 0), b3, voffB); PG8_STAGE(PG8_SB(1, 1), b3 + hstep, voffB); PG8_STAGE(PG8_SA(1, 0), a3, x0);
            PG8_WAIT_V(8); PG8_WAIT_L(0); PG8_BAR; PG8_MMA(1, 0, At, B0); PG8_MMA(1, 1, At, B1); PG8_BAR; PG8_SCHED;
            } else {
            PG8_LDB(B0, 0, 0); PG8_SCHED; PG8_LDA(At, 0, 0); PG8_STAGE(PG8_SA(1, 1), a1 + hstep, voffA);
            PG8_WAIT_L(8); PG8_BAR; PG8_WAIT_L(0); PG8_MMA(0, 0, At, B0); PG8_BAR; PG8_SCHED;
            PG8_LDB(B1, 0, 1); PG8_STAGE(PG8_SB(0, 0), b2, voffB);
            PG8_BAR; PG8_WAIT_L(0); PG8_MMA(0, 1, At, B1); PG8_BAR;
            PG8_LDA(At, 0, 1); PG8_STAGE(PG8_SA(0, 0), a2, voffA);
            PG8_BAR; PG8_WAIT_L(0); PG8_MMA(1, 0, At, B0); PG8_BAR; PG8_SCHED;
            PG8_STAGE(PG8_SB(0, 1), b2 + hstep, voffB);
            PG8_WAIT_V(6); PG8_BAR; PG8_MMA(1, 1, At, B1); PG8_BAR;
            PG8_LDB(B0, 1, 0); PG8_SCHED; PG8_LDA(At, 1, 0); PG8_STAGE(PG8_SA(0, 1), a2 + hstep, voffA);
            PG8_WAIT_L(8); PG8_BAR; PG8_WAIT_L(0); PG8_MMA(0, 0, At, B0); PG8_BAR; PG8_SCHED;
            PG8_LDB(B1, 1, 1); PG8_STAGE(PG8_SB(1, 0), b3, voffB);
            PG8_BAR; PG8_WAIT_L(0); PG8_MMA(0, 1, At, B1); PG8_BAR;
            PG8_LDA(At, 1, 1); PG8_STAGE(PG8_SA(1, 0), a3, voffA);
            PG8_BAR; PG8_WAIT_L(0); PG8_MMA(1, 0, At, B0); PG8_BAR; PG8_SCHED;
            PG8_STAGE(PG8_SB(1, 1), b3 + hstep, voffB);
            PG8_WAIT_V(6); PG8_BAR; PG8_MMA(1, 1, At, B1); PG8_BAR;
            }
        }
        if constexpr (ALIGN_EPI) { if (wr == 0) PG8_BAR; }
        if constexpr (!Epi::AFTER_DRAIN) { E(acc, cur, wr, wc, fr, fq); S.done(cur); }
        if (!has_next) break;
#pragma unroll
        for (int a = 0; a < 2; ++a)
#pragma unroll
            for (int b = 0; b < 2; ++b)
#pragma unroll
                for (int m = 0; m < 4; ++m)
#pragma unroll
                    for (int n = 0; n < 2; ++n) acc[a][b][m][n] = (f32x4){0.f, 0.f, 0.f, 0.f};
        cur = nxt; cA = nA; cB = nB; ++ui; _Pragma("unroll") for (int _i = 0; _i < 2; ++_i) { cv0[_i] = nv0[_i]; cv1[_i] = nv1[_i]; }
        if constexpr (ALIGN_EPI) { if (wr == 1) PG8_BAR; }
    }
    PG8_WAIT_V(0);
    if constexpr (!ALIGN_EPI) { if (wr == 0) PG8_BAR; }
    PG8_BAR;
    if constexpr (Epi::AFTER_DRAIN) { E.fused(acc, cur, wr, wc, fr, fq, lds, wid, lane); S.done(cur); }
#undef PG8_SA
#undef PG8_SB
#undef PG8_STAGE
#undef PG8_LDA
#undef PG8_LDB
#undef PG8_MMA
#undef PG8_WAIT_V
#undef PG8_WAIT_L
#undef PG8_BAR
#undef PG8_SCHED
#undef PG8_ROWOFF
}
template <class Epi, class Sched, bool ALIGN_EPI = false, bool SP2 = false>
__device__ __forceinline__ void gemm_phase_seg(PG8_LAS unsigned char* lds, const Gemm g, const Sched& S, const Epi& E) {
    int tid_ = threadIdx.x; asm volatile("" : "+v"(tid_));
    const int tid = tid_, wid = __builtin_amdgcn_readfirstlane(tid >> 6), lane = tid & 63, wr = wid >> 2, wc = wid & 3, fr = lane & 15, fq = lane >> 4;
    int K_ = g.K; asm volatile("" : "+s"(K_)); const int K = K_; int nt;
    unsigned voffA[2], voffB[2];
#pragma unroll
    for (int i = 0; i < 2; ++i) { int R, C; stage_rc(tid * 16 + i * 8192, R, C); const int Rb = Epi::PERM ? ((R & ~31) + perm32(R & 31)) : R;
        voffA[i] = (unsigned)(R * K + C) * 2u; voffB[i] = (unsigned)(Rb * K + C) * 2u; }
    const size_t kstep = (size_t)(BK * 2);
    const size_t hstep = (size_t)HALF * K * 2;
    const size_t tstep = 2 * hstep;
    const unsigned ldsw = (unsigned)wid * 1024u;
    const int aoff = lds_byte(wr * 64 + fr, fq * 8), boff = lds_byte(wc * 32 + fr, fq * 8);
#define PG8_SA(b, h) (((b) * 2 + (h)) * HTB)
#define PG8_SB(b, h) ((4 + (b) * 2 + (h)) * HTB)
#define PG8_STAGE(bufoff, gbase, voff) do { _Pragma("unroll") for (int _i = 0; _i < 2; ++_i) \
        __builtin_amdgcn_global_load_lds((const unsigned*)((const char*)(gbase) + (voff)[_i]), (PG8_LAS unsigned*)(lds + (bufoff) + ldsw + _i * 8192), 16, 0, 0); } while (0)
#define PG8_LDA(dst, b, h) do { _Pragma("unroll") for (int m = 0; m < 4; ++m) _Pragma("unroll") for (int k = 0; k < 2; ++k) dst[m][k] = *(const PG8_LAS bf16x8*)(lds + PG8_SA(b, h) + aoff + m * 2048 + k * 1024); } while (0)
#define PG8_LDB(dst, b, h) do { _Pragma("unroll") for (int n = 0; n < 2; ++n) _Pragma("unroll") for (int k = 0; k < 2; ++k) dst[n][k] = *(const PG8_LAS bf16x8*)(lds + PG8_SB(b, h) + boff + n * 2048 + k * 1024); } while (0)
#define PG8_MMA(ai, bj, At, Bt) do { __builtin_amdgcn_s_setprio(1); _Pragma("unroll") for (int m = 0; m < 4; ++m) _Pragma("unroll") for (int n = 0; n < 2; ++n) _Pragma("unroll") for (int k = 0; k < 2; ++k) \
        acc[ai][bj][m][n] = __builtin_amdgcn_mfma_f32_16x16x32_bf16(Bt[n][k], At[m][k], acc[ai][bj][m][n], 0, 0, 0); __builtin_amdgcn_s_setprio(0); } while (0)
#define PG8_WAIT_V(n) asm volatile("s_waitcnt vmcnt(" #n ")" ::: "memory")
#define PG8_WAIT_L(n) asm volatile("s_waitcnt lgkmcnt(" #n ")" ::: "memory")
#define PG8_BAR __builtin_amdgcn_s_barrier()
#define PG8_SCHED __builtin_amdgcn_sched_barrier(0)
    typename Sched::U cur, nxt; int ui = 0;
    if (!S.next(0, cur)) return;
    f32x4 acc[2][2][4][2];
#pragma unroll
    for (int a = 0; a < 2; ++a)
#pragma unroll
        for (int b = 0; b < 2; ++b)
#pragma unroll
            for (int m = 0; m < 4; ++m)
#pragma unroll
                for (int n = 0; n < 2; ++n) acc[a][b][m][n] = (f32x4){0.f, 0.f, 0.f, 0.f};
    bf16x8 At[4][2], B0[2][2], B1[2][2];
    const char* cA = S.baseA(cur); const char* cB = S.baseB(cur); nt = S.nt(cur); (void)tstep;
    S.a_ready(cur);
    if constexpr (SP2) {
        PG8_STAGE(PG8_SB(0, 0), cB, voffB); PG8_STAGE(PG8_SB(0, 1), cB + hstep, voffB); PG8_STAGE(PG8_SA(0, 0), cA, voffA); PG8_STAGE(PG8_SA(0, 1), cA + hstep, voffA);
        if (wr == 1) PG8_BAR;
        PG8_WAIT_V(2); PG8_BAR;
        PG8_STAGE(PG8_SB(1, 0), cB + kstep, voffB); PG8_STAGE(PG8_SA(1, 0), cA + kstep, voffA); PG8_STAGE(PG8_SB(1, 1), cB + hstep + kstep, voffB);
        PG8_WAIT_V(6); PG8_BAR;
    } else {
        PG8_STAGE(PG8_SB(0, 0), cB, voffB); PG8_STAGE(PG8_SA(0, 0), cA, voffA); PG8_STAGE(PG8_SB(0, 1), cB + hstep, voffB); PG8_STAGE(PG8_SA(0, 1), cA + hstep, voffA);
        if (wr == 1) PG8_BAR;
        PG8_WAIT_V(4); PG8_BAR;
        PG8_STAGE(PG8_SB(1, 0), cB + kstep, voffB); PG8_STAGE(PG8_SA(1, 0), cA + kstep, voffA); PG8_STAGE(PG8_SB(1, 1), cB + hstep + kstep, voffB);
        PG8_WAIT_V(6); PG8_BAR;
    }
    for (;;) {
        const bool has_next = S.next(ui + 1, nxt);
        const char* nA = has_next ? S.baseA(nxt) : cA; const char* nB = has_next ? S.baseB(nxt) : cB;
#pragma unroll 1
        for (int t = 0; t < nt; t += 2) {
            const bool last = (t == nt - 2);
            const char* a1 = cA + (size_t)(t + 1) * kstep;
            const char* a2 = last ? nA : cA + (size_t)(t + 2) * kstep; const char* b2 = last ? nB : cB + (size_t)(t + 2) * kstep;
            const char* a3 = a2 + kstep; const char* b3 = b2 + kstep;
            if (last && has_next) S.a_ready(nxt);
            if constexpr (SP2) {
            PG8_LDB(B0, 0, 0); PG8_LDB(B1, 0, 1); PG8_SCHED; PG8_LDA(At, 0, 0); PG8_STAGE(PG8_SA(1, 1), a1 + hstep, voffA);
            PG8_WAIT_V(8); PG8_WAIT_L(0); PG8_BAR; PG8_MMA(0, 0, At, B0); PG8_MMA(0, 1, At, B1); PG8_BAR; PG8_SCHED;
            PG8_LDA(At, 0, 1); PG8_STAGE(PG8_SB(0, 0), b2, voffB); PG8_STAGE(PG8_SB(0, 1), b2 + hstep, voffB); PG8_STAGE(PG8_SA(0, 0), a2, voffA);
            PG8_WAIT_V(8); PG8_WAIT_L(0); PG8_BAR; PG8_MMA(1, 0, At, B0); PG8_MMA(1, 1, At, B1); PG8_BAR; PG8_SCHED;
            PG8_LDB(B0, 1, 0); PG8_LDB(B1, 1, 1); PG8_SCHED; PG8_LDA(At, 1, 0); PG8_STAGE(PG8_SA(0, 1), a2 + hstep, voffA);
            PG8_WAIT_V(8); PG8_WAIT_L(0); PG8_BAR; PG8_MMA(0, 0, At, B0); PG8_MMA(0, 1, At, B1); PG8_BAR; PG8_SCHED;
            PG8_LDA(At, 1, 1); PG8_STAGE(PG8_SB(1, 0), b3, voffB); PG8_STAGE(PG8_SB(1, 1), b3 + hstep, voffB); PG8_STAGE(PG8_SA(1, 0), a3, voffA);
            PG8_WAIT_V(8); PG8_WAIT_L(0); PG8_BAR; PG8_MMA(1, 0, At, B0); PG8_MMA(1, 1, At, B1); PG8_BAR; PG8_SCHED;
            } else {
            PG8_LDB(B0, 0, 0); PG8_SCHED; PG8_LDA(At, 0, 0); PG8_STAGE(PG8_SA(1, 1), a1 + hstep, voffA);
            PG8_WAIT_L(8); PG8_BAR; PG8_WAIT_L(0); PG8_MMA(0, 0, At, B0); PG8_BAR; PG8_SCHED;
            PG8_LDB(B1, 0, 1); PG8_STAGE(PG8_SB(0, 0), b2, voffB);
            PG8_BAR; PG8_WAIT_L(0); PG8_MMA(0, 1, At, B1); PG8_BAR;
            PG8_LDA(At, 0, 1); PG8_STAGE(PG8_SA(0, 0), a2, voffA);
            PG8_BAR; PG8_WAIT_L(0); PG8_MMA(1, 0, At, B0); PG8_BAR; PG8_SCHED;
            PG8_STAGE(PG8_SB(0, 1), b2 + hstep, voffB);
            PG8_WAIT_V(6); PG8_BAR; PG8_MMA(1, 1, At, B1); PG8_BAR;
            PG8_LDB(B0, 1, 0); PG8_SCHED; PG8_LDA(At, 1, 0); PG8_STAGE(PG8_SA(0, 1), a2 + hstep, voffA);
            PG8_WAIT_L(8); PG8_BAR; PG8_WAIT_L(0); PG8_MMA(0, 0, At, B0); PG8_BAR; PG8_SCHED;
            PG8_LDB(B1, 1, 1); PG8_STAGE(PG8_SB(1, 0), b3, voffB);
            PG8_BAR; PG8_WAIT_L(0); PG8_MMA(0, 1, At, B1); PG8_BAR;
            PG8_LDA(At, 1, 1); PG8_STAGE(PG8_SA(1, 0), a3, voffA);
            PG8_BAR; PG8_WAIT_L(0); PG8_MMA(1, 0, At, B0); PG8_BAR; PG8_SCHED;
            PG8_STAGE(PG8_SB(1, 1), b3 + hstep, voffB);
            PG8_WAIT_V(6); PG8_BAR; PG8_MMA(1, 1, At, B1); PG8_BAR;
            }
        }
        if constexpr (ALIGN_EPI) { if (wr == 0) PG8_BAR; }
        if constexpr (!Epi::AFTER_DRAIN) { E(acc, cur, wr, wc, fr, fq); S.done(cur); }
        if (!has_next) break;
        if (!S.keep(cur)) {
#pragma unroll
        for (int a = 0; a < 2; ++a)
#pragma unroll
            for (int b = 0; b < 2; ++b)
#pragma unroll
                for (int m = 0; m < 4; ++m)
#pragma unroll
                    for (int n = 0; n < 2; ++n) acc[a][b][m][n] = (f32x4){0.f, 0.f, 0.f, 0.f};
        }
        cur = nxt; cA = nA; cB = nB; nt = S.nt(cur); ++ui;
        if constexpr (ALIGN_EPI) { if (wr == 1) PG8_BAR; }
    }
    PG8_WAIT_V(0);
    if constexpr (!ALIGN_EPI) { if (wr == 0) PG8_BAR; }
    PG8_BAR;
    if constexpr (Epi::AFTER_DRAIN) { E.fused(acc, cur, wr, wc, fr, fq, lds, wid, lane); S.done(cur); }
#undef PG8_SA
#undef PG8_SB
#undef PG8_STAGE
#undef PG8_LDA
#undef PG8_LDB
#undef PG8_MMA
#undef PG8_WAIT_V
#undef PG8_WAIT_L
#undef PG8_BAR
#undef PG8_SCHED
}
}

constexpr int NB = 4, S = 4096, T = NB * S, D = 1024, NL = 4;
constexpr int NH = 8, DQK = 96, QR = 384, KVR = 256;
constexpr int NIN_SRC = 5792, NIN = 5888;
constexpr int NE = 16, FF = 1024, CAP = 512;
constexpr float EPS = 1e-6f;
constexpr int NWAVES = 8;

constexpr size_t MiB = 1u << 20;
constexpr size_t WS_CTL = 0, CTL_ZERO_BYTES = 64 * 1024;
constexpr size_t WS_MOD = 1 * MiB;
constexpr size_t WS_COS = 2 * MiB, WS_SIN = 3 * MiB;
constexpr size_t WS_PART = 4 * MiB;
constexpr size_t WS_AFF = 5 * MiB;
constexpr size_t WS_SLOT = 6 * MiB;
constexpr size_t WS_KMAX = 7 * MiB, WS_IDX = 7 * MiB + 512 * 1024;
constexpr size_t WS_W = 8 * MiB;
constexpr size_t WO_IN = 0, WO_UQ = WO_IN + (size_t)NIN * D * 2, WO_UKV = WO_UQ + (size_t)768 * QR * 2, WO_OA = WO_UKV + (size_t)1024 * KVR * 2,
                 WO_POOL = WO_OA + (size_t)D * 512 * 2, WO_OC = WO_POOL + (size_t)D * 512 * 2, WO_OUT = WO_OC + (size_t)D * 512 * 2,
                 WO_GU = WO_OUT + (size_t)D * D * 2, WO_DN = WO_GU + (size_t)NE * 2048 * D * 2, WL_BYTES = WO_DN + (size_t)NE * D * FF * 2;
static_assert(WS_W + NL * WL_BYTES <= 464 * MiB, "weights fit");
constexpr size_t WS_X = 464 * MiB, WS_H = 528 * MiB;
constexpr size_t WS_CQ = 560 * MiB, WS_CKV = 572 * MiB, WS_KR = 580 * MiB, WS_U = 581 * MiB, WS_CV = 597 * MiB, WS_GT = 645 * MiB, WS_Q = 741 * MiB,
                 WS_KV = 765 * MiB, WS_MIX = 797 * MiB, WS_CY = 813 * MiB, WS_O = 829 * MiB, WS_MG = 845 * MiB, WS_END = 877 * MiB;
constexpr size_t WS_XG = 560 * MiB, WS_ACT = 624 * MiB, WS_Y = 688 * MiB;
constexpr int CW_BAR = 4096;

constexpr int LDS_BYTES = 147456;
constexpr int MISC_OFF = 131072 + 1024;
constexpr int LDS_BIAS = 131072 + 2048;

#define GAS __attribute__((address_space(1)))
#define LAS __attribute__((address_space(3)))
typedef unsigned short bf16;
typedef unsigned v4u __attribute__((ext_vector_type(4)));
typedef unsigned v2u __attribute__((ext_vector_type(2)));
using pg8::f32x4;
using pg8::bf16x8;
#define LDS_WAIT() asm volatile("s_waitcnt lgkmcnt(0)" ::: "memory")
#define VM_WAIT() asm volatile("s_waitcnt vmcnt(0)" ::: "memory")
__device__ __forceinline__ unsigned pk2(float lo, float hi) { return pg8::cvt_pk_bf16(lo, hi); }
__device__ __forceinline__ float bflo(unsigned w) { return __uint_as_float(w << 16); }
__device__ __forceinline__ float bfhi(unsigned w) { return __uint_as_float(w & 0xffff0000u); }
__device__ __forceinline__ v4u pack8(const f32x4& a, const f32x4& b) { v4u w; w.x = pk2(a[0], a[1]); w.y = pk2(a[2], a[3]); w.z = pk2(b[0], b[1]); w.w = pk2(b[2], b[3]); return w; }
__device__ __forceinline__ void unpack8(const v4u& w, f32x4& a, f32x4& b) { a = (f32x4){bflo(w.x), bfhi(w.x), bflo(w.y), bfhi(w.y)}; b = (f32x4){bflo(w.z), bfhi(w.z), bflo(w.w), bfhi(w.w)}; }
__device__ __forceinline__ float wave_sum(float v) {
#pragma unroll
    for (int o = 1; o < 64; o <<= 1) v += __shfl_xor(v, o);
    return v;
}
__device__ __forceinline__ float wave_max(float v) {
#pragma unroll
    for (int o = 1; o < 64; o <<= 1) v = fmaxf(v, __shfl_xor(v, o));
    return v;
}
__device__ __forceinline__ unsigned char* opaque(unsigned char* p) { size_t z = 0; asm volatile("" : "+s"(z)); return p + z; }
constexpr float QSCALE = 0.10206207261596575f * 1.4426950408889634f;
__device__ __forceinline__ int otid() { int t = threadIdx.x; asm volatile("" : "+v"(t)); return t; }
__device__ __forceinline__ float sigmoidf_(float x) { return fmaxf(__builtin_amdgcn_rcpf(1.0f + __expf(-x)), 1e-30f); }

#ifndef EPI_REP
#define EPI_REP 1
#endif
struct NoCarry { };
template <class F, int FENCE = 1, bool KREP_SITE = true> struct Epi8 {
    static constexpr bool PERM = true, AFTER_DRAIN = false;
    F f;
    __device__ __forceinline__ void operator()(const f32x4 (&acc)[2][2][4][2], const pg8::Unit& u, int wr, int wc, int fr, int fq) const {
        const int row0 = u.pm * 256 + wr * 64 + fr, col = u.pn * 256 + wc * 32 + 8 * fq;
        typename F::Carry carry{};
#pragma unroll
        for (int g0 = 0; g0 < 8; g0 += FENCE) {
            typename F::L ld[FENCE];
#pragma unroll
            for (int k = 0; k < FENCE; ++k) { const int ai = (g0 + k) >> 2, m = (g0 + k) & 3; ld[k] = f.pre(u, row0 + ai * 128 + m * 16, col); }
#pragma unroll
            for (int k = 0; k < FENCE; ++k) { const int ai = (g0 + k) >> 2, m = (g0 + k) & 3; constexpr float kr = KREP_SITE ? 1.0f / PG8_KREP : 1.0f;
                f.post(u, row0 + ai * 128 + m * 16, col, ld[k], acc[ai][0][m][0] * kr, acc[ai][0][m][1] * kr, acc[ai][1][m][0] * kr, acc[ai][1][m][1] * kr, carry); }
            asm volatile("" ::: "memory");
        }
        f.finish(u, wr, wc, carry);
    }
};

template <class Epi, class Sched>
__device__ __forceinline__ void naive_gemm_phase(LAS unsigned char* lds, const pg8::Gemm g, const Sched& Sd, const Epi& E) {
    const int tid = otid(), wid = tid >> 6, lane = tid & 63, wr = wid >> 2, wc = wid & 3, fr = lane & 15, fq = lane >> 4;
    const int K = g.K;
    LAS bf16* As = (LAS bf16*)lds; LAS bf16* Bs = (LAS bf16*)(lds + 256 * 72 * 2);
    pg8::Unit u;
    for (int ui = 0; Sd.next(ui, u); ++ui) {
        f32x4 acc[2][2][4][2];
#pragma unroll
        for (int a = 0; a < 2; ++a)
#pragma unroll
            for (int b = 0; b < 2; ++b)
#pragma unroll
                for (int m = 0; m < 4; ++m)
#pragma unroll
                    for (int n = 0; n < 2; ++n) acc[a][b][m][n] = (f32x4){0.f, 0.f, 0.f, 0.f};
        for (int k0 = 0; k0 < K; k0 += 64) {
            __syncthreads();
#pragma unroll
            for (int i = 0; i < 4; ++i) { const int id = tid + 512 * i, r = id >> 3, c8 = id & 7;
                *(LAS v4u*)(As + r * 72 + c8 * 8) = *(const v4u*)(g.A + (size_t)(u.pm * 256 + r) * K + k0 + c8 * 8);
                *(LAS v4u*)(Bs + r * 72 + c8 * 8) = *(const v4u*)(g.Bt + (size_t)(u.pn * 256 + r) * K + k0 + c8 * 8); }
            __syncthreads();
#pragma unroll 1
            for (int kk = 0; kk < 64; kk += 8) {
                v4u af[2][4];
#pragma unroll
                for (int ai = 0; ai < 2; ++ai)
#pragma unroll
                    for (int m = 0; m < 4; ++m) af[ai][m] = *(const LAS v4u*)(As + (128 * ai + 64 * wr + 16 * m + fr) * 72 + kk);
#pragma unroll
                for (int bj = 0; bj < 2; ++bj)
#pragma unroll
                    for (int n = 0; n < 2; ++n)
#pragma unroll
                        for (int i = 0; i < 4; ++i) {
                            const v4u bw = *(const LAS v4u*)(Bs + (128 * bj + 32 * wc + 8 * fq + 4 * n + i) * 72 + kk);
                            f32x4 b0, b1; unpack8(bw, b0, b1);
#pragma unroll
                            for (int ai = 0; ai < 2; ++ai)
#pragma unroll
                                for (int m = 0; m < 4; ++m) { f32x4 a0, a1; unpack8(af[ai][m], a0, a1);
                                    float s = acc[ai][bj][m][n][i];
                                    s += a0[0] * b0[0]; s += a0[1] * b0[1]; s += a0[2] * b0[2]; s += a0[3] * b0[3];
                                    s += a1[0] * b1[0]; s += a1[1] * b1[1]; s += a1[2] * b1[2]; s += a1[3] * b1[3];
                                    acc[ai][bj][m][n][i] = s; }
                        }
            }
        }
        E(acc, u, wr, wc, fr, fq);
    }
    __syncthreads();
}
#ifndef PG8_ALIGN
#define PG8_ALIGN true
#endif
#ifndef PG8_SP2
#define PG8_SP2 true
#endif
template <int SITE, class Epi, class Sched>
__device__ __forceinline__ void run_gemm(LAS unsigned char* lds, const pg8::Gemm g, const Sched& Sd, const Epi& E) {
    if constexpr ((NAIVE_GEMM_MASK >> SITE) & 1) naive_gemm_phase<Epi, Sched>(lds, g, Sd, E);
    else pg8::gemm_phase<Epi, Sched, true, PG8_SP2>(lds, g, Sd, E);
}

namespace att {
using s16x4 = __attribute__((ext_vector_type(4))) short;
using f32x16 = __attribute__((ext_vector_type(16))) float;
constexpr int NW = 8, QBLK = 32, KVBLK = 64;
constexpr float SCALE = 0.10206207261596575f;
constexpr float THR = 8.f;
constexpr int LDQ = 768, LDKV = 1024, LDKR = 32, LDO = 512;
constexpr int SHM_V = KVBLK * 64 * 2, SHM_K = KVBLK * 256, SHM_ATTN = 2 * SHM_V + 2 * SHM_K + NW * 64 * 4;
#define KSWZ(row, colB) ((row) * 256 + ((colB) ^ (((row) & 7) << 4)))
#define SBAR() __builtin_amdgcn_sched_barrier(0)
__device__ __forceinline__ int crow(int r, int hi) { return (r & 3) + 8 * (r >> 2) + 4 * hi; }
__device__ __forceinline__ unsigned cvtpk(float lo, float hi) { unsigned r; asm volatile("v_cvt_pk_bf16_f32 %0, %1, %2" : "=v"(r) : "v"(lo), "v"(hi)); return r; }

constexpr float THR2 = THR * 1.4426950408889634f;
template <bool FAST> __device__ __forceinline__ void partialSM(f32x16& p0, f32x16& p1, float& m_reg, float& mn, float& alpha) {
  if constexpr (!FAST) {
    float pmax = p0[0];
#pragma unroll
    for (int r = 1; r < 16; ++r) pmax = fmaxf(pmax, p0[r]);
#pragma unroll
    for (int r = 0; r < 16; ++r) pmax = fmaxf(pmax, p1[r]);
    { auto rr = __builtin_amdgcn_permlane32_swap(__float_as_uint(pmax), __float_as_uint(pmax), false, false);
      pmax = fmaxf(__uint_as_float(rr[0]), __uint_as_float(rr[1])); }
    if (__builtin_expect(__all(pmax - m_reg <= THR2), 1)) { mn = m_reg; alpha = 1.f; }
    else { mn = fmaxf(m_reg, pmax); alpha = __builtin_amdgcn_exp2f(m_reg - mn); m_reg = mn; }
#pragma unroll
    for (int r = 0; r < 16; ++r) p0[r] -= mn;
#pragma unroll
    for (int r = 0; r < 16; ++r) p1[r] -= mn;
  } else { alpha = 1.f; mn = 0.f; }
#pragma unroll
  for (int r = 0; r < 16; ++r) p0[r] = __builtin_amdgcn_exp2f(p0[r]);
}
template <bool FAST> __device__ __forceinline__ void finishSM(f32x16& p0, f32x16& p1, float alpha, float& l_reg, bf16x8& pa0, bf16x8& pa1, bf16x8& pa2, bf16x8& pa3) {
#pragma unroll
  for (int r = 0; r < 16; ++r) p1[r] = __builtin_amdgcn_exp2f(p1[r]);
  float ps = 0;
#pragma unroll
  for (int r = 0; r < 16; ++r) ps += p0[r];
#pragma unroll
  for (int r = 0; r < 16; ++r) ps += p1[r];
  { auto rr = __builtin_amdgcn_permlane32_swap(__float_as_uint(ps), __float_as_uint(ps), false, false);
    ps = __uint_as_float(rr[0]) + __uint_as_float(rr[1]); }
  if constexpr (FAST) l_reg += ps; else l_reg = l_reg * alpha + ps;
#define PK4(P, BASE, OUT) do { unsigned a0 = cvtpk(P[BASE + 0], P[BASE + 1]), a1 = cvtpk(P[BASE + 2], P[BASE + 3]);   \
    unsigned b0 = cvtpk(P[BASE + 4], P[BASE + 5]), b1 = cvtpk(P[BASE + 6], P[BASE + 7]);                              \
    auto r0 = __builtin_amdgcn_permlane32_swap(a0, b0, false, false); auto r1 = __builtin_amdgcn_permlane32_swap(a1, b1, false, false); \
    v4u w = {r0[0], r1[0], r0[1], r1[1]}; OUT = *reinterpret_cast<bf16x8*>(&w); } while (0)
  PK4(p0, 0, pa0); PK4(p0, 8, pa1); PK4(p1, 0, pa2); PK4(p1, 8, pa3);
#undef PK4
}
__device__ __forceinline__ void qkt(f32x16& p0, f32x16& p1, const LAS char* Ks, const bf16x8* qr, int r32, int hi) {
  p0 = f32x16{}; p1 = f32x16{};
#if ATTN_KBATCH
  bf16x8 kb0[6], kb1[6];
#pragma unroll
  for (int d0 = 0; d0 < 6; ++d0) { const int cb = (d0 * 16 + hi * 8) * 2; kb0[d0] = *(const LAS bf16x8*)(Ks + KSWZ(r32, cb)); kb1[d0] = *(const LAS bf16x8*)(Ks + KSWZ(32 + r32, cb)); }
  asm volatile("s_waitcnt lgkmcnt(0)" ::: "memory"); SBAR();
#pragma unroll
  for (int d0 = 0; d0 < 6; ++d0) { p0 = __builtin_amdgcn_mfma_f32_32x32x16_bf16(kb0[d0], qr[d0], p0, 0, 0, 0); p1 = __builtin_amdgcn_mfma_f32_32x32x16_bf16(kb1[d0], qr[d0], p1, 0, 0, 0); }
  SBAR();
#else
#pragma unroll
  for (int d0 = 0; d0 < 6; ++d0) { const int cb = (d0 * 16 + hi * 8) * 2;
    const bf16x8 b0 = *(const LAS bf16x8*)(Ks + KSWZ(r32, cb));
    const bf16x8 b1 = *(const LAS bf16x8*)(Ks + KSWZ(32 + r32, cb));
    p0 = __builtin_amdgcn_mfma_f32_32x32x16_bf16(b0, qr[d0], p0, 0, 0, 0);
    p1 = __builtin_amdgcn_mfma_f32_32x32x16_bf16(b1, qr[d0], p1, 0, 0, 0); }
#endif
}
__device__ __forceinline__ int v_st(int k, int c) { const int kk = (k & ~0xC) | ((k & 4) << 1) | ((k & 8) >> 1); return ((kk >> 3) * 2 + (c >> 5)) * 512 + ((kk & 7) * 32 + (c & 31)) * 2; }
__device__ __forceinline__ int v_rd_base(int lane) { return ((lane & 3) << 3) | (((lane >> 2) & 3) << 6) | (((lane >> 4) & 1) << 5) | (((lane >> 5) & 1) << 8); }
constexpr int v_rd_off(int d0, int ks, int half) { return d0 * 512 + ks * 2048 + half * 1024; }
template <int OFF> __device__ __forceinline__ s16x4 tr_read(int vb) {
  s16x4 r; asm volatile("ds_read_b64_tr_b16 %0, %1 offset:%2" : "=&v"(r) : "v"(vb), "i"(OFF) : "memory"); return r;
}
template <int D0> __device__ __forceinline__ void pv_one(f32x16& od, int vb, bf16x8 pa0, bf16x8 pa1, bf16x8 pa2, bf16x8 pa3) {
  const s16x4 l0 = tr_read<v_rd_off(D0, 0, 0)>(vb), h0 = tr_read<v_rd_off(D0, 0, 1)>(vb), l1 = tr_read<v_rd_off(D0, 1, 0)>(vb), h1 = tr_read<v_rd_off(D0, 1, 1)>(vb);
  const s16x4 l2 = tr_read<v_rd_off(D0, 2, 0)>(vb), h2 = tr_read<v_rd_off(D0, 2, 1)>(vb), l3 = tr_read<v_rd_off(D0, 3, 0)>(vb), h3 = tr_read<v_rd_off(D0, 3, 1)>(vb);
  asm volatile("s_waitcnt lgkmcnt(0)" ::: "memory"); SBAR();
#define PK(L, H) (bf16x8){L[0], L[1], L[2], L[3], H[0], H[1], H[2], H[3]}
  od = __builtin_amdgcn_mfma_f32_32x32x16_bf16(pa0, PK(l0, h0), od, 0, 0, 0);
  od = __builtin_amdgcn_mfma_f32_32x32x16_bf16(pa1, PK(l1, h1), od, 0, 0, 0);
  od = __builtin_amdgcn_mfma_f32_32x32x16_bf16(pa2, PK(l2, h2), od, 0, 0, 0);
  od = __builtin_amdgcn_mfma_f32_32x32x16_bf16(pa3, PK(l3, h3), od, 0, 0, 0);
#undef PK
}
__device__ __forceinline__ void pv_d0(f32x16* o, int vb, bf16x8 pa0, bf16x8 pa1, bf16x8 pa2, bf16x8 pa3) {
  pv_one<0>(o[0], vb, pa0, pa1, pa2, pa3); pv_one<1>(o[1], vb, pa0, pa1, pa2, pa3);
}

__device__ __forceinline__ void istep(f32x16& A0, f32x16& A1, f32x16& C0, f32x16& C1, f32x16* o, float& l_reg, const bf16x8* qr, const LAS char* Ks, const LAS char* KsN, const LAS char* Vs,
                                      bf16x8 (&kn)[6], int r32, int hi) {
  bf16x8 kf[12]; const f32x16 z = {};
  float ps; unsigned a0, a1, b0, b1, c0, c1, e0, e1; bf16x8 pa0, pa1, pa2, pa3;
#define KADDR(B, i) ((B) + KSWZ(((i) & 1) * 32 + r32, (((i) >> 1) * 16 + hi * 8) * 2))
#define LDK(i) kf[i] = *(const LAS bf16x8*)KADDR(Ks, i)
#define EX(P, a) do { P[a] = __builtin_amdgcn_exp2f(P[a]); asm volatile("" :: "v"(P[a])); } while (0)
#define MF(X, Y, Z) __builtin_amdgcn_mfma_f32_32x32x16_bf16(X, Y, Z, 0, 0, 0)
  s16x4 l00, h00, l10, h10, l01, h01, l11, h11, l02, h02, l12, h12, l03, h03, l13, h13;
#define TRB(D0, KS, HF) __builtin_amdgcn_ds_read_tr16_b64_v4i16((LAS s16x4*)(Vs + v_rd_off(D0, KS, HF)))
#define VRD(KS) do { l0##KS = TRB(0, KS, 0); h0##KS = TRB(0, KS, 1); l1##KS = TRB(1, KS, 0); h1##KS = TRB(1, KS, 1); } while (0)
#define SWP(OUT, x0, y0, x1, y1) do { auto r0_ = __builtin_amdgcn_permlane32_swap(x0, y0, false, false); auto r1_ = __builtin_amdgcn_permlane32_swap(x1, y1, false, false); \
    v4u w_ = {r0_[0], r1_[0], r0_[1], r1_[1]}; OUT = *reinterpret_cast<bf16x8*>(&w_); } while (0)
#pragma unroll
  for (int i = 0; i < 6; ++i) kf[i] = kn[i];
  LDK(6);  C0 = MF(kf[0], qr[0], z);   ps = A0[0] + A0[1]; ps += A0[2]; ps += A0[3]; EX(A1, 0); EX(A1, 1); SBAR();
  LDK(7);  C1 = MF(kf[1], qr[0], z);   ps += A0[4]; ps += A0[5]; ps += A0[6]; ps += A0[7]; EX(A1, 2); EX(A1, 3); SBAR();
  LDK(8);  C0 = MF(kf[2], qr[1], C0);  ps += A0[8]; ps += A0[9]; ps += A0[10]; ps += A0[11]; EX(A1, 4); EX(A1, 5); SBAR();
  LDK(9);  C1 = MF(kf[3], qr[1], C1);  ps += A0[12]; ps += A0[13]; ps += A0[14]; ps += A0[15]; EX(A1, 6); EX(A1, 7); SBAR();
  LDK(10); C0 = MF(kf[4], qr[2], C0);  a0 = cvtpk(A0[0], A0[1]); a1 = cvtpk(A0[2], A0[3]); b0 = cvtpk(A0[4], A0[5]); b1 = cvtpk(A0[6], A0[7]); EX(A1, 8); EX(A1, 9); SBAR();
  LDK(11); C1 = MF(kf[5], qr[2], C1);  c0 = cvtpk(A0[8], A0[9]); c1 = cvtpk(A0[10], A0[11]); e0 = cvtpk(A0[12], A0[13]); e1 = cvtpk(A0[14], A0[15]); EX(A1, 10); EX(A1, 11); SBAR();
           C0 = MF(kf[6], qr[3], C0);  SWP(pa0, a0, b0, a1, b1); SWP(pa1, c0, e0, c1, e1); EX(A1, 12); EX(A1, 13); SBAR();
           C1 = MF(kf[7], qr[3], C1);  EX(A1, 14); EX(A1, 15); a0 = cvtpk(A1[0], A1[1]); a1 = cvtpk(A1[2], A1[3]); b0 = cvtpk(A1[4], A1[5]); b1 = cvtpk(A1[6], A1[7]); SBAR();
  VRD(0);  C0 = MF(kf[8], qr[4], C0);  c0 = cvtpk(A1[8], A1[9]); c1 = cvtpk(A1[10], A1[11]); e0 = cvtpk(A1[12], A1[13]); e1 = cvtpk(A1[14], A1[15]); SWP(pa2, a0, b0, a1, b1); SBAR();
  VRD(1);  C1 = MF(kf[9], qr[4], C1);  SWP(pa3, c0, e0, c1, e1); ps += A1[0]; ps += A1[1]; ps += A1[2]; ps += A1[3]; SBAR();
  VRD(2);  C0 = MF(kf[10], qr[5], C0); ps += A1[4]; ps += A1[5]; ps += A1[6]; ps += A1[7]; ps += A1[8]; ps += A1[9]; SBAR();
  VRD(3);  C1 = MF(kf[11], qr[5], C1); ps += A1[10]; ps += A1[11]; ps += A1[12]; ps += A1[13]; ps += A1[14]; ps += A1[15]; SBAR();
#define PK(L, H) (bf16x8){L[0], L[1], L[2], L[3], H[0], H[1], H[2], H[3]}
  kn[0] = *(const LAS bf16x8*)KADDR(KsN, 0);
  o[0] = MF(pa0, PK(l00, h00), o[0]); EX(C0, 0);  EX(C0, 1);  SBAR();
  kn[1] = *(const LAS bf16x8*)KADDR(KsN, 1);
  o[1] = MF(pa0, PK(l10, h10), o[1]); EX(C0, 2);  EX(C0, 3);  SBAR();
  kn[2] = *(const LAS bf16x8*)KADDR(KsN, 2);
  o[0] = MF(pa1, PK(l01, h01), o[0]); EX(C0, 4);  EX(C0, 5);  SBAR();
  kn[3] = *(const LAS bf16x8*)KADDR(KsN, 3);
  o[1] = MF(pa1, PK(l11, h11), o[1]); EX(C0, 6);  EX(C0, 7);  SBAR();
  kn[4] = *(const LAS bf16x8*)KADDR(KsN, 4);
  o[0] = MF(pa2, PK(l02, h02), o[0]); EX(C0, 8);  EX(C0, 9);  SBAR();
  kn[5] = *(const LAS bf16x8*)KADDR(KsN, 5);
  o[1] = MF(pa2, PK(l12, h12), o[1]); EX(C0, 10); EX(C0, 11); SBAR();
  o[0] = MF(pa3, PK(l03, h03), o[0]); EX(C0, 12); EX(C0, 13); SBAR();
  o[1] = MF(pa3, PK(l13, h13), o[1]); EX(C0, 14); EX(C0, 15);
  { auto rr = __builtin_amdgcn_permlane32_swap(__float_as_uint(ps), __float_as_uint(ps), false, false); l_reg += __uint_as_float(rr[0]) + __uint_as_float(rr[1]); }
  SBAR();
#undef PK
#undef KADDR
#undef LDK
#undef EX
#undef MF
#undef SWP
#undef TRB
#undef VRD
}

template <bool FAST> __device__ __forceinline__ void attn_unit_t(const bf16* __restrict__ KV, const bf16* __restrict__ KR, bf16* __restrict__ O,
                                          long t0, long kb0, int h, LAS char* lds, const bf16x8 (&qr)[6]) {
  const int tid = otid(), wid = tid >> 6, lane = tid & 63, r32 = lane & 31, hi = lane >> 5;
  LAS char* V_lds = lds; LAS char* K_lds = lds + 2 * SHM_V;
  LAS float* ws = (LAS float*)(lds + 2 * SHM_V + 2 * SHM_K) + wid * 64; LAS float* li_l = ws; LAS float* al_l = ws + 32;
  float m_reg = -1e30f, l_reg = 0; f32x16 o[2] = {};
  const int sr = tid >> 4, kc = tid & 15; const bool kact = kc < 12, krope = kc >= 8;
  const bf16* kptr = krope ? (KR + (kb0 + sr) * LDKR + (kc - 8) * 8) : (KV + (kb0 + sr) * LDKV + h * 128 + kc * 8);
  const long kstr = krope ? LDKR : LDKV;
  const int vr = tid >> 3, vc = (tid & 7) * 8;
  const bf16* vptr = KV + (kb0 + vr) * LDKV + h * 128 + 64 + vc;
  const int vst = v_st(vr, vc), kst0 = KSWZ(sr, kc * 16), kst1 = KSWZ(32 + sr, kc * 16);
  const int vb0 = (int)(uintptr_t)V_lds + v_rd_base(lane);
  struct { bf16x8 vs, ks0, ks1; } sr_[2];
#define SLOAD(i, k0) do { sr_[i].vs = *reinterpret_cast<const bf16x8*>(vptr + (long)(k0) * LDKV); \
    if (kact) { sr_[i].ks0 = *reinterpret_cast<const bf16x8*>(kptr + (long)(k0) * kstr); sr_[i].ks1 = *reinterpret_cast<const bf16x8*>(kptr + (long)((k0) + 32) * kstr); } } while (0)
#define SWRITE(b, i) do { *(LAS bf16x8*)(V_lds + (b) * SHM_V + vst) = sr_[i].vs; \
    if (kact) { *(LAS bf16x8*)(K_lds + (b) * SHM_K + kst0) = sr_[i].ks0; *(LAS bf16x8*)(K_lds + (b) * SHM_K + kst1) = sr_[i].ks1; } } while (0)
#define SWAIT() asm volatile("s_waitcnt vmcnt(3)" ::: "memory")
#define RESC(a) do { if constexpr (!FAST) { if (__any((a) < 1.f)) { if (hi == 0) al_l[r32] = (a); asm volatile("s_waitcnt lgkmcnt(0)" ::: "memory"); \
    _Pragma("unroll") for (int d = 0; d < 2; ++d) _Pragma("unroll") for (int r = 0; r < 16; ++r) o[d][r] *= al_l[crow(r, hi)]; } } } while (0)
  f32x16 pA0, pA1, pB0, pB1; float mnA, mnB, alA, alB; bf16x8 pa0, pa1, pa2, pa3; constexpr int NT = S / KVBLK;
  SLOAD(0, 0); asm volatile("s_waitcnt vmcnt(0)" ::: "memory"); SWRITE(0, 0); __syncthreads();
  qkt(pA0, pA1, K_lds, qr, r32, hi); partialSM<FAST>(pA0, pA1, m_reg, mnA, alA);
  SLOAD(1, KVBLK); SLOAD(0, 2 * KVBLK);
  SWAIT(); SWRITE(1, 1); __syncthreads();
  for (int j = 1; j + 1 < NT; j += 2) {
    SBAR(); qkt(pB0, pB1, K_lds + SHM_K, qr, r32, hi);
    finishSM<FAST>(pA0, pA1, alA, l_reg, pa0, pa1, pa2, pa3); SBAR();
    SLOAD(1, (j + 2) * KVBLK); SBAR();
    pv_d0(o, vb0, pa0, pa1, pa2, pa3); partialSM<FAST>(pB0, pB1, m_reg, mnB, alB);
    __syncthreads(); SWAIT(); SWRITE(0, 0);
    RESC(alB); __syncthreads();
    SBAR(); qkt(pA0, pA1, K_lds, qr, r32, hi);
    finishSM<FAST>(pB0, pB1, alB, l_reg, pa0, pa1, pa2, pa3); SBAR();
    if (j + 3 < NT) SLOAD(0, (j + 3) * KVBLK); SBAR();
    pv_d0(o, vb0 + SHM_V, pa0, pa1, pa2, pa3); partialSM<FAST>(pA0, pA1, m_reg, mnA, alA);
    __syncthreads(); SWAIT(); SWRITE(1, 1);
    RESC(alA); __syncthreads();
  }
  SBAR(); qkt(pB0, pB1, K_lds + SHM_K, qr, r32, hi);
  finishSM<FAST>(pA0, pA1, alA, l_reg, pa0, pa1, pa2, pa3); SBAR();
  pv_d0(o, vb0, pa0, pa1, pa2, pa3); partialSM<FAST>(pB0, pB1, m_reg, mnB, alB);
  __syncthreads(); RESC(alB);
  finishSM<FAST>(pB0, pB1, alB, l_reg, pa0, pa1, pa2, pa3); SBAR();
  pv_d0(o, vb0 + SHM_V, pa0, pa1, pa2, pa3);
  if (hi == 0) li_l[r32] = l_reg; asm volatile("s_waitcnt lgkmcnt(0)" ::: "memory");
  float rli[16];
#pragma unroll
  for (int r = 0; r < 16; ++r) rli[r] = __builtin_amdgcn_rcpf(li_l[crow(r, hi)]);
  bf16* Ow = O + (t0 + wid * QBLK) * LDO + h * 64;
  { LAS bf16* stg = (LAS bf16*)(lds + 53248) + wid * 2048;
#pragma unroll
    for (int r = 0; r < 16; ++r) { const int orow = crow(r, hi);
#pragma unroll
      for (int d0 = 0; d0 < 2; ++d0) stg[orow * 64 + d0 * 32 + r32] = (bf16)(cvtpk(o[d0][r] * rli[r], 0.f) & 0xffffu); }
    asm volatile("s_waitcnt lgkmcnt(0)" ::: "memory");
#pragma unroll
    for (int i = 0; i < 4; ++i) { const int row = i * 8 + (lane >> 3), ch = lane & 7; const v4u v = *(const LAS v4u*)(stg + row * 64 + ch * 8); *(v4u*)(Ow + (long)row * LDO + ch * 8) = v; } }
#undef SLOAD
#undef SWRITE
#undef SWAIT
#undef RESC
  __syncthreads();
}


template <bool FAST> __device__ __forceinline__ void attn_unit_1b(const bf16* __restrict__ KV, const bf16* __restrict__ KR, bf16* __restrict__ O,
                                          long t0, long kb0, int h, LAS char* lds, const bf16x8 (&qr)[6]) {
  const int tid = otid(), wid = tid >> 6, lane = tid & 63, r32 = lane & 31, hi = lane >> 5;
  constexpr int KOFF = 0, VOFF = 3 * SHM_K, WSOFF = 3 * SHM_K + 3 * SHM_V, STGOFF = WSOFF + NW * 256;
  LAS float* ws = (LAS float*)(lds + WSOFF) + wid * 64; LAS float* li_l = ws; LAS float* al_l = ws + 32;
  float m_reg = -1e30f, l_reg = 0; f32x16 o[2] = {};
  const int sr = tid >> 4, kc = tid & 15; const bool kact = kc < 12, krope = kc >= 8;
  const bf16* kptr = krope ? (KR + (kb0 + sr) * LDKR + (kc - 8) * 8) : (KV + (kb0 + sr) * LDKV + h * 128 + kc * 8);
  const long kstr = krope ? LDKR : LDKV;
  const int vr = tid >> 3, vc = (tid & 7) * 8;
  const bf16* vptr = KV + (kb0 + vr) * LDKV + h * 128 + 64 + vc;
  const int vst = VOFF + v_st(vr, vc), kst0 = KOFF + KSWZ(sr, kc * 16), kst1 = KOFF + KSWZ(32 + sr, kc * 16);
  const int vrb = v_rd_base(lane), vb0 = (int)(uintptr_t)lds + VOFF + vrb;
  bf16x8 svs, sk0, sk1;
#define LOADK(t) do { if (kact) { sk0 = *reinterpret_cast<const bf16x8*>(kptr + (long)((t) * KVBLK) * kstr); sk1 = *reinterpret_cast<const bf16x8*>(kptr + (long)((t) * KVBLK + 32) * kstr); } } while (0)
#define LOADV(t) do { svs = *reinterpret_cast<const bf16x8*>(vptr + (long)((t) * KVBLK) * LDKV); } while (0)
#define WRITEK(slot) do { if (kact) { *(LAS bf16x8*)(lds + (slot) * SHM_K + kst0) = sk0; *(LAS bf16x8*)(lds + (slot) * SHM_K + kst1) = sk1; } } while (0)
#define WRITEV(slot) do { *(LAS bf16x8*)(lds + (slot) * SHM_V + vst) = svs; } while (0)
#define OBAR() asm volatile("s_waitcnt lgkmcnt(0)\n\ts_barrier" ::: "memory")
#define RESC(a) do { if constexpr (!FAST) { if (__any((a) < 1.f)) { if (hi == 0) al_l[r32] = (a); asm volatile("s_waitcnt lgkmcnt(0)" ::: "memory"); \
    _Pragma("unroll") for (int d = 0; d < 2; ++d) _Pragma("unroll") for (int r = 0; r < 16; ++r) o[d][r] *= al_l[crow(r, hi)]; } } } while (0)
  f32x16 pA0, pA1, pB0, pB1; float mnA, mnB, alA, alB; bf16x8 pa0, pa1, pa2, pa3; constexpr int NT = S / KVBLK;
  LOADK(0); LOADV(0); asm volatile("s_waitcnt vmcnt(0)" ::: "memory"); WRITEK(0); WRITEV(0);
  LOADK(1); asm volatile("s_waitcnt vmcnt(0)" ::: "memory"); WRITEK(1);
  LOADK(2); LOADV(1); OBAR();
  int kc_ = 0, kn_ = 1, kw_ = 2, vp_ = 2, vc_ = 0, vw_ = 1;
#define ROT() do { const int a_ = kc_; kc_ = kn_; kn_ = kw_; kw_ = a_; const int b_ = vp_; vp_ = vc_; vc_ = vw_; vw_ = b_; } while (0)
  qkt(pA0, pA1, lds + KOFF + kc_ * SHM_K, qr, r32, hi); partialSM<FAST>(pA0, pA1, m_reg, mnA, alA);
  WRITEK(kw_); WRITEV(vw_); LOADK(3); LOADV(2); OBAR(); ROT();
#if ATTN_ISTEP
  if constexpr (FAST) {
#if ATTN_PRIO
    if (wid >= 4) __builtin_amdgcn_s_setprio(1);
#endif
    bf16x8 kn[6];
#pragma unroll
    for (int i = 0; i < 6; ++i) kn[i] = *(const LAS bf16x8*)(lds + KOFF + kc_ * SHM_K + KSWZ((i & 1) * 32 + r32, ((i >> 1) * 16 + hi * 8) * 2));
#pragma unroll 1
    for (int j = 1; j + 1 < NT; j += 2) {
      if (j + 2 < NT) WRITEK(kw_); WRITEV(vw_);
      if (j + 3 < NT) LOADK(j + 3); if (j + 2 < NT) LOADV(j + 2);
      SBAR(); istep(pA0, pA1, pB0, pB1, o, l_reg, qr, lds + KOFF + kc_ * SHM_K, lds + KOFF + kn_ * SHM_K, lds + VOFF + vp_ * SHM_V + vrb, kn, r32, hi);
      OBAR(); ROT();
      if (j + 3 < NT) WRITEK(kw_); if (j + 2 < NT) WRITEV(vw_);
      if (j + 4 < NT) LOADK(j + 4); if (j + 3 < NT) LOADV(j + 3);
      SBAR(); istep(pB0, pB1, pA0, pA1, o, l_reg, qr, lds + KOFF + kc_ * SHM_K, lds + KOFF + kn_ * SHM_K, lds + VOFF + vp_ * SHM_V + vrb, kn, r32, hi);
      OBAR(); ROT();
    }
#if ATTN_PRIO
    __builtin_amdgcn_s_setprio(0);
#endif
  } else
#endif
#pragma unroll 1
  for (int j = 1; j + 1 < NT; j += 2) {
    SBAR(); qkt(pB0, pB1, lds + KOFF + kc_ * SHM_K, qr, r32, hi);
    finishSM<FAST>(pA0, pA1, alA, l_reg, pa0, pa1, pa2, pa3); SBAR();
    pv_d0(o, vb0 + vp_ * SHM_V, pa0, pa1, pa2, pa3); partialSM<FAST>(pB0, pB1, m_reg, mnB, alB);
    if (j + 2 < NT) WRITEK(kw_); WRITEV(vw_);
    if (j + 3 < NT) LOADK(j + 3); if (j + 2 < NT) LOADV(j + 2);
    RESC(alB); OBAR(); ROT();
    SBAR(); qkt(pA0, pA1, lds + KOFF + kc_ * SHM_K, qr, r32, hi);
    finishSM<FAST>(pB0, pB1, alB, l_reg, pa0, pa1, pa2, pa3); SBAR();
    pv_d0(o, vb0 + vp_ * SHM_V, pa0, pa1, pa2, pa3); partialSM<FAST>(pA0, pA1, m_reg, mnA, alA);
    if (j + 3 < NT) WRITEK(kw_); if (j + 2 < NT) WRITEV(vw_);
    if (j + 4 < NT) LOADK(j + 4); if (j + 3 < NT) LOADV(j + 3);
    RESC(alA); OBAR(); ROT();
  }
  SBAR(); qkt(pB0, pB1, lds + KOFF + kc_ * SHM_K, qr, r32, hi);
  finishSM<FAST>(pA0, pA1, alA, l_reg, pa0, pa1, pa2, pa3); SBAR();
  pv_d0(o, vb0 + vp_ * SHM_V, pa0, pa1, pa2, pa3); partialSM<FAST>(pB0, pB1, m_reg, mnB, alB);
  RESC(alB); ROT();
  finishSM<FAST>(pB0, pB1, alB, l_reg, pa0, pa1, pa2, pa3); SBAR();
  pv_d0(o, vb0 + vp_ * SHM_V, pa0, pa1, pa2, pa3);
  if (hi == 0) li_l[r32] = l_reg; asm volatile("s_waitcnt lgkmcnt(0)" ::: "memory");
  float rli[16];
#pragma unroll
  for (int r = 0; r < 16; ++r) rli[r] = __builtin_amdgcn_rcpf(li_l[crow(r, hi)]);
  bf16* Ow = O + (t0 + wid * QBLK) * LDO + h * 64;
  { LAS bf16* stg = (LAS bf16*)(lds + STGOFF) + wid * 2048;
#pragma unroll
    for (int r = 0; r < 16; ++r) { const int orow = crow(r, hi);
#pragma unroll
      for (int d0 = 0; d0 < 2; ++d0) stg[orow * 64 + d0 * 32 + r32] = (bf16)(cvtpk(o[d0][r] * rli[r], 0.f) & 0xffffu); }
    asm volatile("s_waitcnt lgkmcnt(0)" ::: "memory");
#pragma unroll
    for (int i = 0; i < 4; ++i) { const int row = i * 8 + (lane >> 3), ch = lane & 7; const v4u v = *(const LAS v4u*)(stg + row * 64 + ch * 8); *(v4u*)(Ow + (long)row * LDO + ch * 8) = v; } }
#undef LOADK
#undef LOADV
#undef WRITEK
#undef WRITEV
#undef RESC
#undef ROT
  asm volatile("s_waitcnt vmcnt(0) lgkmcnt(0)\n\ts_barrier" ::: "memory");
#undef OBAR
}

__device__ __forceinline__ void attn_unit(const bf16* __restrict__ Q, const bf16* __restrict__ KV, const bf16* __restrict__ KR, bf16* __restrict__ O,
                                          long t0, long kb0, int h, LAS char* lds, float kmax2) {
  const int tid = otid(), wid = tid >> 6, lane = tid & 63, r32 = lane & 31, hi = lane >> 5;
  bf16x8 qr[6];
  const bf16* Qw = Q + (t0 + wid * QBLK + r32) * LDQ + h * DQK + hi * 8;
#pragma unroll
  for (int d0 = 0; d0 < 6; ++d0) qr[d0] = *reinterpret_cast<const bf16x8*>(Qw + d0 * 16);
  float qn2 = 0.f;
#pragma unroll
  for (int d0 = 0; d0 < 6; ++d0) { const v4u w = *reinterpret_cast<const v4u*>(&qr[d0]); f32x4 a, b; unpack8(w, a, b); qn2 += (a[0] * a[0] + a[1] * a[1]) + (a[2] * a[2] + a[3] * a[3]) + (b[0] * b[0] + b[1] * b[1]) + (b[2] * b[2] + b[3] * b[3]); }
  qn2 += __shfl_xor(qn2, 32);
  const bool fast = ATTN_FASTPATH && __all(qn2 * kmax2 * 1.1f < 100.0f * 100.0f);
#if ATTN_ONEBAR
  if (fast) attn_unit_1b<true>(KV, KR, O, t0, kb0, h, lds, qr); else attn_unit_1b<false>(KV, KR, O, t0, kb0, h, lds, qr);
#else
  if (fast) attn_unit_t<true>(KV, KR, O, t0, kb0, h, lds, qr); else attn_unit_t<false>(KV, KR, O, t0, kb0, h, lds, qr);
#endif
}
#undef KSWZ
#undef SBAR
}

struct Args { const float* in[24]; float* out; unsigned char* ws; int p_lo, p_hi; };
enum { I_X = 0, I_C, I_POS, I_WMOD, I_BMOD, I_N1G, I_WIN, I_BGATE, I_QNG, I_WUQ, I_KVNG, I_WUKV, I_WOA, I_WPOOL, I_PSCALE, I_CONVW, I_WOC, I_WOUT, I_N2G, I_WROUTER, I_WGATE, I_WUP, I_WDOWN, I_FINALG };

__device__ __forceinline__ void conv_item(const float* src, int ldsrc, int c0, bf16* dst, int ldd, int dk0, int nblk, int pm, const float* scale, LAS float* scr, int item, int lane, const float* nscale = nullptr) {
    const int kb = item / nblk, nb = item % nblk, k0 = 64 * kb, n0 = 32 * nb;
    float lv[32];
#pragma unroll
    for (int i = 0; i < 32; ++i) { const int kk = 2 * i + (lane >> 5); lv[i] = src[(size_t)(k0 + kk) * ldsrc + c0 + n0 + (lane & 31)]; }
    const float ns = nscale ? nscale[n0 + (lane & 31)] : 1.0f;
#pragma unroll
    for (int i = 0; i < 32; ++i) { const int kk = 2 * i + (lane >> 5); float v = lv[i] * ns; if (scale) v *= scale[k0 + kk]; scr[kk * 33 + (lane & 31)] = v; }
    LDS_WAIT(); asm volatile("" ::: "memory");
    const bool perm = (pm == 1) || (pm == 2 && (nb % 3) == 2);
    const int c = lane & 7;
#pragma unroll
    for (int j = 0; j < 4; ++j) { const int n = (lane >> 3) + 8 * j; const int q = n >> 3, r = n & 7; const int sn = perm ? ((r < 4) ? 4 * q + r : 16 + 4 * q + (r - 4)) : n;
        const LAS float* s = scr + (8 * c) * 33 + sn;
        v4u o; o.x = pk2(s[0 * 33], s[1 * 33]); o.y = pk2(s[2 * 33], s[3 * 33]); o.z = pk2(s[4 * 33], s[5 * 33]); o.w = pk2(s[6 * 33], s[7 * 33]);
        *(v4u*)(dst + (size_t)(n0 + n) * ldd + dk0 + k0 + 8 * c) = o; }
    LDS_WAIT(); asm volatile("" ::: "memory");
}
#define SEG(src, ldsrc, c0, K, dst, ldd, dk0, rows, pm, scale) do { const int nblk_ = (rows) / 32, nit_ = ((K) / 64) * nblk_; \
    for (int it_ = (gw + NGW - rot) % NGW; it_ < nit_; it_ += NGW) conv_item(src, ldsrc, c0, dst, ldd, dk0, nblk_, pm, scale, scr, it_, lane); rot = (rot + nit_) % NGW; } while (0)

constexpr int MOE_GU_ITEMS = 16 * (NE * 2048 / 32), MOE_DN_ITEMS = 16 * (NE * 1024 / 32), MOE_ITEMS = MOE_GU_ITEMS + MOE_DN_ITEMS;
#ifndef CONV_SLOT_A
#define CONV_SLOT_A 0
#endif
#ifndef CONV_SLOT_C
#define CONV_SLOT_C 0
#endif
#ifndef CONV_SLOT_B
#define CONV_SLOT_B 0
#endif
__device__ __forceinline__ void conv_moe_item(const Args& a, unsigned char* wl, int l, int idx, LAS float* scr, int lane) {
    if (idx < MOE_GU_ITEMS) { const int it = idx, kb = it / (NE * 64), nb = it % (NE * 64), e = nb >> 6, rb = nb & 63, pn = rb >> 3, half = (rb >> 2) & 1, sub = rb & 3;
        const float* src = (half ? a.in[I_WUP] : a.in[I_WGATE]) + ((size_t)l * NE + e) * D * FF;
        conv_item(src, FF, 128 * pn + 32 * sub, (bf16*)(wl + WO_GU) + ((size_t)e * 2048 + rb * 32) * D, D, 0, 1, 0, nullptr, scr, kb, lane); }
    else { const int it = idx - MOE_GU_ITEMS, kb = it / (NE * 32), nb = it % (NE * 32), e = nb >> 5, rb = nb & 31;
        conv_item(a.in[I_WDOWN] + ((size_t)l * NE + e) * FF * D, D, 32 * rb, (bf16*)(wl + WO_DN) + ((size_t)e * 1024 + rb * 32) * FF, FF, 0, 1, 0, nullptr, scr, kb, lane); }
}
struct ConvDesc { const float* src; bf16* dst; int ldsrc, ldd; };
__device__ __forceinline__ ConvDesc moe_desc(const Args& a, unsigned char* wl, int l, int idx) {
    ConvDesc d;
    if (idx < MOE_GU_ITEMS) { const int it = idx, kb = it / (NE * 64), nb = it % (NE * 64), e = nb >> 6, rb = nb & 63, pn = rb >> 3, half = (rb >> 2) & 1, sub = rb & 3;
        d.src = (half ? a.in[I_WUP] : a.in[I_WGATE]) + ((size_t)l * NE + e) * D * FF + (size_t)(64 * kb) * FF + 128 * pn + 32 * sub; d.ldsrc = FF;
        d.dst = (bf16*)(wl + WO_GU) + ((size_t)e * 2048 + rb * 32) * D + 64 * kb; d.ldd = D; }
    else { const int it = idx - MOE_GU_ITEMS, kb = it / (NE * 32), nb = it % (NE * 32), e = nb >> 5, rb = nb & 31;
        d.src = a.in[I_WDOWN] + ((size_t)l * NE + e) * FF * D + (size_t)(64 * kb) * D + 32 * rb; d.ldsrc = D;
        d.dst = (bf16*)(wl + WO_DN) + ((size_t)e * 1024 + rb * 32) * FF + 64 * kb; d.ldd = FF; }
    return d;
}
__device__ __forceinline__ void conv_load(const ConvDesc& d, float (&lv)[32], int lane) {
#pragma unroll
    for (int i = 0; i < 32; ++i) { const int kk = 2 * i + (lane >> 5); lv[i] = __builtin_nontemporal_load(d.src + (size_t)kk * d.ldsrc + (lane & 31)); }
}
__device__ __forceinline__ void conv_fin(const ConvDesc& d, const float (&lv)[32], LAS float* scr, int lane) {
#pragma unroll
    for (int i = 0; i < 32; ++i) { const int kk = 2 * i + (lane >> 5); scr[kk * 33 + (lane & 31)] = lv[i]; }
    LDS_WAIT(); asm volatile("" ::: "memory");
    const int c = lane & 7;
#pragma unroll
    for (int j = 0; j < 4; ++j) { const int n = (lane >> 3) + 8 * j; const LAS float* s = scr + (8 * c) * 33 + n;
        v4u o; o.x = pk2(s[0 * 33], s[1 * 33]); o.y = pk2(s[2 * 33], s[3 * 33]); o.z = pk2(s[4 * 33], s[5 * 33]); o.w = pk2(s[6 * 33], s[7 * 33]);
        __builtin_nontemporal_store(o, (v4u*)(d.dst + (size_t)n * d.ldd + 8 * c)); }
    LDS_WAIT(); asm volatile("" ::: "memory");
}
__device__ __forceinline__ void conv_moe_range(const Args& a, LAS unsigned char* lds, int l, int first, int count, int wg, int nwg) {
    const int tid = otid(), lane = tid & 63, wave = tid >> 6;
    LAS float* scr = (LAS float*)(lds + wave * 16384);
    unsigned char* ws = opaque(a.ws); unsigned char* wl = ws + WS_W + (size_t)l * WL_BYTES;
    const int stride = nwg * NWAVES; int i = wg * NWAVES + wave;
    if (i >= count) return;
    ConvDesc dc = moe_desc(a, wl, l, first + i); float lc[32]; conv_load(dc, lc, lane);
#pragma unroll 1
    for (;;) { const int in = i + stride; const bool more = in < count;
        ConvDesc dn = dc; float ln[32];
#pragma unroll
        for (int k = 0; k < 32; ++k) ln[k] = 0.f;
        if (more) { dn = moe_desc(a, wl, l, first + in); conv_load(dn, ln, lane); }
        conv_fin(dc, lc, scr, lane);
        if (!more) break;
        dc = dn; i = in;
#pragma unroll
        for (int k = 0; k < 32; ++k) lc[k] = ln[k]; }
}

constexpr int NONMOE_ITEMS = 192 + 16 + 128 + 2560 + 144 + 128 + 256 + 64 + 256 + 512;
__device__ __forceinline__ void nonmoe_item(const Args& a, unsigned char* ws, int l, int idx, LAS float* scr, int lane) {
    unsigned char* wl = ws + WS_W + (size_t)l * WL_BYTES;
    const float* win = a.in[I_WIN] + (size_t)l * D * NIN_SRC; bf16* WIN = (bf16*)(wl + WO_IN);
    const float* src; int ldsrc, c0, ldd, dk0 = 0, nblk, pm = 0, item; bf16* dst; const float* scale = nullptr; const float* nsc = nullptr;
    if (idx < 192)       { src = win; ldsrc = NIN_SRC; c0 = 0;   dst = WIN; ldd = D; nblk = 12; item = idx; }
    else if (idx < 208)  { src = win; ldsrc = NIN_SRC; c0 = 640; dst = WIN + (size_t)384 * D; ldd = D; nblk = 1; pm = 1; item = idx - 192; }
    else if (idx < 336)  { src = win; ldsrc = NIN_SRC; c0 = 384; dst = WIN + (size_t)512 * D; ldd = D; nblk = 8; item = idx - 208; }
    else if (idx < 2896) { src = win; ldsrc = NIN_SRC; c0 = 672; dst = WIN + (size_t)768 * D; ldd = D; nblk = 160; item = idx - 336; }
    else if (idx < 3040) { src = a.in[I_WUQ] + (size_t)l * QR * 768; ldsrc = 768; c0 = 0; dst = (bf16*)(wl + WO_UQ); ldd = QR; nblk = 24; pm = 2; scale = a.in[I_QNG] + l * QR; item = idx - 2896; }
    else if (idx < 3168) { src = a.in[I_WUKV] + (size_t)l * KVR * 1024; ldsrc = 1024; c0 = 0; dst = (bf16*)(wl + WO_UKV); ldd = KVR; nblk = 32; scale = a.in[I_KVNG] + l * KVR; item = idx - 3040; }
    else if (idx < 3424) { src = a.in[I_WOA] + (size_t)l * 512 * D; ldsrc = D; c0 = 0; dst = (bf16*)(wl + WO_OA); ldd = 512; nblk = 32; item = idx - 3168; }
    else if (idx < 3488) { const int g = (idx - 3424) >> 4; src = a.in[I_WPOOL] + ((size_t)l * 4 + g) * 128 * 256; ldsrc = 256; c0 = 0; dst = (bf16*)(wl + WO_POOL) + (size_t)(g * 256) * 512; ldd = 512; dk0 = g * 128; nblk = 8;
                           nsc = MERGE_FUSED ? a.in[I_PSCALE] + (size_t)l * D + g * 256 : (const float*)nullptr; item = (idx - 3424) & 15; }
    else if (idx < 3744) { src = a.in[I_WOC] + (size_t)l * 512 * D; ldsrc = D; c0 = 0; dst = (bf16*)(wl + WO_OC); ldd = 512; nblk = 32; item = idx - 3488; }
    else                 { src = a.in[I_WOUT] + (size_t)l * D * D; ldsrc = D; c0 = 0; dst = (bf16*)(wl + WO_OUT); ldd = D; nblk = 32; item = idx - 3744; }
    conv_item(src, ldsrc, c0, dst, ldd, dk0, nblk, pm, scale, scr, item, lane, nsc);
}
constexpr int NQ = 7, CW_Q = 8192;
__device__ __forceinline__ int q_count(int q, int G) { return (q & 1) ? NONMOE_ITEMS : MOE_ITEMS - ((G == 256) ? CONV_SLOT_A + CONV_SLOT_C + CONV_SLOT_B : 0); }
__device__ __forceinline__ bool conv_steal(const Args& a, LAS unsigned char* lds, volatile LAS unsigned* mw, int& qcur, int qmax, int G) {
    const int tid = otid(), lane = tid & 63, wave = __builtin_amdgcn_readfirstlane(tid >> 6);
    unsigned char* ws = opaque(a.ws); unsigned* ctl = (unsigned*)(ws + WS_CTL);
    while (qcur < qmax) {
        const int cnt = q_count(qcur, G); const bool moe = (qcur & 1) == 0;
        if (threadIdx.x == 0) mw[3] = __hip_atomic_fetch_add(ctl + CW_Q + 64 * qcur, moe ? 16u : 8u, __ATOMIC_RELAXED, __HIP_MEMORY_SCOPE_AGENT);
        __syncthreads();
        const unsigned base = mw[3];
        __syncthreads();
        if (base < (unsigned)cnt) { LAS float* scr = (LAS float*)(lds + wave * 16384);
            if (moe) { const int l = qcur >> 1, first = MOE_ITEMS - cnt, i0 = (int)base + wave, i1 = i0 + 8; unsigned char* wl = ws + WS_W + (size_t)l * WL_BYTES;
                if (i0 < cnt) { const ConvDesc d0 = moe_desc(a, wl, l, first + i0); float b0[32]; conv_load(d0, b0, lane);
                    if (i1 < cnt) { const ConvDesc d1 = moe_desc(a, wl, l, first + i1); float b1[32]; conv_load(d1, b1, lane); conv_fin(d0, b0, scr, lane); conv_fin(d1, b1, scr, lane); }
                    else conv_fin(d0, b0, scr, lane); } }
            else { const int idx = (int)base + wave; if (idx < cnt) nonmoe_item(a, ws, (qcur + 1) >> 1, idx, scr, lane); }
            return true; }
        ++qcur;
    }
    return false;
}
__device__ __forceinline__ void conv_drain(const Args& a, LAS unsigned char* lds, volatile LAS unsigned* mw, int& qcur, int qmax, int G) { while (conv_steal(a, lds, mw, qcur, qmax, G)) { } __syncthreads(); }

__device__ __forceinline__ void phase_prologue(const Args& a, LAS unsigned char* lds, int vcu, int G) {
    const int tid = otid(), lane = tid & 63, wave = tid >> 6;
    LAS float* scr = (LAS float*)(lds + wave * 16384);
    const int gw = vcu * NWAVES + wave, NGW = G * NWAVES; int rot = 0;
    unsigned char* ws = opaque(a.ws);
    for (int it = gw; it < NONMOE_ITEMS; it += NGW) nonmoe_item(a, ws, 0, it, scr, lane);
    const size_t gt = (size_t)vcu * 512 + tid, ngt = (size_t)G * 512;
    for (size_t i = gt; i < (size_t)NL * 96 * 128; i += ngt) { const int l = (int)(i / (96 * 128)), r = (int)(i % (96 * 128));
        *(v4u*)(ws + WS_W + (size_t)l * WL_BYTES + WO_IN + ((size_t)(416 + r / 128) * D + (r % 128) * 8) * 2) = (v4u){0u, 0u, 0u, 0u}; }
    for (size_t i = gt; i < (size_t)NL * 1024 * 64; i += ngt) { const int l = (int)(i / (1024 * 64)), r = (int)(i % (1024 * 64)), n = r >> 6, ch = r & 63;
        if ((ch >> 4) != (n >> 8)) *(v4u*)(ws + WS_W + (size_t)l * WL_BYTES + WO_POOL + ((size_t)n * 512 + ch * 8) * 2) = (v4u){0u, 0u, 0u, 0u}; }
    { float* COS = (float*)(ws + WS_COS); float* SIN = (float*)(ws + WS_SIN); const int* pos = (const int*)a.in[I_POS];
      for (size_t i = gt; i < (size_t)T * 16; i += ngt) { const int t = (int)(i >> 4), j = (int)(i & 15);
          const float freq = (float)pow(10000.0, -(double)(2 * j) / 32.0); const float ang = (float)pos[t] * freq;
          COS[i] = (float)cos((double)ang); SIN[i] = (float)sin((double)ang); } }
    __syncthreads();
    { LAS float* cact = (LAS float*)lds;
      LAS float* red = (LAS float*)(lds + 16384);
      for (int i = tid; i < NB * D; i += 512) { const float c = a.in[I_C][i]; cact[i] = c / (1.0f + __expf(-c)); }
      __syncthreads();
      for (int cb = blockIdx.x; cb < 256; cb += G) { const int l = cb >> 6, n0 = (cb & 63) * 96;
          const float* wm = a.in[I_WMOD] + (size_t)l * D * 6144 + n0;
          float acc0[4] = {0.f, 0.f, 0.f, 0.f}, acc1[4] = {0.f, 0.f, 0.f, 0.f};
          for (int k0 = wave * 128; k0 < wave * 128 + 128; k0 += 8) { float w0[8], w1[8];
#pragma unroll
              for (int kk = 0; kk < 8; ++kk) { w0[kk] = wm[(size_t)(k0 + kk) * 6144 + lane]; w1[kk] = lane < 32 ? wm[(size_t)(k0 + kk) * 6144 + 64 + lane] : 0.f; }
#pragma unroll
              for (int kk = 0; kk < 8; ++kk)
#pragma unroll
                  for (int b = 0; b < 4; ++b) { const float c = cact[b * D + k0 + kk]; acc0[b] += c * w0[kk]; acc1[b] += c * w1[kk]; } }
#pragma unroll
          for (int b = 0; b < 4; ++b) { red[(wave * 4 + b) * 96 + lane] = acc0[b]; if (lane < 32) red[(wave * 4 + b) * 96 + 64 + lane] = acc1[b]; }
          __syncthreads();
          if (tid < 384) { const int b = tid / 96, n = tid % 96; float s = a.in[I_BMOD][l * 6144 + n0 + n];
#pragma unroll
              for (int w = 0; w < 8; ++w) s += red[(w * 4 + b) * 96 + n];
              ((float*)(ws + WS_MOD))[((size_t)l * NB + b) * 6144 + n0 + n] = s; }
          __syncthreads(); } }
}
#undef SEG

__device__ __forceinline__ void phase_norm1(const Args& a, int l, int vcu, int G) {
    const int tid = otid(), lane = tid & 63, wave = tid >> 6;
    unsigned char* ws = opaque(a.ws);
    float* X = (float*)(ws + WS_X); bf16* H = (bf16*)(ws + WS_H); const bf16* Y = (const bf16*)(ws + WS_Y); const int* SLOT = (const int*)(ws + WS_SLOT); const float* AFF = (const float*)(ws + WS_AFF);
    const float* MOD = (const float*)(ws + WS_MOD);
    if (l < NL && blockIdx.x == 0 && tid < 128) __hip_atomic_store((unsigned*)(ws + WS_KMAX) + tid, 0u, __ATOMIC_RELAXED, __HIP_MEMORY_SCOPE_AGENT);
    const float* xsrc = (l == 0 ? a.in[I_X] : X);
    const int rpw = (T + G * NWAVES - 1) / (G * NWAVES);
    int t = (vcu * NWAVES + wave) * rpw; const int tend = min(t + rpw, T);
    f32x4 vn[4]; int svn = -1; float tvn = 0.f;
    f32x4 g2v[4], gg[4], s1v[4], h1v[4]; int bcur = -1;
    { const float* g = (l < NL) ? a.in[I_N1G] + l * D : a.in[I_FINALG];
#pragma unroll
      for (int j = 0; j < 4; ++j) gg[j] = ((const f32x4*)g)[lane + 64 * j]; }
    if (t < tend) {
#pragma unroll
        for (int j = 0; j < 4; ++j) vn[j] = ((const f32x4*)(xsrc + (size_t)t * D))[lane + 64 * j];
        if (l > 0 && lane < NE) { svn = SLOT[((t / S) * NE + lane) * S + t % S]; tvn = AFF[((t / S) * NE + lane) * S + t % S]; } }
    for (; t < tend; ++t) {
        const int b = t / S;
        f32x4 v[4]; const int sv = svn; const float tv = tvn;
#pragma unroll
        for (int j = 0; j < 4; ++j) v[j] = vn[j];
        unsigned long long mask = (l > 0) ? __ballot(sv >= 0) : 0ull;
        const bool any = mask != 0; bool two = false; v2u w0[4], w1[4]; float tv0 = 0.f, tv1 = 0.f;
        if (any) { const int e0 = __builtin_ctzll(mask); mask &= mask - 1; two = mask != 0; const int e1 = two ? __builtin_ctzll(mask) : e0; if (two) mask &= mask - 1;
            const int s0 = __shfl(sv, e0), s1 = __shfl(sv, e1); tv0 = __shfl(tv, e0); tv1 = __shfl(tv, e1);
            const bf16* y0 = Y + ((size_t)((b * NE + e0) * CAP + s0)) * D; const bf16* y1 = Y + ((size_t)((b * NE + e1) * CAP + s1)) * D;
#pragma unroll
            for (int j = 0; j < 4; ++j) { w0[j] = ((const v2u*)y0)[lane + 64 * j]; w1[j] = ((const v2u*)y1)[lane + 64 * j]; } }
        if (b != bcur) { bcur = b; const float* g2 = MOD + ((size_t)(l > 0 ? l - 1 : 0) * NB + b) * 6144 + 5 * D;
          const float* sh = MOD + ((size_t)(l < NL ? l : 0) * NB + b) * 6144; const float* sc = sh + D;
#pragma unroll
          for (int j = 0; j < 4; ++j) { g2v[j] = ((const f32x4*)g2)[lane + 64 * j]; s1v[j] = ((const f32x4*)sc)[lane + 64 * j] + 1.0f; h1v[j] = ((const f32x4*)sh)[lane + 64 * j]; } }
        asm volatile("" ::: "memory");
        if (t + 1 < tend) { const int tn = t + 1;
#pragma unroll
            for (int j = 0; j < 4; ++j) vn[j] = ((const f32x4*)(xsrc + (size_t)tn * D))[lane + 64 * j];
            if (l > 0 && lane < NE) { svn = SLOT[((tn / S) * NE + lane) * S + tn % S]; tvn = AFF[((tn / S) * NE + lane) * S + tn % S]; } }
        asm volatile("" ::: "memory");
        if (l > 0) {
            f32x4 acc[4];
#pragma unroll
            for (int j = 0; j < 4; ++j) acc[j] = (f32x4){0.f, 0.f, 0.f, 0.f};
            if (any) {
#pragma unroll
                for (int j = 0; j < 4; ++j) { acc[j] += (f32x4){bflo(w0[j].x), bfhi(w0[j].x), bflo(w0[j].y), bfhi(w0[j].y)} * tv0;
                    if (two) acc[j] += (f32x4){bflo(w1[j].x), bfhi(w1[j].x), bflo(w1[j].y), bfhi(w1[j].y)} * tv1; } }
            while (mask) {
                const int e0 = __builtin_ctzll(mask); mask &= mask - 1; const int s0 = __shfl(sv, e0); const float tve = __shfl(tv, e0);
                const bf16* y0 = Y + ((size_t)((b * NE + e0) * CAP + s0)) * D;
#pragma unroll
                for (int j = 0; j < 4; ++j) { const v2u w = ((const v2u*)y0)[lane + 64 * j]; acc[j] += (f32x4){bflo(w.x), bfhi(w.x), bflo(w.y), bfhi(w.y)} * tve; } }
#pragma unroll
            for (int j = 0; j < 4; ++j) v[j] += g2v[j] * acc[j];
            if (l < NL) {
#pragma unroll
                for (int j = 0; j < 4; ++j) ((f32x4*)(X + (size_t)t * D))[lane + 64 * j] = v[j]; }
        }
        float ssq = 0.f;
#pragma unroll
        for (int j = 0; j < 4; ++j) ssq += (v[j][0] * v[j][0] + v[j][1] * v[j][1]) + (v[j][2] * v[j][2] + v[j][3] * v[j][3]);
        const float rstd = 1.0f / sqrtf(wave_sum(ssq) * (1.0f / D) + EPS);
        if (l < NL) {
#pragma unroll
            for (int j = 0; j < 4; ++j) { const f32x4 o = v[j] * rstd * gg[j] * s1v[j] + h1v[j];
                ((v2u*)(H + (size_t)t * D))[lane + 64 * j] = (v2u){pk2(o[0], o[1]), pk2(o[2], o[3])}; }
        } else {
#pragma unroll
            for (int j = 0; j < 4; ++j) ((f32x4*)(a.out + (size_t)t * D))[lane + 64 * j] = v[j] * rstd * gg[j];
        }
    }
}

__device__ __forceinline__ void st8(bf16* p, const f32x4& x0, const f32x4& x1) { *(v4u*)p = pack8(x0, x1); }
__device__ __forceinline__ float ssq8(const f32x4& x0, const f32x4& x1) { return (x0[0] * x0[0] + x0[1] * x0[1]) + (x0[2] * x0[2] + x0[3] * x0[3]) + (x1[0] * x1[0] + x1[1] * x1[1]) + (x1[2] * x1[2] + x1[3] * x1[3]); }
__device__ __forceinline__ void row_part(float* p, float s) { s += __shfl_xor(s, 16); s += __shfl_xor(s, 32); if ((otid() & 63) < 16) *p = s; }
__device__ __forceinline__ void row_max_atomic(unsigned* p, float s) { if (!KMAX_ATOMICS) return; s += __shfl_xor(s, 16); s += __shfl_xor(s, 32); s = fmaxf(s, __shfl_xor(s, 1)); s = fmaxf(s, __shfl_xor(s, 2)); s = fmaxf(s, __shfl_xor(s, 4)); s = fmaxf(s, __shfl_xor(s, 8));
    if (KMAX_ATOMICS && (otid() & 63) == 0) atomicMax(p, __float_as_uint(s)); }
__device__ __forceinline__ void rope8(f32x4& x1, f32x4& x2, const float* cs, const float* sn, int qi) {
    const f32x4 c = *(const f32x4*)(cs + 4 * qi), s = *(const f32x4*)(sn + 4 * qi);
    const f32x4 o1 = x1 * c - x2 * s, o2 = x1 * s + x2 * c; x1 = o1; x2 = o2;
}
struct KCarry { float a = 0.f, b = 0.f; };
struct FProj { static constexpr bool IDEMPOTENT = true;
    bf16 *CQ, *CKV, *KR, *U, *CV, *GT; float* PART; const float *COS, *SIN; const LAS float* bgate; unsigned* KMAX;
    typedef KCarry Carry;
    struct L { f32x4 x0, x1, x2, x3; };
    __device__ __forceinline__ L pre(const pg8::Unit& u, int row, int col) const { L r; const f32x4 z = {0.f, 0.f, 0.f, 0.f}; r.x0 = z; r.x1 = z; r.x2 = z; r.x3 = z;
        if (u.pn >= 11) { const int c = col - 2816; r.x0 = *(const LAS f32x4*)(bgate + c); r.x1 = *(const LAS f32x4*)(bgate + c + 4); r.x2 = *(const LAS f32x4*)(bgate + c + 128); r.x3 = *(const LAS f32x4*)(bgate + c + 132); }
        else if (u.pn == 1 && col + 128 < 416) { const int qi = (col + 128 - 384) >> 3; r.x0 = *(const f32x4*)(COS + (size_t)row * 16 + 4 * qi); r.x1 = *(const f32x4*)(SIN + (size_t)row * 16 + 4 * qi); }
        return r; }
    __device__ __forceinline__ void post(const pg8::Unit& u, int row, int col, const L& ld, const f32x4& a0, const f32x4& a1, const f32x4& b0, const f32x4& b1, Carry& cy) const {
        const int pn = u.pn;
        if (pn >= 11) { const int c = col - 2816;
            f32x4 x0, x1, y0, y1;
#pragma unroll
            for (int i = 0; i < 4; ++i) { x0[i] = sigmoidf_(a0[i] + ld.x0[i]); x1[i] = sigmoidf_(a1[i] + ld.x1[i]); y0[i] = sigmoidf_(b0[i] + ld.x2[i]); y1[i] = sigmoidf_(b1[i] + ld.x3[i]); }
            st8(GT + (size_t)row * 3072 + c, x0, x1); st8(GT + (size_t)row * 3072 + c + 128, y0, y1);
        } else if (pn >= 5) { st8(CV + (size_t)row * 1536 + (col - 1280), a0, a1); st8(CV + (size_t)row * 1536 + (col - 1280) + 128, b0, b1);
        } else if (pn >= 3) { st8(U + (size_t)row * 512 + (col - 768), a0, a1); st8(U + (size_t)row * 512 + (col - 768) + 128, b0, b1);
        } else if (pn == 2) { st8(CKV + (size_t)row * KVR + (col - 512), a0, a1); st8(CKV + (size_t)row * KVR + (col - 512) + 128, b0, b1);
            row_part(PART + (size_t)row * 16 + 8 + ((col >> 5) & 3), ssq8(a0, a1) + ssq8(b0, b1));
        } else if (pn == 0) { st8(CQ + (size_t)row * QR + col, a0, a1); st8(CQ + (size_t)row * QR + col + 128, b0, b1);
            row_part(PART + (size_t)row * 16 + ((col >> 5) & 3), ssq8(a0, a1) + ssq8(b0, b1));
        } else { st8(CQ + (size_t)row * QR + col, a0, a1); row_part(PART + (size_t)row * 16 + 4 + ((col >> 5) & 3), ssq8(a0, a1));
            const int cb = col + 128;
            if (cb < 416) { const f32x4 o1 = b0 * ld.x0 - b1 * ld.x1, o2 = b0 * ld.x1 + b1 * ld.x0; st8(KR + (size_t)row * 32 + (cb - 384), o1, o2);
                float q = ssq8(b0, b1); q += __shfl_xor(q, 16); q += __shfl_xor(q, 32); cy.a = fmaxf(cy.a, q); }
        }
    }
    __device__ __forceinline__ void finish(const pg8::Unit& u, int wr, int wc, const Carry& cy) const {
        if (u.pn == 1 && wc == 0) { float q = cy.a; q = fmaxf(q, __shfl_xor(q, 1)); q = fmaxf(q, __shfl_xor(q, 2)); q = fmaxf(q, __shfl_xor(q, 4)); q = fmaxf(q, __shfl_xor(q, 8));
            if ((otid() & 63) == 0) ((float*)KMAX)[(((u.pm >> 4) * (NH * 2 + 1)) + NH * 2) * 32 + (u.pm & 15) * 2 + wr] = q; } }
};
struct FQ { static constexpr bool IDEMPOTENT = true;
    bf16* Q; const float *PART, *COS, *SIN;
    typedef NoCarry Carry;
    struct L { f32x4 p0, p1, c, s; };
    __device__ __forceinline__ L pre(const pg8::Unit& u, int row, int col) const { L r; r.p0 = *(const f32x4*)(PART + (size_t)row * 16); r.p1 = *(const f32x4*)(PART + (size_t)row * 16 + 4);
        const int qi = (col & 31) >> 3; r.c = *(const f32x4*)(COS + (size_t)row * 16 + 4 * qi); r.s = *(const f32x4*)(SIN + (size_t)row * 16 + 4 * qi); return r; }
    __device__ __forceinline__ void post(const pg8::Unit& u, int row, int col, const L& ld, const f32x4& a0, const f32x4& a1, const f32x4& b0, const f32x4& b1, Carry& cy) const {
        const float rstd = 1.0f / sqrtf((((ld.p0[0] + ld.p0[1]) + (ld.p0[2] + ld.p0[3])) + ((ld.p1[0] + ld.p1[1]) + (ld.p1[2] + ld.p1[3]))) * (1.0f / QR) + EPS);
        const float rq = rstd * QSCALE;
        f32x4 x0 = a0 * rq, x1 = a1 * rq, y0 = b0 * rq, y1 = b1 * rq;
        const int ga = col >> 5, gb = ga + 4;
        if (ga % 3 == 2) { const f32x4 o1 = x0 * ld.c - x1 * ld.s, o2 = x0 * ld.s + x1 * ld.c; x0 = o1; x1 = o2; }
        if (gb % 3 == 2) { const f32x4 o1 = y0 * ld.c - y1 * ld.s, o2 = y0 * ld.s + y1 * ld.c; y0 = o1; y1 = o2; }
        st8(Q + (size_t)row * 768 + col, x0, x1); st8(Q + (size_t)row * 768 + col + 128, y0, y1);
    }
    __device__ __forceinline__ void finish(const pg8::Unit&, int, int, const Carry&) const {}
};
struct FKV { static constexpr bool IDEMPOTENT = true;
    bf16* KV; const float* PART; unsigned* KMAX;
    typedef KCarry Carry;
    struct L { f32x4 p0; };
    __device__ __forceinline__ L pre(const pg8::Unit& u, int row, int col) const { L r; r.p0 = *(const f32x4*)(PART + (size_t)row * 16 + 8); return r; }
    __device__ __forceinline__ void post(const pg8::Unit& u, int row, int col, const L& ld, const f32x4& a0, const f32x4& a1, const f32x4& b0, const f32x4& b1, Carry& cy) const {
        const float rstd = 1.0f / sqrtf(((ld.p0[0] + ld.p0[1]) + (ld.p0[2] + ld.p0[3])) * (1.0f / KVR) + EPS);
        st8(KV + (size_t)row * 1024 + col, a0 * rstd, a1 * rstd); st8(KV + (size_t)row * 1024 + col + 128, b0 * rstd, b1 * rstd);
        const int wc = (col >> 5) & 7;
        if (wc < 2) { float qa = ssq8(a0, a1) * rstd * rstd, qb = ssq8(b0, b1) * rstd * rstd; qa += __shfl_xor(qa, 16); qa += __shfl_xor(qa, 32); qb += __shfl_xor(qb, 16); qb += __shfl_xor(qb, 32);
            cy.a = fmaxf(cy.a, qa); cy.b = fmaxf(cy.b, qb); }
    }
    __device__ __forceinline__ void finish(const pg8::Unit& u, int wr, int wc, const Carry& cy) const {
        if (wc < 2) { float qa = cy.a, qb = cy.b;
#pragma unroll
            for (int o = 1; o < 16; o <<= 1) { qa = fmaxf(qa, __shfl_xor(qa, o)); qb = fmaxf(qb, __shfl_xor(qb, o)); }
            if ((otid() & 63) == 0) { float* kn = (float*)KMAX + (size_t)(u.pm >> 4) * (NH * 2 + 1) * 32; const int sl = (u.pm & 15) * 2 + wr;
                kn[((u.pn * 2) * 2 + wc) * 32 + sl] = qa; kn[((u.pn * 2 + 1) * 2 + wc) * 32 + sl] = qb; } } }
};
template <int MODE> struct FMerge { static constexpr bool IDEMPOTENT = false;
    bf16* MG; const bf16* GT; const float* ps;
    static constexpr int goff = MODE == 0 ? 0 : (MODE == 1 ? 2048 : 1024);
    typedef NoCarry Carry;
    struct L { v4u ga, gb, ma, mb; };
    __device__ __forceinline__ L pre(const pg8::Unit& u, int row, int col) const { L r; r.ga = *(const v4u*)(GT + (size_t)row * 3072 + goff + col); r.gb = *(const v4u*)(GT + (size_t)row * 3072 + goff + col + 128);
        if (MODE != 0) { r.ma = *(const v4u*)(MG + (size_t)row * D + col); r.mb = *(const v4u*)(MG + (size_t)row * D + col + 128); } else { r.ma = r.ga; r.mb = r.gb; }
        return r; }
    __device__ __forceinline__ void one(int row, int c, const v4u& gw, const v4u& mw, const f32x4& v0, const f32x4& v1) const {
        f32x4 g0, g1; unpack8(gw, g0, g1);
        f32x4 r0 = g0 * v0, r1 = g1 * v1;
        if (MODE == 2) { r0 = r0 * *(const f32x4*)(ps + c); r1 = r1 * *(const f32x4*)(ps + c + 4); }
        if (MODE != 0) { f32x4 m0, m1; unpack8(mw, m0, m1); r0 += m0; r1 += m1; }
        st8(MG + (size_t)row * D + c, r0, r1);
    }
    __device__ __forceinline__ void post(const pg8::Unit& u, int row, int col, const L& ld, const f32x4& a0, const f32x4& a1, const f32x4& b0, const f32x4& b1, Carry& cy) const { one(row, col, ld.ga, ld.ma, a0, a1); one(row, col + 128, ld.gb, ld.mb, b0, b1); }
    __device__ __forceinline__ void finish(const pg8::Unit&, int, int, const Carry&) const {}
};
struct FOut { static constexpr bool IDEMPOTENT = false;
    const float* xin; float* X; const float* g1;
    typedef NoCarry Carry;
    struct L { f32x4 x0, x1, x2, x3; };
    __device__ __forceinline__ L pre(const pg8::Unit& u, int row, int col) const { L r; const float* xi = xin + (size_t)row * D + col;
        r.x0 = *(const f32x4*)xi; r.x1 = *(const f32x4*)(xi + 4); r.x2 = *(const f32x4*)(xi + 128); r.x3 = *(const f32x4*)(xi + 132); return r; }
    __device__ __forceinline__ void post(const pg8::Unit& u, int row, int col, const L& ld, const f32x4& a0, const f32x4& a1, const f32x4& b0, const f32x4& b1, Carry& cy) const {
        const float* g = g1 + (size_t)(row / S) * 6144 + col; float* xo = X + (size_t)row * D + col;
        *(f32x4*)xo = ld.x0 + *(const f32x4*)g * a0; *(f32x4*)(xo + 4) = ld.x1 + *(const f32x4*)(g + 4) * a1;
        *(f32x4*)(xo + 128) = ld.x2 + *(const f32x4*)(g + 128) * b0; *(f32x4*)(xo + 132) = ld.x3 + *(const f32x4*)(g + 132) * b1;
    }
    __device__ __forceinline__ void finish(const pg8::Unit&, int, int, const Carry&) const {}
};
struct FGu { static constexpr bool IDEMPOTENT = true;
    bf16* ACT;
    typedef NoCarry Carry;
    struct L { };
    __device__ __forceinline__ L pre(const pg8::Unit& u, int row, int col) const { return L{}; }
    __device__ __forceinline__ void post(const pg8::Unit& u, int row, int col, const L& ld, const f32x4& a0, const f32x4& a1, const f32x4& b0, const f32x4& b1, Carry& cy) const {
        const int oc = (u.pn & 7) * 128 + (col & 255);
        f32x4 r0, r1;
#pragma unroll
        for (int i = 0; i < 4; ++i) { r0[i] = a0[i] * __builtin_amdgcn_rcpf(1.0f + __expf(-a0[i])) * b0[i]; r1[i] = a1[i] * __builtin_amdgcn_rcpf(1.0f + __expf(-a1[i])) * b1[i]; }
        st8(ACT + (size_t)row * FF + oc, r0, r1);
    }
    __device__ __forceinline__ void finish(const pg8::Unit&, int, int, const Carry&) const {}
};
struct FDn { static constexpr bool IDEMPOTENT = true;
    bf16* Y;
    typedef NoCarry Carry;
    struct L { };
    __device__ __forceinline__ L pre(const pg8::Unit& u, int row, int col) const { return L{}; }
    __device__ __forceinline__ void post(const pg8::Unit& u, int row, int col, const L& ld, const f32x4& a0, const f32x4& a1, const f32x4& b0, const f32x4& b1, Carry& cy) const {
        const int oc = (u.pn & 3) * 256 + (col & 255);
        st8(Y + (size_t)row * D + oc, a0, a1); st8(Y + (size_t)row * D + oc + 128, b0, b1);
    }
    __device__ __forceinline__ void finish(const pg8::Unit&, int, int, const Carry&) const {}
};
struct MUnit { int pm, pn, seg; };
struct MergeSched {
    typedef MUnit U;
    pg8::StaticOrder so; const char *ws, *wl;
    __device__ __forceinline__ bool next(int i, MUnit& u) const { const int tile = i / 3; pg8::Unit t; if (!so.next(tile, t)) return false; u.pm = t.pm; u.pn = t.pn; u.seg = i - 3 * tile; return true; }
    __device__ __forceinline__ const char* baseA(const MUnit& u) const { const size_t off = u.seg == 0 ? WS_O : (u.seg == 1 ? WS_CY : WS_MIX); return ws + off + (size_t)u.pm * (256 * 512 * 2) + (u.seg == 2 ? u.pn * 256 : 0); }
    __device__ __forceinline__ const char* baseB(const MUnit& u) const { const size_t off = u.seg == 0 ? WO_OA : (u.seg == 1 ? WO_OC : WO_POOL); return wl + off + (size_t)u.pn * (256 * 512 * 2) + (u.seg == 2 ? u.pn * 256 : 0); }
    __device__ __forceinline__ int nt(const MUnit& u) const { return u.seg == 2 ? 2 : 8; }
    __device__ __forceinline__ bool keep(const MUnit& u) const { return u.seg != 2; }
    __device__ __forceinline__ void a_ready(const MUnit&) const {}
    __device__ __forceinline__ void done(const MUnit&) const {}
};
struct EMergeFused {
    static constexpr bool PERM = true, AFTER_DRAIN = false; static constexpr int MB = 2;
    bf16* MG; const bf16* GT;
    __device__ __forceinline__ static void ratio8(const v4u& nw, const v4u& dw, f32x4& r0, f32x4& r1) { f32x4 n0, n1, d0, d1; unpack8(nw, n0, n1); unpack8(dw, d0, d1);
#pragma unroll
        for (int i = 0; i < 4; ++i) { r0[i] = n0[i] * __builtin_amdgcn_rcpf(d0[i]); r1[i] = n1[i] * __builtin_amdgcn_rcpf(d1[i]); } }
    __device__ __forceinline__ void operator()(f32x4 (&acc)[2][2][4][2], const MUnit& u, int wr, int wc, int fr, int fq) const {
        const int row0 = u.pm * 256 + wr * 64 + fr, col = u.pn * 256 + wc * 32 + 8 * fq;
        const int noff = u.seg == 0 ? 0 : (u.seg == 1 ? 2048 : 1024), doff = u.seg == 0 ? 2048 : 1024;
#pragma unroll
        for (int g0 = 0; g0 < 8; g0 += MB) {
            v4u na[MB], nb[MB], da[MB], db[MB];
#pragma unroll
            for (int k = 0; k < MB; ++k) { const int ai = (g0 + k) >> 2, m = (g0 + k) & 3; const bf16* gp = GT + (size_t)(row0 + ai * 128 + m * 16) * 3072 + col;
                na[k] = *(const v4u*)(gp + noff); nb[k] = *(const v4u*)(gp + noff + 128);
                if (u.seg != 2) { da[k] = *(const v4u*)(gp + doff); db[k] = *(const v4u*)(gp + doff + 128); } else { da[k] = na[k]; db[k] = nb[k]; } }
#pragma unroll
            for (int k = 0; k < MB; ++k) { const int ai = (g0 + k) >> 2, m = (g0 + k) & 3;
                if (u.seg != 2) { f32x4 r0, r1; ratio8(na[k], da[k], r0, r1); acc[ai][0][m][0] *= r0; acc[ai][0][m][1] *= r1; ratio8(nb[k], db[k], r0, r1); acc[ai][1][m][0] *= r0; acc[ai][1][m][1] *= r1; }
                else { bf16* mp = MG + (size_t)(row0 + ai * 128 + m * 16) * D + col; f32x4 x0, x1; unpack8(na[k], x0, x1); st8(mp, acc[ai][0][m][0] * x0, acc[ai][0][m][1] * x1);
                    unpack8(nb[k], x0, x1); st8(mp + 128, acc[ai][1][m][0] * x0, acc[ai][1][m][1] * x1); } }
            asm volatile("" ::: "memory");
        }
    }
};
struct GuOrder { int G, c;
    __device__ __forceinline__ bool next(int i, pg8::Unit& u) const { const int L = i * G + c; if (L >= 1024) return false;
        const int x = L & 7, j = (L >> 3) & 31, r = L >> 8, sg = r * 8 + x, e = sg >> 1, bh = sg & 1, pmi = j & 3, pnl = j >> 2, b = 2 * bh + (pmi >> 1);
        u.pm = (b * NE + e) * 2 + (pmi & 1); u.pn = e * 8 + pnl; return true; }
    __device__ __forceinline__ void a_ready(const pg8::Unit&) const {}
    __device__ __forceinline__ void done(const pg8::Unit&) const {} };
struct DnOrder { int G, c;
    __device__ __forceinline__ bool next(int i, pg8::Unit& u) const { const int L = i * G + c; if (L >= 512) return false;
        const int x = L & 7, j = (L >> 3) & 31, r = L >> 8, e = r * 8 + x, pmi = j & 7, pnl = j >> 3;
        u.pm = ((pmi >> 1) * NE + e) * 2 + (pmi & 1); u.pn = e * 4 + pnl; return true; }
    __device__ __forceinline__ void a_ready(const pg8::Unit&) const {}
    __device__ __forceinline__ void done(const pg8::Unit&) const {} };

__device__ __forceinline__ void ld8f(const bf16* p, f32x4& x0, f32x4& x1) { unpack8(*(const v4u*)p, x0, x1); }
__device__ __forceinline__ void phase_prep_elem(const Args& a, int l, int vcu, int G) {
    unsigned char* ws = opaque(a.ws);
    const bf16* U = (const bf16*)(ws + WS_U); const bf16* CV = (const bf16*)(ws + WS_CV); bf16* MIX = (bf16*)(ws + WS_MIX); bf16* CY = (bf16*)(ws + WS_CY);
    const float* cw = a.in[I_CONVW] + (size_t)l * 3 * 512;
    const f32x4 z4 = {0.f, 0.f, 0.f, 0.f};
    for (size_t idx = (size_t)vcu * 512 + otid(); idx < (size_t)(T / 16) * 128; idx += (size_t)G * 512) {
        const int t0 = (int)(idx >> 7) * 16, ch = (int)(idx & 127), tt0 = t0 % S;
        if (ch < 64) {
            const int hw = 1 << (ch >> 4);
            const bf16* up = U + (size_t)(t0 - tt0) * 512 + ch * 8;
            f32x4 s0 = z4, s1 = z4;
#pragma unroll
            for (int k = 0; k < 16; ++k) { const int r = tt0 - hw + k; if (k < 2 * hw && r >= 0) { f32x4 x0, x1; ld8f(up + (size_t)r * 512, x0, x1); s0 += x0; s1 += x1; } }
#pragma unroll
            for (int i = 0; i < 16; ++i) { const int tt = tt0 + i;
                f32x4 c0, c1; ld8f(up + (size_t)tt * 512, c0, c1);
                const int lo = max(tt - hw, 0), hi = min(tt + hw - 1, S - 1); const float inv = 1.0f / (float)(hi - lo + 1);
                st8(MIX + (size_t)(t0 + i) * 512 + ch * 8, s0 * inv - c0, s1 * inv - c1);
                f32x4 p0 = z4, p1 = z4, m0 = z4, m1 = z4;
                if (tt + hw < S) ld8f(up + (size_t)(tt + hw) * 512, p0, p1);
                if (tt - hw >= 0) ld8f(up + (size_t)(tt - hw) * 512, m0, m1);
                s0 += p0 - m0; s1 += p1 - m1; }
        } else {
            const int c = (ch - 64) * 8; const bf16* p = CV + (size_t)t0 * 1536 + c;
            const f32x4 w00 = *(const f32x4*)(cw + c), w01 = *(const f32x4*)(cw + c + 4), w10 = *(const f32x4*)(cw + 512 + c), w11 = *(const f32x4*)(cw + 512 + c + 4),
                        w20 = *(const f32x4*)(cw + 1024 + c), w21 = *(const f32x4*)(cw + 1024 + c + 4);
            f32x4 zp0 = z4, zp1 = z4, zc0, zc1;
            if (tt0 > 0) { f32x4 x0, x1, y0, y1; ld8f(p - 1536, x0, x1); ld8f(p - 1536 + 1024, y0, y1); zp0 = x0 * y0; zp1 = x1 * y1; }
            { f32x4 x0, x1, y0, y1; ld8f(p, x0, x1); ld8f(p + 1024, y0, y1); zc0 = x0 * y0; zc1 = x1 * y1; }
#pragma unroll
            for (int i = 0; i < 16; ++i) { const bf16* pi = p + (size_t)i * 1536;
                f32x4 zn0 = z4, zn1 = z4;
                if (tt0 + i + 1 < S) { f32x4 x0, x1, y0, y1; ld8f(pi + 1536, x0, x1); ld8f(pi + 1536 + 1024, y0, y1); zn0 = x0 * y0; zn1 = x1 * y1; }
                f32x4 b0, b1; ld8f(pi + 512, b0, b1);
                st8(CY + (size_t)(t0 + i) * 512 + c, b0 * (w00 * zp0 + w10 * zc0 + w20 * zn0), b1 * (w01 * zp1 + w11 * zc1 + w21 * zn1));
                zp0 = zc0; zp1 = zc1; zc0 = zn0; zc1 = zn1; }
        }
    }
}

__device__ __forceinline__ float reduce16(const float (&p)[16], int lane) {
    float q8[8], q4[4], q2[2];
    { const bool up = lane & 32;
#pragma unroll
      for (int i = 0; i < 8; ++i) { float lo = p[i], hi = p[8 + i]; asm volatile("" : "+v"(lo), "+v"(hi)); const float keep = up ? hi : lo, send = up ? lo : hi; q8[i] = keep + __shfl_xor(send, 32); } }
    { const bool up = lane & 16;
#pragma unroll
      for (int i = 0; i < 4; ++i) { float lo = q8[i], hi = q8[4 + i]; asm volatile("" : "+v"(lo), "+v"(hi)); const float keep = up ? hi : lo, send = up ? lo : hi; q4[i] = keep + __shfl_xor(send, 16); } }
    { const bool up = lane & 8;
#pragma unroll
      for (int i = 0; i < 2; ++i) { float lo = q4[i], hi = q4[2 + i]; asm volatile("" : "+v"(lo), "+v"(hi)); const float keep = up ? hi : lo, send = up ? lo : hi; q2[i] = keep + __shfl_xor(send, 8); } }
    float lo = q2[0], hi = q2[1]; asm volatile("" : "+v"(lo), "+v"(hi));
    const bool up = lane & 4; const float keep = up ? hi : lo, send = up ? lo : hi;
    float q = keep + __shfl_xor(send, 4); q += __shfl_xor(q, 2); q += __shfl_xor(q, 1); return q;
}
__device__ __forceinline__ void phase_norm2(const Args& a, int l, LAS unsigned char* lds, int vcu, int G) {
    const int tid = otid(), lane = tid & 63, wave = tid >> 6;
    unsigned char* ws = opaque(a.ws);
    const float* X = (const float*)(ws + WS_X); bf16* H = (bf16*)(ws + WS_H); float* AFF = (float*)(ws + WS_AFF); const float* MOD = (const float*)(ws + WS_MOD);
    LAS float* wl = (LAS float*)lds;
    const float* wr = a.in[I_WROUTER] + (size_t)l * D * NE;
    { f32x4 wv[8];
#pragma unroll
      for (int k = 0; k < 8; ++k) wv[k] = ((const f32x4*)wr)[tid + 512 * k];
#pragma unroll
      for (int k = 0; k < 8; ++k) { const int i4 = tid + 512 * k, c = i4 >> 2, e0 = (i4 & 3) * 4;
#pragma unroll
          for (int q = 0; q < 4; ++q) wl[(e0 + q) * D + c] = wv[k][q]; } }
    __syncthreads();
    const float* g = a.in[I_N2G] + l * D;
    const int myexp = ((lane >> 5) & 1) * 8 + ((lane >> 4) & 1) * 4 + ((lane >> 3) & 1) * 2 + ((lane >> 2) & 1);
    const int rpw = (T + G * NWAVES - 1) / (G * NWAVES);
    int t = (vcu * NWAVES + wave) * rpw; const int tend = min(t + rpw, T);
    f32x4 gg[4], s1v[4], h1v[4]; int bcur = -1;
#pragma unroll
    for (int j = 0; j < 4; ++j) gg[j] = ((const f32x4*)g)[lane + 64 * j];
    f32x4 na[4], nb[4];
    if (t < tend) { const int tb = min(t + 1, tend - 1);
#pragma unroll
        for (int j = 0; j < 4; ++j) { na[j] = ((const f32x4*)(X + (size_t)t * D))[lane + 64 * j]; nb[j] = ((const f32x4*)(X + (size_t)tb * D))[lane + 64 * j]; } }
    for (; t < tend; t += 2) {
        const int b = t / S; const int t1 = min(t + 1, tend - 1);
        f32x4 va[4], vb[4];
#pragma unroll
        for (int j = 0; j < 4; ++j) { va[j] = na[j]; vb[j] = nb[j]; }
        if (b != bcur) { bcur = b; const float* sh = MOD + ((size_t)l * NB + b) * 6144 + 3 * D; const float* sc = sh + D;
#pragma unroll
            for (int j = 0; j < 4; ++j) { s1v[j] = ((const f32x4*)sc)[lane + 64 * j] + 1.0f; h1v[j] = ((const f32x4*)sh)[lane + 64 * j]; } }
        asm volatile("" ::: "memory");
        if (t + 2 < tend) { const int ta = t + 2, tb = min(t + 3, tend - 1);
#pragma unroll
            for (int j = 0; j < 4; ++j) { na[j] = ((const f32x4*)(X + (size_t)ta * D))[lane + 64 * j]; nb[j] = ((const f32x4*)(X + (size_t)tb * D))[lane + 64 * j]; } }
        asm volatile("" ::: "memory");
        float sa = 0.f, sb = 0.f;
#pragma unroll
        for (int j = 0; j < 4; ++j) { sa += (va[j][0] * va[j][0] + va[j][1] * va[j][1]) + (va[j][2] * va[j][2] + va[j][3] * va[j][3]); sb += (vb[j][0] * vb[j][0] + vb[j][1] * vb[j][1]) + (vb[j][2] * vb[j][2] + vb[j][3] * vb[j][3]); }
        const float ra = 1.0f / sqrtf(wave_sum(sa) * (1.0f / D) + EPS), rb = 1.0f / sqrtf(wave_sum(sb) * (1.0f / D) + EPS);
#pragma unroll
        for (int j = 0; j < 4; ++j) { va[j] = va[j] * ra * gg[j] * s1v[j] + h1v[j]; vb[j] = vb[j] * rb * gg[j] * s1v[j] + h1v[j];
            ((v2u*)(H + (size_t)t * D))[lane + 64 * j] = (v2u){pk2(va[j][0], va[j][1]), pk2(va[j][2], va[j][3])};
            ((v2u*)(H + (size_t)t1 * D))[lane + 64 * j] = (v2u){pk2(vb[j][0], vb[j][1]), pk2(vb[j][2], vb[j][3])}; }
        float pa[NE], pb[NE];
#pragma unroll
        for (int e = 0; e < NE; ++e) { float xa = 0.f, xb = 0.f;
#pragma unroll
            for (int j = 0; j < 4; ++j) { const f32x4 w = *(const LAS f32x4*)(wl + e * D + 4 * lane + 256 * j);
                xa += (va[j][0] * w[0] + va[j][1] * w[1]) + (va[j][2] * w[2] + va[j][3] * w[3]);
                xb += (vb[j][0] * w[0] + vb[j][1] * w[1]) + (vb[j][2] * w[2] + vb[j][3] * w[3]); }
            pa[e] = xa; pb[e] = xb;
            asm volatile("" : "+v"(pa[e]), "+v"(pb[e]) :: "memory"); }
        { const float lg = reduce16(pa, lane); float mx = lg;
#pragma unroll
          for (int o = 4; o < 64; o <<= 1) mx = fmaxf(mx, __shfl_xor(mx, o));
          const float ex = __expf(lg - mx); float sum = ex;
#pragma unroll
          for (int o = 4; o < 64; o <<= 1) sum += __shfl_xor(sum, o);
          if ((lane & 3) == 0) AFF[((size_t)b * NE + myexp) * S + t % S] = ex / sum; }
        { const float lg = reduce16(pb, lane); float mx = lg;
#pragma unroll
          for (int o = 4; o < 64; o <<= 1) mx = fmaxf(mx, __shfl_xor(mx, o));
          const float ex = __expf(lg - mx); float sum = ex;
#pragma unroll
          for (int o = 4; o < 64; o <<= 1) sum += __shfl_xor(sum, o);
          if ((lane & 3) == 0) AFF[((size_t)b * NE + myexp) * S + t1 % S] = ex / sum; }
    }
    __syncthreads();
}

__device__ __forceinline__ void phase_topk(const Args& a, LAS unsigned char* lds, int G) {
    const int tid = otid(), lane = tid & 63, wave = tid >> 6;
    unsigned char* ws = opaque(a.ws);
    const float* AFF = (const float*)(ws + WS_AFF); int* SLOT = (int*)(ws + WS_SLOT); int* IDXG = (int*)(ws + WS_IDX); const bf16* H = (const bf16*)(ws + WS_H); bf16* XG = (bf16*)(ws + WS_XG);
    LAS unsigned* hist = (LAS unsigned*)lds;
    LAS unsigned* sel = hist + 256;
    LAS unsigned* wtot = sel + 8;
    LAS int* idxl = (LAS int*)(wtot + 8);
    const int npart = GATHER_FUSED ? 1 : ((G % 4 == 0 && G >= 4) ? 4 : 1), part = blockIdx.x % npart;
    for (int pi = blockIdx.x / npart; pi < NB * NE; pi += G / npart) {
        const int b = pi / NE;
        const float* ap = AFF + (size_t)pi * S + tid * 8;
        const f32x4 v0 = *(const f32x4*)ap, v1 = *(const f32x4*)(ap + 4);
        unsigned key[8];
#pragma unroll
        for (int i = 0; i < 4; ++i) { key[i] = __float_as_uint(v0[i]); key[4 + i] = __float_as_uint(v1[i]); }
        unsigned prefix = 0, kk = CAP;
#pragma unroll 1
        for (int pass = 0; pass < 4; ++pass) { const int shift = 24 - 8 * pass;
            if (tid < 256) hist[tid] = 0u;
            __syncthreads();
#pragma unroll
            for (int i = 0; i < 8; ++i) { const bool m = (pass == 0) ? true : ((key[i] >> (shift + 8)) == prefix); if (m) __hip_atomic_fetch_add(&hist[(key[i] >> shift) & 255u], 1u, __ATOMIC_RELAXED, __HIP_MEMORY_SCOPE_WORKGROUP); }
            __syncthreads();
            if (wave == 0) { const unsigned c0 = hist[4 * lane], c1 = hist[4 * lane + 1], c2 = hist[4 * lane + 2], c3 = hist[4 * lane + 3]; const unsigned s = c0 + c1 + c2 + c3;
                unsigned suf = s;
#pragma unroll
                for (int o = 1; o < 64; o <<= 1) { const unsigned tv = __shfl_down(suf, o); if (lane + o < 64) suf += tv; }
                unsigned above = suf - s;
                const unsigned cs[4] = {c3, c2, c1, c0};
#pragma unroll
                for (int q = 0; q < 4; ++q) { if (above < kk && above + cs[q] >= kk) { sel[0] = (unsigned)(4 * lane + 3 - q); sel[1] = kk - above; } above += cs[q]; } }
            __syncthreads();
            prefix = (prefix << 8) | sel[0]; kk = sel[1];
            __syncthreads(); }
        unsigned ngt = 0, neq = 0;
#pragma unroll
        for (int i = 0; i < 8; ++i) { ngt += key[i] > prefix; neq += key[i] == prefix; }
        unsigned pk = ngt | (neq << 16), inc = pk;
#pragma unroll
        for (int o = 1; o < 64; o <<= 1) { const unsigned tv = __shfl_up(inc, o); if (lane >= o) inc += tv; }
        if (lane == 63) wtot[wave] = inc;
        __syncthreads();
        unsigned base = 0;
#pragma unroll
        for (int w = 0; w < 8; ++w) base += (w < wave) ? wtot[w] : 0u;
        const unsigned ex = base + inc - pk; unsigned gtb = ex & 0xffffu, eqb = ex >> 16;
#pragma unroll
        for (int i = 0; i < 8; ++i) { const bool gt = key[i] > prefix, eq = key[i] == prefix; const bool s = gt || (eq && eqb < kk);
            const int slot = (int)(gtb + (eqb < kk ? eqb : kk)); const int tt = tid * 8 + i;
            if (s) idxl[slot] = tt;
            if (part == 0) { SLOT[(size_t)pi * S + tt] = s ? slot : -1; if (s) IDXG[(size_t)pi * CAP + slot] = b * S + tt; }
            gtb += gt; eqb += eq; }
        __syncthreads();
#if !GATHER_FUSED
        const int per = CAP / npart;
        for (int si = wave * 4; si < per; si += NWAVES * 4) {
            v4u r0[4], r1[4];
#pragma unroll
            for (int k = 0; k < 4; ++k) { const int tt = idxl[part * per + si + k]; const v4u* src = (const v4u*)(H + ((size_t)b * S + tt) * D); r0[k] = src[lane]; r1[k] = src[lane + 64]; }
#pragma unroll
            for (int k = 0; k < 4; ++k) { v4u* dst = (v4u*)(XG + ((size_t)pi * CAP + part * per + si + k) * D); dst[lane] = r0[k]; dst[lane + 64] = r1[k]; } }
        __syncthreads();
#else
        (void)H; (void)XG; (void)lane;
#endif
    }
}

#if NAIVE_ATTN
__device__ __forceinline__ void phase_attn(const Args& a, LAS unsigned char* lds, int vcu, int G) {
    const int tid = otid(), lane = tid & 63, wave = tid >> 6;
    unsigned char* ws = opaque(a.ws);
    const bf16* Q = (const bf16*)(ws + WS_Q); const bf16* KV = (const bf16*)(ws + WS_KV); const bf16* KR = (const bf16*)(ws + WS_KR); bf16* O = (bf16*)(ws + WS_O);
    LAS float* pl = (LAS float*)(lds + wave * 16384);
    for (int row = vcu * NWAVES + wave; row < NB * NH * S; row += G * NWAVES) {
        const int b = row / (NH * S), h = (row / S) % NH, q = row % S; const size_t t = (size_t)b * S + q;
        float qf[DQK];
#pragma unroll
        for (int c = 0; c < 12; ++c) { f32x4 x0, x1; unpack8(*(const v4u*)(Q + t * 768 + h * 96 + c * 8), x0, x1);
#pragma unroll
            for (int i = 0; i < 4; ++i) { qf[c * 8 + i] = x0[i]; qf[c * 8 + 4 + i] = x1[i]; } }
        float mx = -1e30f;
        for (int jj = 0; jj < S / 64; ++jj) { const int key = jj * 64 + lane; const size_t kt = (size_t)b * S + key; float s = 0.f;
#pragma unroll
            for (int c = 0; c < 12; ++c) { f32x4 x0, x1; const bf16* kp = (c < 8) ? (KV + kt * 1024 + h * 128 + c * 8) : (KR + kt * 32 + (c - 8) * 8); unpack8(*(const v4u*)kp, x0, x1);
#pragma unroll
                for (int i = 0; i < 4; ++i) { s += qf[c * 8 + i] * x0[i]; s += qf[c * 8 + 4 + i] * x1[i]; } }
            pl[key] = s; mx = fmaxf(mx, s); }
        mx = wave_max(mx);
        float sum = 0.f;
        for (int jj = 0; jj < S / 64; ++jj) { const int key = jj * 64 + lane; const float e = exp2f(pl[key] - mx); pl[key] = e; sum += e; }
        sum = wave_sum(sum);
        LDS_WAIT();
        float o = 0.f; const bf16* vp = KV + (size_t)b * S * 1024 + h * 128 + 64 + lane;
        for (int key = 0; key < S; ++key) o += pl[key] * __uint_as_float((unsigned)vp[(size_t)key * 1024] << 16);
        O[t * 512 + h * 64 + lane] = (bf16)(pk2(o / sum, 0.f) & 0xffffu);
    }
    __syncthreads();
}
#else
__device__ __forceinline__ void phase_attn(const Args& a, LAS unsigned char* lds, int vcu, int G) {
    unsigned char* ws = opaque(a.ws);
    const bf16* Q = (const bf16*)(ws + WS_Q); const bf16* KV = (const bf16*)(ws + WS_KV); const bf16* KR = (const bf16*)(ws + WS_KR); bf16* O = (bf16*)(ws + WS_O);
    for (int i = 0;; ++i) { const int L = i * G + (int)blockIdx.x; if (L >= NB * NH * (S / 256)) break;
        const int x = L & 7, j = (L >> 3) & 31, r = L >> 8, bh = x * 4 + r * 2 + (j >> 4), qb = j & 15, b = bh >> 3, h = bh & 7;
        float kmax2;
        { const float* kn = (const float*)(ws + WS_KMAX) + (size_t)b * (NH * 2 + 1) * 32; const int ln = otid() & 31;
          float m0 = kn[(h * 2) * 32 + ln], m1 = kn[(h * 2 + 1) * 32 + ln], m2 = kn[(NH * 2) * 32 + ln];
#pragma unroll
          for (int o = 1; o < 32; o <<= 1) { m0 = fmaxf(m0, __shfl_xor(m0, o)); m1 = fmaxf(m1, __shfl_xor(m1, o)); m2 = fmaxf(m2, __shfl_xor(m2, o)); }
          kmax2 = m0 + m1 + m2; }
        att::attn_unit(Q, KV, KR, O, (long)b * S + qb * 256, (long)b * S, h, (LAS char*)lds, kmax2); }
}
#endif

#define L1_INV() do { VM_WAIT(); __builtin_amdgcn_fence(__ATOMIC_ACQUIRE, "agent"); VM_WAIT(); __syncthreads(); } while (0)
#define XB_TMO      128
#define XB_XCNT(j)  (256  + 64 * (j))
#define XB_XSUB(j)  (1280 + 64 * (j))
#define XB_XGEN(j)  (2304 + 64 * (j))
#define XB_TOP      3328
#define XB_TOPGEN   3392
#define XCD_BAR_WORDS 3456
#define XB_SPIN_CAP (1u << 20)

__device__ __forceinline__ unsigned xb_ld(unsigned* p)              { return __hip_atomic_load(p, __ATOMIC_RELAXED, __HIP_MEMORY_SCOPE_AGENT); }
__device__ __forceinline__ unsigned xb_add(unsigned* p, unsigned v) { return __hip_atomic_fetch_add(p, v, __ATOMIC_RELAXED, __HIP_MEMORY_SCOPE_AGENT); }
__device__ __forceinline__ unsigned xb_xcc_id() { return (unsigned)__builtin_amdgcn_s_getreg((3 << 11) | 20) & 0xFu; }
#define XB_SPIN(cond, bar) do { unsigned _sp = 0; while (cond) { __builtin_amdgcn_s_sleep(1); \
    if ((++_sp & 255u) == 0u) { if (xb_ld(&(bar)[XB_TMO])) break; if (_sp > XB_SPIN_CAP) { atomicAdd(&(bar)[XB_TMO], 1u); break; } } } } while (0)

struct XcdBarrier {
    unsigned* bar; unsigned x;
    volatile LAS unsigned* st;
};

__device__ __forceinline__ XcdBarrier xcd_barrier_post(unsigned* bar, volatile LAS unsigned* st) {
    XcdBarrier b; b.bar = bar; b.x = xb_xcc_id(); b.st = st;
    if (threadIdx.x == 0) (void)xb_add(&bar[XB_XCNT(b.x)], 1u);
    return b;
}
__device__ __forceinline__ void xcd_barrier_complete(unsigned* bar, unsigned x, unsigned& nloc, unsigned& nx) {
    const unsigned G = gridDim.x * gridDim.y * gridDim.z;
    unsigned sum, cnt, mine, sp = 0u;
    for (;;) {
        sum = 0u; cnt = 0u; mine = 0u;
#pragma unroll
        for (unsigned j = 0; j < 16; ++j) { const unsigned c = xb_ld(&bar[XB_XCNT(j)]); sum += c; cnt += (c > 0u) ? 1u : 0u; mine = (j == x) ? c : mine; }
        if (sum == G) break;
        __builtin_amdgcn_s_sleep(1);
        if ((++sp & 255u) == 0u) { if (xb_ld(&bar[XB_TMO])) break; if (sp > XB_SPIN_CAP) { atomicAdd(&bar[XB_TMO], 1u); break; } }
    }
    nloc = mine > 0u ? mine : 1u; nx = cnt > 0u ? cnt : 1u;
}

__device__ __forceinline__ void xcd_barrier(const XcdBarrier& b) {
    asm volatile("s_waitcnt vmcnt(0)" ::: "memory");
    __syncthreads();
    if (threadIdx.x == 0) {
        unsigned* bar = b.bar;
        __builtin_amdgcn_s_waitcnt(0);
        unsigned nloc = b.st[0], nx = b.st[1];
        if (nloc == 0u) { xcd_barrier_complete(bar, b.x, nloc, nx); b.st[0] = nloc; b.st[1] = nx; }
        const unsigned old = xb_add(&bar[XB_XSUB(b.x)], 1u);
        const unsigned gen = old / nloc;
        if (old + 1u == (gen + 1u) * nloc) {
            __builtin_amdgcn_fence(__ATOMIC_RELEASE, "agent");
            asm volatile("s_waitcnt vmcnt(0)" ::: "memory");
            const unsigned og = xb_add(&bar[XB_TOP], 1u);
            const unsigned tg = og / nx;
            if (og + 1u == (tg + 1u) * nx) xb_add(&bar[XB_TOPGEN], 1u);
            else XB_SPIN(xb_ld(&bar[XB_TOPGEN]) == tg, bar);
            __builtin_amdgcn_fence(__ATOMIC_ACQUIRE, "agent");
            xb_add(&bar[XB_XGEN(b.x)], 1u);
            asm volatile("s_waitcnt vmcnt(0)" ::: "memory");
        } else {
            XB_SPIN(xb_ld(&bar[XB_XGEN(b.x)]) == gen, bar);
            __builtin_amdgcn_fence(__ATOMIC_ACQUIRE, "agent");
            asm volatile("s_waitcnt vmcnt(0)" ::: "memory");
        }
    }
    __syncthreads();
}

template <class Work> __device__ __forceinline__ void xcd_barrier_work(const XcdBarrier& b, volatile LAS unsigned* mw, Work&& work) {
    asm volatile("s_waitcnt vmcnt(0)" ::: "memory");
    __syncthreads();
    if (threadIdx.x == 0) {
        unsigned* bar = b.bar;
        __builtin_amdgcn_s_waitcnt(0);
        unsigned nloc = b.st[0], nx = b.st[1];
        if (nloc == 0u) { xcd_barrier_complete(bar, b.x, nloc, nx); b.st[0] = nloc; b.st[1] = nx; }
        const unsigned old = xb_add(&bar[XB_XSUB(b.x)], 1u);
        const unsigned gen = old / nloc;
        if (old + 1u == (gen + 1u) * nloc) {
            __builtin_amdgcn_fence(__ATOMIC_RELEASE, "agent");
            asm volatile("s_waitcnt vmcnt(0)" ::: "memory");
            const unsigned og = xb_add(&bar[XB_TOP], 1u);
            const unsigned tg = og / nx;
            if (og + 1u == (tg + 1u) * nx) xb_add(&bar[XB_TOPGEN], 1u);
            else XB_SPIN(xb_ld(&bar[XB_TOPGEN]) == tg, bar);
            __builtin_amdgcn_fence(__ATOMIC_ACQUIRE, "agent");
            xb_add(&bar[XB_XGEN(b.x)], 1u);
            asm volatile("s_waitcnt vmcnt(0)" ::: "memory");
            mw[0] = 1u;
        } else { mw[0] = 0u; mw[1] = gen; }
    }
    __syncthreads();
    if (mw[0] == 0u) {
        const unsigned gen = mw[1]; unsigned sp = 0u;
        for (;;) {
            if (threadIdx.x == 0) { unsigned r = (xb_ld(&b.bar[XB_XGEN(b.x)]) != gen) ? 1u : 0u;
                if (!r && ((++sp & 255u) == 0u)) { if (xb_ld(&b.bar[XB_TMO])) r = 1u; else if (sp > XB_SPIN_CAP) { atomicAdd(&b.bar[XB_TMO], 1u); r = 1u; } }
                if (!r && XB_WORK_UNTIL_LOCAL && xb_ld(&b.bar[XB_XSUB(b.x)]) >= (gen + 1u) * b.st[0]) r = 2u;
                mw[2] = r; }
            __syncthreads();
            const unsigned rel = mw[2];
            __syncthreads();
            if (rel == 1u) break;
            if (rel == 2u || !work()) __builtin_amdgcn_s_sleep(1);
        }
        if (threadIdx.x == 0) { __builtin_amdgcn_fence(__ATOMIC_ACQUIRE, "agent"); asm volatile("s_waitcnt vmcnt(0)" ::: "memory"); }
    }
    __syncthreads();
}


__global__ void __launch_bounds__(NWAVES * 64, 2) fwd(Args args) {
    extern __shared__ __attribute__((aligned(16))) unsigned char lds_raw[];
    LAS unsigned char* lds = (LAS unsigned char*)lds_raw;
    volatile LAS unsigned* MISC = (volatile LAS unsigned*)(lds + MISC_OFF);
    const int tid = threadIdx.x;
    const int G = gridDim.x; const int bx = blockIdx.x; const int vcu = (G % 8 == 0) ? (bx % 8) * (G / 8) + bx / 8 : bx;
    if (tid < 32) MISC[tid] = 0u;
    __syncthreads();
    unsigned char* ws0 = args.ws;
    unsigned* ctl = (unsigned*)(ws0 + WS_CTL);
    XcdBarrier bar; bar.bar = ctl + CW_BAR; bar.x = 0; bar.st = nullptr;
#if !MK_PER_PHASE
    bar = xcd_barrier_post(ctl + CW_BAR, MISC + 8);
#endif
    const int lo = args.p_lo, hi = args.p_hi;
    int qcur = 0;
#ifndef EPF
#define EPF 4
#endif
#ifndef PHASE_MASK
#define PHASE_MASK 0xFFF
#endif
#define IN(k) (lo <= (k) && (k) < hi)
#define PM(b) ((PHASE_MASK >> (b)) & 1)
#ifndef REPEAT_MASK
#define REPEAT_MASK 0
#endif
#define NREP(b) (((REPEAT_MASK >> (b)) & 1) ? 2 : 1)
#define REPBAR(b) do { if (rep_ + 1 < NREP(b)) xcd_barrier(bar); } while (0)
#if MK_PER_PHASE
#define SEAM(k) do { } while (0)
#else
#ifndef EXTRA_BARRIERS
#define EXTRA_BARRIERS 0
#endif
#define SEAM(k) do { if (IN(k) && IN((k) + 1)) { xcd_barrier_work(bar, MISC + 16, [&]() { return conv_steal(args, lds, MISC + 16, qcur, NQ, G); }); _Pragma("unroll 1") for (int xb_ = 0; xb_ < EXTRA_BARRIERS; ++xb_) xcd_barrier(bar); } } while (0)
#endif
    if (PM(10) && IN(0)) { _Pragma("unroll 1") for (int rep_ = 0; rep_ < NREP(10); ++rep_) { phase_prologue(args, lds, vcu, G); REPBAR(10); } }
    SEAM(0);
#pragma unroll 1
    for (int l = 0; l < NL; ++l) {
        const int pb = 1 + 10 * l;
        if (PM(0) && IN(pb + 0)) phase_norm1(args, l, vcu, G);
        if (l > 0) conv_drain(args, lds, MISC + 16, qcur, 2 * l, G);
        SEAM(pb + 0);
        if (PM(1) && IN(pb + 1)) { _Pragma("unroll 1") for (int rep_ = 0; rep_ < NREP(1); ++rep_) {
            unsigned char* ws = opaque(args.ws); unsigned char* wl = ws + WS_W + (size_t)l * WL_BYTES;
            { const float* bg = args.in[I_BGATE] + (size_t)l * 3072; for (int i = otid(); i < 768; i += NWAVES * 64) *(LAS f32x4*)(lds + LDS_BIAS + i * 16) = ((const f32x4*)bg)[i]; }
            __syncthreads();
            pg8::Gemm g{(const bf16*)(ws + WS_H), (const bf16*)(wl + WO_IN), T, NIN, D}; pg8::StaticOrder So; So.init(T, NIN, G, bx);
            Epi8<FProj, EPF> E{FProj{(bf16*)(ws + WS_CQ), (bf16*)(ws + WS_CKV), (bf16*)(ws + WS_KR), (bf16*)(ws + WS_U), (bf16*)(ws + WS_CV), (bf16*)(ws + WS_GT),
                                (float*)(ws + WS_PART), (const float*)(ws + WS_COS), (const float*)(ws + WS_SIN), (const LAS float*)(lds + LDS_BIAS), (unsigned*)(ws + WS_KMAX)}};
            run_gemm<0>(lds, g, So, E);
            if (CONV_SLOT_A > 0 && bx >= 192 && G == 256) { __syncthreads(); conv_moe_range(args, lds, l, 0, CONV_SLOT_A, bx - 192, 64); }
         REPBAR(1); } }
        SEAM(pb + 1);
        if (PM(2) && IN(pb + 2)) { _Pragma("unroll 1") for (int rep_ = 0; rep_ < NREP(2); ++rep_) {
            unsigned char* ws = opaque(args.ws); unsigned char* wl = ws + WS_W + (size_t)l * WL_BYTES;
#ifndef PREP_PARTS
#define PREP_PARTS 7
#endif
            if (PREP_PARTS & 1) { pg8::Gemm g{(const bf16*)(ws + WS_CQ), (const bf16*)(wl + WO_UQ), T, 768, QR}; pg8::StaticOrder So; So.init(T, 768, G, bx);
              Epi8<FQ, EPF> E{FQ{(bf16*)(ws + WS_Q), (const float*)(ws + WS_PART), (const float*)(ws + WS_COS), (const float*)(ws + WS_SIN)}};
              run_gemm<1>(lds, g, So, E); }
            if (CONV_SLOT_C > 0 && bx >= 192 && G == 256) { __syncthreads(); conv_moe_range(args, lds, l, CONV_SLOT_A, CONV_SLOT_C, bx - 192, 64); __syncthreads(); }
            if (PREP_PARTS & 2) { pg8::Gemm g{(const bf16*)(ws + WS_CKV), (const bf16*)(wl + WO_UKV), T, 1024, KVR}; pg8::StaticOrder So; So.init(T, 1024, G, bx);
              Epi8<FKV, EPF> E{FKV{(bf16*)(ws + WS_KV), (const float*)(ws + WS_PART), (unsigned*)(ws + WS_KMAX)}};
              run_gemm<2>(lds, g, So, E); }
            if (PREP_PARTS & 4) phase_prep_elem(args, l, vcu, G);
         REPBAR(2); } }
        SEAM(pb + 2);
        if (PM(3) && IN(pb + 3)) { _Pragma("unroll 1") for (int rep_ = 0; rep_ < NREP(3); ++rep_) { phase_attn(args, lds, vcu, G); REPBAR(3); } }
        SEAM(pb + 3);
        if (PM(4) && IN(pb + 4)) { _Pragma("unroll 1") for (int rep_ = 0; rep_ < NREP(4); ++rep_) {
            unsigned char* ws = opaque(args.ws); unsigned char* wl = ws + WS_W + (size_t)l * WL_BYTES;
#if MERGE_FUSED
            { pg8::Gemm g{(const bf16*)(ws + WS_O), (const bf16*)(wl + WO_OA), T, D, 512};
              MergeSched Sm; Sm.so.init(T, D, G, bx); Sm.ws = (const char*)ws; Sm.wl = (const char*)wl;
              EMergeFused E{(bf16*)(ws + WS_MG), (const bf16*)(ws + WS_GT)};
              pg8::gemm_phase_seg<EMergeFused, MergeSched, true, true>(lds, g, Sm, E); }
#else
            pg8::StaticOrder So; So.init(T, D, G, bx);
            { pg8::Gemm g{(const bf16*)(ws + WS_O), (const bf16*)(wl + WO_OA), T, D, 512};
              Epi8<FMerge<0>, EPF> E{FMerge<0>{(bf16*)(ws + WS_MG), (const bf16*)(ws + WS_GT), nullptr}}; run_gemm<3>(lds, g, So, E); } L1_INV();
            { pg8::Gemm g{(const bf16*)(ws + WS_CY), (const bf16*)(wl + WO_OC), T, D, 512};
              Epi8<FMerge<1>, EPF> E{FMerge<1>{(bf16*)(ws + WS_MG), (const bf16*)(ws + WS_GT), nullptr}}; run_gemm<4>(lds, g, So, E); } L1_INV();
            { pg8::Gemm g{(const bf16*)(ws + WS_MIX), (const bf16*)(wl + WO_POOL), T, D, 512};
              Epi8<FMerge<2>, EPF> E{FMerge<2>{(bf16*)(ws + WS_MG), (const bf16*)(ws + WS_GT), args.in[I_PSCALE] + (size_t)l * D}}; run_gemm<5>(lds, g, So, E); }
#endif
         REPBAR(4); } }
        SEAM(pb + 4);
        if (PM(5) && IN(pb + 5)) {
            unsigned char* ws = opaque(args.ws); unsigned char* wl = ws + WS_W + (size_t)l * WL_BYTES; const float* MOD = (const float*)(ws + WS_MOD);
            pg8::Gemm g{(const bf16*)(ws + WS_MG), (const bf16*)(wl + WO_OUT), T, D, D}; pg8::StaticOrder So; So.init(T, D, G, bx);
            Epi8<FOut, EPF> E{FOut{l == 0 ? args.in[I_X] : (const float*)(ws + WS_X), (float*)(ws + WS_X), MOD + (size_t)l * NB * 6144 + 2 * D}};
            run_gemm<6>(lds, g, So, E);
        }
        SEAM(pb + 5);
        if (PM(6) && IN(pb + 6)) { _Pragma("unroll 1") for (int rep_ = 0; rep_ < NREP(6); ++rep_) { phase_norm2(args, l, lds, vcu, G); REPBAR(6); } }
        SEAM(pb + 6);
        if (PM(7) && IN(pb + 7)) { _Pragma("unroll 1") for (int rep_ = 0; rep_ < NREP(7); ++rep_) { phase_topk(args, lds, G);
            if (CONV_SLOT_B > 0 && bx >= 64 && G == 256) conv_moe_range(args, lds, l, CONV_SLOT_A + CONV_SLOT_C, CONV_SLOT_B, bx - 64, 192);
         REPBAR(7); } }
        conv_drain(args, lds, MISC + 16, qcur, 2 * l + 1, G);
        SEAM(pb + 7);
        if (PM(8) && IN(pb + 8)) { _Pragma("unroll 1") for (int rep_ = 0; rep_ < NREP(8); ++rep_) {
            unsigned char* ws = opaque(args.ws); unsigned char* wl = ws + WS_W + (size_t)l * WL_BYTES;
#if GATHER_FUSED
            pg8::Gemm g{(const bf16*)(ws + WS_H), (const bf16*)(wl + WO_GU), NB * NE * CAP, NE * 2048, D}; GuOrder So{G, bx};
            Epi8<FGu, EPF, false> E{FGu{(bf16*)(ws + WS_ACT)}}; pg8::gemm_phase_gather<Epi8<FGu, EPF, false>, GuOrder, true, true>(lds, g, So, E, (const int*)(ws + WS_IDX));
#else
            pg8::Gemm g{(const bf16*)(ws + WS_XG), (const bf16*)(wl + WO_GU), NB * NE * CAP, NE * 2048, D}; GuOrder So{G, bx};
            Epi8<FGu, EPF> E{FGu{(bf16*)(ws + WS_ACT)}}; run_gemm<7>(lds, g, So, E);
#endif
         REPBAR(8); } }
        SEAM(pb + 8);
        if (PM(9) && IN(pb + 9)) { _Pragma("unroll 1") for (int rep_ = 0; rep_ < NREP(9); ++rep_) {
            unsigned char* ws = opaque(args.ws); unsigned char* wl = ws + WS_W + (size_t)l * WL_BYTES;
            pg8::Gemm g{(const bf16*)(ws + WS_ACT), (const bf16*)(wl + WO_DN), NB * NE * CAP, NE * 1024, FF}; DnOrder So{G, bx};
            Epi8<FDn, EPF> E{FDn{(bf16*)(ws + WS_Y)}}; run_gemm<8>(lds, g, So, E);
         REPBAR(9); } }
        SEAM(pb + 9);
    }
    if (PM(11) && IN(41)) phase_norm1(args, NL, vcu, G);
#undef IN
#undef SEAM
}

extern "C" void kernel_launch(void* const* d_in, const int* in_sizes, int n_in, void* d_out, int out_size, void* d_ws, size_t ws_size, hipStream_t stream) {
    static int grid = 0;
    if (grid == 0) {
        if (n_in != 24 || out_size != T * D || ws_size < WS_END) { fprintf(stderr, "kernel_launch: unexpected shapes: n_in %d out %d ws %zu (need %zu)\n", n_in, out_size, ws_size, (size_t)WS_END); grid = -1; return; }
        int dev = 0, cus = 0, per_cu = 0;
        if (hipGetDevice(&dev) != hipSuccess || hipDeviceGetAttribute(&cus, hipDeviceAttributeMultiprocessorCount, dev) != hipSuccess) { grid = -1; return; }
        if (hipFuncSetAttribute((const void*)fwd, hipFuncAttributeMaxDynamicSharedMemorySize, LDS_BYTES) != hipSuccess) { fprintf(stderr, "kernel_launch: hipFuncSetAttribute failed\n"); grid = -1; return; }
        if (hipOccupancyMaxActiveBlocksPerMultiprocessor(&per_cu, (const void*)fwd, NWAVES * 64, LDS_BYTES) != hipSuccess || per_cu < 1) fprintf(stderr, "kernel_launch: occupancy query reports %d\n", per_cu);
        (void)hipGetLastError();
        grid = cus;
    }
    if (grid < 0) return;
    if (hipMemsetAsync((char*)d_ws + WS_CTL, 0, CTL_ZERO_BYTES, stream) != hipSuccess) return;
    Args a{};
    for (int i = 0; i < 24; ++i) a.in[i] = (const float*)d_in[i];
    a.out = (float*)d_out; a.ws = (unsigned char*)d_ws;
#if MK_PER_PHASE
    for (int p = 0; p < 42; ++p) { a.p_lo = p; a.p_hi = p + 1; hipLaunchKernelGGL(fwd, dim3(grid), dim3(NWAVES * 64), LDS_BYTES, stream, a); }
#else
    a.p_lo = 0; a.p_hi = 42;
    hipLaunchKernelGGL(fwd, dim3(grid), dim3(NWAVES * 64), LDS_BYTES, stream, a);
#endif
    const hipError_t le = hipPeekAtLastError();
    if (le != hipSuccess) fprintf(stderr, "kernel_launch: launch failed: %s\n", hipGetErrorName(le));
}
```

```cpp
#include <hip/hip_runtime.h>
#include <cstdio>
#include <cstdint>
#ifndef MK_PER_PHASE
#define MK_PER_PHASE 0
#endif
#ifndef NAIVE_GEMM_MASK
#define NAIVE_GEMM_MASK 0
#endif
#ifndef NAIVE_ATTN
#define NAIVE_ATTN 0
#endif
#ifndef ATTN_V2
#define ATTN_V2 0
#endif
#ifndef MERGE_FUSED
#define MERGE_FUSED 1
#endif
#ifndef ATTN_KBATCH
#define ATTN_KBATCH 0
#endif
#ifndef GATHER_FUSED
#define GATHER_FUSED 1
#endif
#ifndef ATTN_FASTPATH
#define ATTN_FASTPATH 1
#endif
#ifndef KMAX_ATOMICS
#define KMAX_ATOMICS 1
#endif
#ifndef ATTN_ONEBAR
#define ATTN_ONEBAR 1
#endif
#ifndef ATTN_ISTEP
#define ATTN_ISTEP 1
#endif
#ifndef ATTN_PRIO
#define ATTN_PRIO 0
#endif
#ifndef XB_WORK_UNTIL_LOCAL
#define XB_WORK_UNTIL_LOCAL 0
#endif

namespace pg8 {
#define PG8_LAS __attribute__((address_space(3)))
typedef unsigned short bf16_t;
typedef short bf16x8 __attribute__((ext_vector_type(8)));
typedef float f32x4 __attribute__((ext_vector_type(4)));
typedef unsigned u32x4 __attribute__((ext_vector_type(4)));
constexpr int BM = 256, BK = 64, HALF = 128, HTB = HALF * BK * 2  , STAGE_BYTES = 8 * HTB, NXCD = 8, WGM = 8;

__host__ __device__ __forceinline__ int lds_byte(int r, int c) { const int st = (r >> 4) * 2 + (c >> 5), rr = r & 15, cc = c & 31, ob = rr * 64 + cc * 2; return st * 1024 + (ob ^ (((ob >> 9) & 1) << 5)); }
__host__ __device__ __forceinline__ void stage_rc(int b, int& R, int& C) { const int st = b / 1024, sb = b % 1024, swz = sb ^ (((sb >> 9) & 1) << 5); R = (st >> 1) * 16 + swz / 64; C = (st & 1) * 32 + (swz % 64) / 2; }
__host__ __device__ __forceinline__ int perm32(int rho) { const int n = rho >> 4, i = rho & 15; return 8 * (i >> 2) + 4 * n + (i & 3); }

struct Unit { int pm, pn; };
struct Gemm { const bf16_t* A; const bf16_t* Bt; int M, N, K; };

struct StaticOrder {
    int nM, nN, nwg, G, c;
    __host__ __device__ void init(int M, int N, int G_, int c_) { nM = M / BM; nN = N / BM; nwg = nM * nN; G = G_; c = c_; }
    __host__ __device__ bool next(int i, Unit& u) const {
        const long L = (long)i * G + c; if (L >= nwg) return false;
        int wgid = (int)L; { const int q = nwg / NXCD, r = nwg % NXCD, xcd = wgid % NXCD, off = wgid / NXCD; wgid = (xcd < r ? xcd * (q + 1) : r * (q + 1) + (xcd - r) * q) + off; }
        const int nig = WGM * nN, gid = wgid / nig, fm = gid * WGM, gsz = (nM - fm) < WGM ? (nM - fm) : WGM;
        u.pm = fm + ((wgid % nig) % gsz); u.pn = (wgid % nig) / gsz; return true;
    }
    __device__ __forceinline__ void a_ready(const Unit&) const {}
    __device__ __forceinline__ void done(const Unit&) const {}
};

__device__ __forceinline__ unsigned cvt_pk_bf16(float lo, float hi) { unsigned r; asm volatile("v_cvt_pk_bf16_f32 %0, %1, %2" : "=v"(r) : "v"(lo), "v"(hi)); return r; }
#ifndef PG8_KREP
#define PG8_KREP 1
#endif
template <class Epi, class Sched, bool ALIGN_EPI = false, bool SP2 = false>
__device__ __forceinline__ void gemm_phase(PG8_LAS unsigned char* lds, const Gemm g, const Sched& S, const Epi& E) {
    int tid_ = threadIdx.x; asm volatile("" : "+v"(tid_));
    const int tid = tid_, wid = __builtin_amdgcn_readfirstlane(tid >> 6), lane = tid & 63, wr = wid >> 2, wc = wid & 3, fr = lane & 15, fq = lane >> 4;
    int K_ = g.K; asm volatile("" : "+s"(K_)); const int K = K_, nt = K / BK;
    unsigned voffA[2], voffB[2];
#pragma unroll
    for (int i = 0; i < 2; ++i) { int R, C; stage_rc(tid * 16 + i * 8192, R, C); const int Rb = Epi::PERM ? ((R & ~31) + perm32(R & 31)) : R;
        voffA[i] = (unsigned)(R * K + C) * 2u; voffB[i] = (unsigned)(Rb * K + C) * 2u; }
    const size_t kstep = (size_t)(BK * 2);
    const size_t hstep = (size_t)HALF * K * 2;
    const size_t tstep = 2 * hstep;
    const unsigned ldsw = (unsigned)wid * 1024u;
    const int aoff = lds_byte(wr * 64 + fr, fq * 8), boff = lds_byte(wc * 32 + fr, fq * 8);
#define PG8_SA(b, h) (((b) * 2 + (h)) * HTB)
#define PG8_SB(b, h) ((4 + (b) * 2 + (h)) * HTB)
#define PG8_STAGE(bufoff, gbase, voff) do { _Pragma("unroll") for (int _i = 0; _i < 2; ++_i) \
        __builtin_amdgcn_global_load_lds((const unsigned*)((const char*)(gbase) + (voff)[_i]), (PG8_LAS unsigned*)(lds + (bufoff) + ldsw + _i * 8192), 16, 0, 0); } while (0)
#define PG8_LDA(dst, b, h) do { _Pragma("unroll") for (int m = 0; m < 4; ++m) _Pragma("unroll") for (int k = 0; k < 2; ++k) dst[m][k] = *(const PG8_LAS bf16x8*)(lds + PG8_SA(b, h) + aoff + m * 2048 + k * 1024); } while (0)
#define PG8_LDB(dst, b, h) do { _Pragma("unroll") for (int n = 0; n < 2; ++n) _Pragma("unroll") for (int k = 0; k < 2; ++k) dst[n][k] = *(const PG8_LAS bf16x8*)(lds + PG8_SB(b, h) + boff + n * 2048 + k * 1024); } while (0)
#define PG8_MMA(ai, bj, At, Bt) do { __builtin_amdgcn_s_setprio(1); _Pragma("unroll") for (int m = 0; m < 4; ++m) _Pragma("unroll") for (int n = 0; n < 2; ++n) _Pragma("unroll") for (int k = 0; k < 2; ++k) \
        acc[ai][bj][m][n] = __builtin_amdgcn_mfma_f32_16x16x32_bf16(Bt[n][k], At[m][k], acc[ai][bj][m][n], 0, 0, 0); __builtin_amdgcn_s_setprio(0); } while (0)
#define PG8_WAIT_V(n) asm volatile("s_waitcnt vmcnt(" #n ")" ::: "memory")
#define PG8_WAIT_L(n) asm volatile("s_waitcnt lgkmcnt(" #n ")" ::: "memory")
#define PG8_BAR __builtin_amdgcn_s_barrier()
#define PG8_SCHED __builtin_amdgcn_sched_barrier(0)
    Unit cur, nxt; int ui = 0;
    if (!S.next(0, cur)) return;
    f32x4 acc[2][2][4][2];
#pragma unroll
    for (int a = 0; a < 2; ++a)
#pragma unroll
        for (int b = 0; b < 2; ++b)
#pragma unroll
            for (int m = 0; m < 4; ++m)
#pragma unroll
                for (int n = 0; n < 2; ++n) acc[a][b][m][n] = (f32x4){0.f, 0.f, 0.f, 0.f};
    bf16x8 At[4][2], B0[2][2], B1[2][2];
    const char* cA = (const char*)g.A + (size_t)cur.pm * tstep; const char* cB = (const char*)g.Bt + (size_t)cur.pn * tstep;
    S.a_ready(cur);
    if constexpr (SP2) {
        PG8_STAGE(PG8_SB(0, 0), cB, voffB); PG8_STAGE(PG8_SB(0, 1), cB + hstep, voffB); PG8_STAGE(PG8_SA(0, 0), cA, voffA); PG8_STAGE(PG8_SA(0, 1), cA + hstep, voffA);
        if (wr == 1) PG8_BAR;
        PG8_WAIT_V(2); PG8_BAR;
        PG8_STAGE(PG8_SB(1, 0), cB + kstep, voffB); PG8_STAGE(PG8_SA(1, 0), cA + kstep, voffA); PG8_STAGE(PG8_SB(1, 1), cB + hstep + kstep, voffB);
        PG8_WAIT_V(6); PG8_BAR;
    } else {
        PG8_STAGE(PG8_SB(0, 0), cB, voffB); PG8_STAGE(PG8_SA(0, 0), cA, voffA); PG8_STAGE(PG8_SB(0, 1), cB + hstep, voffB); PG8_STAGE(PG8_SA(0, 1), cA + hstep, voffA);
        if (wr == 1) PG8_BAR;
        PG8_WAIT_V(4); PG8_BAR;
        PG8_STAGE(PG8_SB(1, 0), cB + kstep, voffB); PG8_STAGE(PG8_SA(1, 0), cA + kstep, voffA); PG8_STAGE(PG8_SB(1, 1), cB + hstep + kstep, voffB);
        PG8_WAIT_V(6); PG8_BAR;
    }
    for (;;) {
        const bool has_next = S.next(ui + 1, nxt);
        const char* nA = has_next ? (const char*)g.A + (size_t)nxt.pm * tstep : cA; const char* nB = has_next ? (const char*)g.Bt + (size_t)nxt.pn * tstep : cB;
#pragma unroll 1
        for (int tt_ = 0; tt_ < PG8_KREP * nt; tt_ += 2) {
            const bool last = (tt_ == PG8_KREP * nt - 2); const int t = tt_ % nt; const int t2_ = (tt_ + 2) % nt;
            const char* a1 = cA + (size_t)(t + 1) * kstep;
            const char* a2 = last ? nA : cA + (size_t)t2_ * kstep; const char* b2 = last ? nB : cB + (size_t)t2_ * kstep;
            const char* a3 = a2 + kstep; const char* b3 = b2 + kstep;
            if (last && has_next) S.a_ready(nxt);
            if constexpr (SP2) {
            PG8_LDB(B0, 0, 0); PG8_LDB(B1, 0, 1); PG8_SCHED; PG8_LDA(At, 0, 0); PG8_STAGE(PG8_SA(1, 1), a1 + hstep, voffA);
            PG8_WAIT_V(8); PG8_WAIT_L(0); PG8_BAR; PG8_MMA(0, 0, At, B0); PG8_MMA(0, 1, At, B1); PG8_BAR; PG8_SCHED;
            PG8_LDA(At, 0, 1); PG8_STAGE(PG8_SB(0, 0), b2, voffB); PG8_STAGE(PG8_SB(0, 1), b2 + hstep, voffB); PG8_STAGE(PG8_SA(0, 0), a2, voffA);
            PG8_WAIT_V(8); PG8_WAIT_L(0); PG8_BAR; PG8_MMA(1, 0, At, B0); PG8_MMA(1, 1, At, B1); PG8_BAR; PG8_SCHED;
            PG8_LDB(B0, 1, 0); PG8_LDB(B1, 1, 1); PG8_SCHED; PG8_LDA(At, 1, 0); PG8_STAGE(PG8_SA(0, 1), a2 + hstep, voffA);
            PG8_WAIT_V(8); PG8_WAIT_L(0); PG8_BAR; PG8_MMA(0, 0, At, B0); PG8_MMA(0, 1, At, B1); PG8_BAR; PG8_SCHED;
            PG8_LDA(At, 1, 1); PG8_STAGE(PG8_SB(1, 0), b3, voffB); PG8_STAGE(PG8_SB(1, 1), b3 + hstep, voffB); PG8_STAGE(PG8_SA(1, 0), a3, voffA);
            PG8_WAIT_V(8); PG8_WAIT_L(0); PG8_BAR; PG8_MMA(1, 0, At, B0); PG8_MMA(1, 1, At, B1); PG8_BAR; PG8_SCHED;
            } else {
            PG8_LDB(B0, 0, 0); PG8_SCHED; PG8_LDA(At, 0, 0); PG8_STAGE(PG8_SA(1, 1), a1 + hstep, voffA);
            PG8_WAIT_L(8); PG8_BAR; PG8_WAIT_L(0); PG8_MMA(0, 0, At, B0); PG8_BAR; PG8_SCHED;
            PG8_LDB(B1, 0, 1); PG8_STAGE(PG8_SB(0, 0), b2, voffB);
            PG8_BAR; PG8_WAIT_L(0); PG8_MMA(0, 1, At, B1); PG8_BAR;
            PG8_LDA(At, 0, 1); PG8_STAGE(PG8_SA(0, 0), a2, voffA);
            PG8_BAR; PG8_WAIT_L(0); PG8_MMA(1, 0, At, B0); PG8_BAR; PG8_SCHED;
            PG8_STAGE(PG8_SB(0, 1), b2 + hstep, voffB);
            PG8_WAIT_V(6); PG8_BAR; PG8_MMA(1, 1, At, B1); PG8_BAR;
            PG8_LDB(B0, 1, 0); PG8_SCHED; PG8_LDA(At, 1, 0); PG8_STAGE(PG8_SA(0, 1), a2 + hstep, voffA);
            PG8_WAIT_L(8); PG8_BAR; PG8_WAIT_L(0); PG8_MMA(0, 0, At, B0); PG8_BAR; PG8_SCHED;
            PG8_LDB(B1, 1, 1); PG8_STAGE(PG8_SB(1, 0), b3, voffB);
            PG8_BAR; PG8_WAIT_L(0); PG8_MMA(0, 1, At, B1); PG8_BAR;
            PG8_LDA(At, 1, 1); PG8_STAGE(PG8_SA(1, 0), a3, voffA);
            PG8_BAR; PG8_WAIT_L(0); PG8_MMA(1, 0, At, B0); PG8_BAR; PG8_SCHED;
            PG8_STAGE(PG8_SB(1, 1), b3 + hstep, voffB);
            PG8_WAIT_V(6); PG8_BAR; PG8_MMA(1, 1, At, B1); PG8_BAR;
            }
        }
        if constexpr (ALIGN_EPI) { if (wr == 0) PG8_BAR; }
        if constexpr (!Epi::AFTER_DRAIN) { E(acc, cur, wr, wc, fr, fq); S.done(cur); }
        if (!has_next) break;
#pragma unroll
        for (int a = 0; a < 2; ++a)
#pragma unroll
            for (int b = 0; b < 2; ++b)
#pragma unroll
                for (int m = 0; m < 4; ++m)
#pragma unroll
                    for (int n = 0; n < 2; ++n) acc[a][b][m][n] = (f32x4){0.f, 0.f, 0.f, 0.f};
        cur = nxt; cA = nA; cB = nB; ++ui;
        if constexpr (ALIGN_EPI) { if (wr == 1) PG8_BAR; }
    }
    PG8_WAIT_V(0);
    if constexpr (!ALIGN_EPI) { if (wr == 0) PG8_BAR; }
    PG8_BAR;
    if constexpr (Epi::AFTER_DRAIN) { E.fused(acc, cur, wr, wc, fr, fq, lds, wid, lane); S.done(cur); }
#undef PG8_SA
#undef PG8_SB
#undef PG8_STAGE
#undef PG8_LDA
#undef PG8_LDB
#undef PG8_MMA
#undef PG8_WAIT_V
#undef PG8_WAIT_L
#undef PG8_BAR
#undef PG8_SCHED
}
template <class Epi, class Sched, bool ALIGN_EPI = false, bool SP2 = false>
__device__ __forceinline__ void gemm_phase_gather(PG8_LAS unsigned char* lds, const Gemm g, const Sched& S, const Epi& E, const int* __restrict__ rowidx) {
    int tid_ = threadIdx.x; asm volatile("" : "+v"(tid_));
    const int tid = tid_, wid = __builtin_amdgcn_readfirstlane(tid >> 6), lane = tid & 63, wr = wid >> 2, wc = wid & 3, fr = lane & 15, fq = lane >> 4;
    int K_ = g.K; asm volatile("" : "+s"(K_)); const int K = K_, nt = K / BK;
    static_assert(SP2, "gemm_phase_gather: SP2 loop only");
    unsigned voffA[2], voffB[2]; int rA[2]; unsigned cv0[2], cv1[2], nv0[2], nv1[2];
#pragma unroll
    for (int i = 0; i < 2; ++i) { int R, C; stage_rc(tid * 16 + i * 8192, R, C); const int Rb = Epi::PERM ? ((R & ~31) + perm32(R & 31)) : R;
        voffA[i] = (unsigned)C * 2u; rA[i] = R; voffB[i] = (unsigned)(Rb * K + C) * 2u; }
#define PG8_ROWOFF(dst0, dst1, u) do { _Pragma("unroll") for (int _i = 0; _i < 2; ++_i) { dst0[_i] = (unsigned)rowidx[(u).pm * 256 + rA[_i]] * (unsigned)(K * 2) + voffA[_i]; dst1[_i] = (unsigned)rowidx[(u).pm * 256 + 128 + rA[_i]] * (unsigned)(K * 2) + voffA[_i]; } } while (0)
    const size_t kstep = (size_t)(BK * 2);
    const size_t hstep = (size_t)HALF * K * 2;
    const size_t tstep = 2 * hstep;
    const unsigned ldsw = (unsigned)wid * 1024u;
    const int aoff = lds_byte(wr * 64 + fr, fq * 8), boff = lds_byte(wc * 32 + fr, fq * 8);
#define PG8_SA(b, h) (((b) * 2 + (h)) * HTB)
#define PG8_SB(b, h) ((4 + (b) * 2 + (h)) * HTB)
#define PG8_STAGE(bufoff, gbase, voff) do { _Pragma("unroll") for (int _i = 0; _i < 2; ++_i) \
        __builtin_amdgcn_global_load_lds((const unsigned*)((const char*)(gbase) + (voff)[_i]), (PG8_LAS unsigned*)(lds + (bufoff) + ldsw + _i * 8192), 16, 0, 0); } while (0)
#define PG8_LDA(dst, b, h) do { _Pragma("unroll") for (int m = 0; m < 4; ++m) _Pragma("unroll") for (int k = 0; k < 2; ++k) dst[m][k] = *(const PG8_LAS bf16x8*)(lds + PG8_SA(b, h) + aoff + m * 2048 + k * 1024); } while (0)
#define PG8_LDB(dst, b, h) do { _Pragma("unroll") for (int n = 0; n < 2; ++n) _Pragma("unroll") for (int k = 0; k < 2; ++k) dst[n][k] = *(const PG8_LAS bf16x8*)(lds + PG8_SB(b, h) + boff + n * 2048 + k * 1024); } while (0)
#define PG8_MMA(ai, bj, At, Bt) do { __builtin_amdgcn_s_setprio(1); _Pragma("unroll") for (int m = 0; m < 4; ++m) _Pragma("unroll") for (int n = 0; n < 2; ++n) _Pragma("unroll") for (int k = 0; k < 2; ++k) \
        acc[ai][bj][m][n] = __builtin_amdgcn_mfma_f32_16x16x32_bf16(Bt[n][k], At[m][k], acc[ai][bj][m][n], 0, 0, 0); __builtin_amdgcn_s_setprio(0); } while (0)
#define PG8_WAIT_V(n) asm volatile("s_waitcnt vmcnt(" #n ")" ::: "memory")
#define PG8_WAIT_L(n) asm volatile("s_waitcnt lgkmcnt(" #n ")" ::: "memory")
#define PG8_BAR __builtin_amdgcn_s_barrier()
#define PG8_SCHED __builtin_amdgcn_sched_barrier(0)
    Unit cur, nxt; int ui = 0;
    if (!S.next(0, cur)) return;
    f32x4 acc[2][2][4][2];
#pragma unroll
    for (int a = 0; a < 2; ++a)
#pragma unroll
        for (int b = 0; b < 2; ++b)
#pragma unroll
            for (int m = 0; m < 4; ++m)
#pragma unroll
                for (int n = 0; n < 2; ++n) acc[a][b][m][n] = (f32x4){0.f, 0.f, 0.f, 0.f};
    bf16x8 At[4][2], B0[2][2], B1[2][2];
    const char* cA = (const char*)g.A; const char* cB = (const char*)g.Bt + (size_t)cur.pn * tstep;
    PG8_ROWOFF(cv0, cv1, cur);
    S.a_ready(cur);
    if constexpr (SP2) {
        PG8_STAGE(PG8_SB(0, 0), cB, voffB); PG8_STAGE(PG8_SB(0, 1), cB + hstep, voffB); PG8_STAGE(PG8_SA(0, 0), cA, cv0); PG8_STAGE(PG8_SA(0, 1), cA, cv1);
        if (wr == 1) PG8_BAR;
        PG8_WAIT_V(2); PG8_BAR;
        PG8_STAGE(PG8_SB(1, 0), cB + kstep, voffB); PG8_STAGE(PG8_SA(1, 0), cA + kstep, cv0); PG8_STAGE(PG8_SB(1, 1), cB + hstep + kstep, voffB);
        PG8_WAIT_V(6); PG8_BAR;
    } else {
        PG8_STAGE(PG8_SB(0, 0), cB, voffB); PG8_STAGE(PG8_SA(0, 0), cA, voffA); PG8_STAGE(PG8_SB(0, 1), cB + hstep, voffB); PG8_STAGE(PG8_SA(0, 1), cA + hstep, voffA);
        if (wr == 1) PG8_BAR;
        PG8_WAIT_V(4); PG8_BAR;
        PG8_STAGE(PG8_SB(1, 0), cB + kstep, voffB); PG8_STAGE(PG8_SA(1, 0), cA + kstep, voffA); PG8_STAGE(PG8_SB(1, 1), cB + hstep + kstep, voffB);
        PG8_WAIT_V(6); PG8_BAR;
    }
    for (;;) {
        const bool has_next = S.next(ui + 1, nxt);
        const char* nA = cA; const char* nB = has_next ? (const char*)g.Bt + (size_t)nxt.pn * tstep : cB;
        if (has_next) PG8_ROWOFF(nv0, nv1, nxt); else { _Pragma("unroll") for (int _i = 0; _i < 2; ++_i) { nv0[_i] = cv0[_i]; nv1[_i] = cv1[_i]; } }
#pragma unroll 1
        for (int t = 0; t < nt; t += 2) {
            const bool last = (t == nt - 2);
            const char* a1 = cA + (size_t)(t + 1) * kstep;
            const char* a2 = last ? nA : cA + (size_t)(t + 2) * kstep; unsigned x0[2], x1[2]; _Pragma("unroll") for (int _i = 0; _i < 2; ++_i) { x0[_i] = last ? nv0[_i] : cv0[_i]; x1[_i] = last ? nv1[_i] : cv1[_i]; } const char* b2 = last ? nB : cB + (size_t)(t + 2) * kstep;
            const char* a3 = a2 + kstep; const char* b3 = b2 + kstep;
            if (last && has_next) S.a_ready(nxt);
            if constexpr (SP2) {
            PG8_LDB(B0, 0, 0); PG8_LDB(B1, 0, 1); PG8_SCHED; PG8_LDA(At, 0, 0); PG8_STAGE(PG8_SA(1, 1), a1, cv1);
            PG8_WAIT_V(8); PG8_WAIT_L(0); PG8_BAR; PG8_MMA(0, 0, At, B0); PG8_MMA(0, 1, At, B1); PG8_BAR; PG8_SCHED;
            PG8_LDA(At, 0, 1); PG8_STAGE(PG8_SB(0, 0), b2, voffB); PG8_STAGE(PG8_SB(0, 1), b2 + hstep, voffB); PG8_STAGE(PG8_SA(0, 0), a2, x0);
            PG8_WAIT_V(8); PG8_WAIT_L(0); PG8_BAR; PG8_MMA(1, 0, At, B0); PG8_MMA(1, 1, At, B1); PG8_BAR; PG8_SCHED;
            PG8_LDB(B0, 1, 0); PG8_LDB(B1, 1, 1); PG8_SCHED; PG8_LDA(At, 1, 0); PG8_STAGE(PG8_SA(0, 1), a2, x1);
            PG8_WAIT_V(8); PG8_WAIT_L(0); PG8_BAR; PG8_MMA(0, 0, At, B0); PG8_MMA(0, 1, At, B1); PG8_BAR; PG8_SCHED;
            PG8_LDA(At, 1, 1); PG8_STAGE(PG8_SB(1, 0), b3, voffB); PG8_STAGE(PG8_SB(1, 1), b3 + hstep, voffB); PG8_STAGE(PG8_SA(1, 0), a3, x0);
            PG8_WAIT_V(8); PG8_WAIT_L(0); PG8_BAR; PG8_MMA(1, 0, At, B0); PG8_MMA(1, 1, At, B1); PG8_BAR; PG8_SCHED;
            } else {
            PG8_LDB(B0, 0, 0); PG8_SCHED; PG8_LDA(At, 0, 0); PG8_STAGE(PG8_SA(1, 1), a1 + hstep, voffA);
            PG8_WAIT_L(8); PG8_BAR; PG8_WAIT_L(0); PG8_MMA(0, 0, At, B0); PG8_BAR; PG8_SCHED;
            PG8_LDB(B1, 0, 1); PG8_STAGE(PG8_SB(0, 0), b2, voffB);
            PG8_BAR; PG8_WAIT_L(0); PG8_MMA(0, 1, At, B1); PG8_BAR;
            PG8_LDA(At, 0, 1); PG8_STAGE(PG8_SA(0, 0), a2, voffA);
            PG8_BAR; PG8_WAIT_L(0); PG8_MMA(1, 0, At, B0); PG8_BAR; PG8_SCHED;
            PG8_STAGE(PG8_SB(0, 1), b2 + hstep, voffB);
            PG8_WAIT_V(6); PG8_BAR; PG8_MMA(1, 1, At, B1); PG8_BAR;
            PG8_LDB(B0, 1, 0); PG8_SCHED; PG8_LDA(At, 1, 0); PG8_STAGE(PG8_SA(0, 1), a2 + hstep, voffA);
            PG8_WAIT_L(8); PG8_BAR; PG8_WAIT_L(0); PG8_MMA(0, 0, At, B0); PG8_BAR; PG8_SCHED;
            PG8_LDB(B1, 1, 1); PG8_STAGE(PG8_SB(1, 0), b3, voffB);
            PG8_BAR; PG8_WAIT_L(0); PG8_MMA(0, 1, At, B1); PG8_BAR;
            PG8_LDA(At, 1, 1); PG8_STAGE(PG8_SA(1, 0), a3, voffA);
            PG8_BAR; PG8_WAIT_L(0); PG8_MMA(1, 0, At, B0); PG8_BAR; PG8_SCHED;
            PG8_STAGE(PG8_SB(1, 1), b3 + hstep, voffB);
            PG8_WAIT_V(6); PG8_BAR; PG8_MMA(1, 1, At, B1); PG8_BAR;
            }
        }
        if constexpr (ALIGN_EPI) { if (wr == 0) PG8_BAR; }
        if constexpr (!Epi::AFTER_DRAIN) { E(acc, cur, wr, wc, fr, fq); S.done(cur); }
        if (!has_next) break;
#pragma unroll
        for (int a = 0; a < 2; ++a)
#pragma unroll
            for (int b = 0; b < 2; ++b)
#pragma unroll
                for (int m = 0; m < 4; ++m)
#pragma unroll
                    for (int n = 0; n < 2; ++n) acc[a][b][m][n] = (f32x4){0.f, 0.f, 0.f, 0.f};
        cur = nxt; cA = nA; cB = nB; ++ui; _Pragma("unroll") for (int _i = 0; _i < 2; ++_i) { cv0[_i] = nv0[_i]; cv1[_i] = nv1[_i]; }
        if constexpr (ALIGN_EPI) { if (wr == 1) PG8_BAR; }
    }
    PG8_WAIT_V(0);
    if constexpr (!ALIGN_EPI) { if (wr == 0) PG8_BAR; }
    PG8_BAR;
    if constexpr (Epi::AFTER_DRAIN) { E.fused(acc, cur, wr, wc, fr, fq, lds, wid, lane); S.done(cur); }
#undef PG8_SA
#undef PG8_SB
#undef PG8_STAGE
#undef PG8_LDA
#undef PG8_LDB
#undef PG8_MMA
#undef PG8_WAIT_V
#undef PG8_WAIT_L
#undef PG8_BAR
#undef PG8_SCHED
#undef PG8_ROWOFF
}
template <class Epi, class Sched, bool ALIGN_EPI = false, bool SP2 = false>
__device__ __forceinline__ void gemm_phase_seg(PG8_LAS unsigned char* lds, const Gemm g, const Sched& S, const Epi& E) {
    int tid_ = threadIdx.x; asm volatile("" : "+v"(tid_));
    const int tid = tid_, wid = __builtin_amdgcn_readfirstlane(tid >> 6), lane = tid & 63, wr = wid >> 2, wc = wid & 3, fr = lane & 15, fq = lane >> 4;
    int K_ = g.K; asm volatile("" : "+s"(K_)); const int K = K_; int nt;
    unsigned voffA[2], voffB[2];
#pragma unroll
    for (int i = 0; i < 2; ++i) { int R, C; stage_rc(tid * 16 + i * 8192, R, C); const int Rb = Epi::PERM ? ((R & ~31) + perm32(R & 31)) : R;
        voffA[i] = (unsigned)(R * K + C) * 2u; voffB[i] = (unsigned)(Rb * K + C) * 2u; }
    const size_t kstep = (size_t)(BK * 2);
    const size_t hstep = (size_t)HALF * K * 2;
    const size_t tstep = 2 * hstep;
    const unsigned ldsw = (unsigned)wid * 1024u;
    const int aoff = lds_byte(wr * 64 + fr, fq * 8), boff = lds_byte(wc * 32 + fr, fq * 8);
#define PG8_SA(b, h) (((b) * 2 + (h)) * HTB)
#define PG8_SB(b, h) ((4 + (b) * 2 + (h)) * HTB)
#define PG8_STAGE(bufoff, gbase, voff) do { _Pragma("unroll") for (int _i = 0; _i < 2; ++_i) \
        __builtin_amdgcn_global_load_lds((const unsigned*)((const char*)(gbase) + (voff)[_i]), (PG8_LAS unsigned*)(lds + (bufoff) + ldsw + _i * 8192), 16, 0, 0); } while (0)
#define PG8_LDA(dst, b, h) do { _Pragma("unroll") for (int m = 0; m < 4; ++m) _Pragma("unroll") for (int k = 0; k < 2; ++k) dst[m][k] = *(const PG8_LAS bf16x8*)(lds + PG8_SA(b, h) + aoff + m * 2048 + k * 1024); } while (0)
#define PG8_LDB(dst, b, h) do { _Pragma("unroll") for (int n = 0; n < 2; ++n) _Pragma("unroll") for (int k = 0; k < 2; ++k) dst[n][k] = *(const PG8_LAS bf16x8*)(lds + PG8_SB(b, h) + boff + n * 2048 + k * 1024); } while (0)
#define PG8_MMA(ai, bj, At, Bt) do { __builtin_amdgcn_s_setprio(1); _Pragma("unroll") for (int m = 0; m < 4; ++m) _Pragma("unroll") for (int n = 0; n < 2; ++n) _Pragma("unroll") for (int k = 0; k < 2; ++k) \
        acc[ai][bj][m][n] = __builtin_amdgcn_mfma_f32_16x16x32_bf16(Bt[n][k], At[m][k], acc[ai][bj][m][n], 0, 0, 0); __builtin_amdgcn_s_setprio(0); } while (0)
#define PG8_WAIT_V(n) asm volatile("s_waitcnt vmcnt(" #n ")" ::: "memory")
#define PG8_WAIT_L(n) asm volatile("s_waitcnt lgkmcnt(" #n ")" ::: "memory")
#define PG8_BAR __builtin_amdgcn_s_barrier()
#define PG8_SCHED __builtin_amdgcn_sched_barrier(0)
    typename Sched::U cur, nxt; int ui = 0;
    if (!S.next(0, cur)) return;
    f32x4 acc[2][2][4][2];
#pragma unroll
    for (int a = 0; a < 2; ++a)
#pragma unroll
        for (int b = 0; b < 2; ++b)
#pragma unroll
            for (int m = 0; m < 4; ++m)
#pragma unroll
                for (int n = 0; n < 2; ++n) acc[a][b][m][n] = (f32x4){0.f, 0.f, 0.f, 0.f};
    bf16x8 At[4][2], B0[2][2], B1[2][2];
    const char* cA = S.baseA(cur); const char* cB = S.baseB(cur); nt = S.nt(cur); (void)tstep;
    S.a_ready(cur);
    if constexpr (SP2) {
        PG8_STAGE(PG8_SB(0, 0), cB, voffB); PG8_STAGE(PG8_SB(0, 1), cB + hstep, voffB); PG8_STAGE(PG8_SA(0, 0), cA, voffA); PG8_STAGE(PG8_SA(0, 1), cA + hstep, voffA);
        if (wr == 1) PG8_BAR;
        PG8_WAIT_V(2); PG8_BAR;
        PG8_STAGE(PG8_SB(1, 0), cB + kstep, voffB); PG8_STAGE(PG8_SA(1, 0), cA + kstep, voffA); PG8_STAGE(PG8_SB(1, 1), cB + hstep + kstep, voffB);
        PG8_WAIT_V(6); PG8_BAR;
    } else {
        PG8_STAGE(PG8_SB(0, 0), cB, voffB); PG8_STAGE(PG8_SA(0, 0), cA, voffA); PG8_STAGE(PG8_SB(0, 1), cB + hstep, voffB); PG8_STAGE(PG8_SA(0, 1), cA + hstep, voffA);
        if (wr == 1) PG8_BAR;
        PG8_WAIT_V(4); PG8_BAR;
        PG8_STAGE(PG8_SB(1, 0), cB + kstep, voffB); PG8_STAGE(PG8_SA(1, 0), cA + kstep, voffA); PG8_STAGE(PG8_SB(1, 1), cB + hstep + kstep, voffB);
        PG8_WAIT_V(6); PG8_BAR;
    }
    for (;;) {
        const bool has_next = S.next(ui + 1, nxt);
        const char* nA = has_next ? S.baseA(nxt) : cA; const char* nB = has_next ? S.baseB(nxt) : cB;
#pragma unroll 1
        for (int t = 0; t < nt; t += 2) {
            const bool last = (t == nt - 2);
            const char* a1 = cA + (size_t)(t + 1) * kstep;
            const char* a2 = last ? nA : cA + (size_t)(t + 2) * kstep; const char* b2 = last ? nB : cB + (size_t)(t + 2) * kstep;
            const char* a3 = a2 + kstep; const char* b3 = b2 + kstep;
            if (last && has_next) S.a_ready(nxt);
            if constexpr (SP2) {
            PG8_LDB(B0, 0, 0); PG8_LDB(B1, 0, 1); PG8_SCHED; PG8_LDA(At, 0, 0); PG8_STAGE(PG8_SA(1, 1), a1 + hstep, voffA);
            PG8_WAIT_V(8); PG8_WAIT_L(0); PG8_BAR; PG8_MMA(0, 0, At, B0); PG8_MMA(0, 1, At, B1); PG8_BAR; PG8_SCHED;
            PG8_LDA(At, 0, 1); PG8_STAGE(PG8_SB(0, 0), b2, voffB); PG8_STAGE(PG8_SB(0, 1), b2 + hstep, voffB); PG8_STAGE(PG8_SA(0, 0), a2, voffA);
            PG8_WAIT_V(8); PG8_WAIT_L(0); PG8_BAR; PG8_MMA(1, 0, At, B0); PG8_MMA(1, 1, At, B1); PG8_BAR; PG8_SCHED;
            PG8_LDB(B0, 1, 0); PG8_LDB(B1, 1, 1); PG8_SCHED; PG8_LDA(At, 1, 0); PG8_STAGE(PG8_SA(0, 1), a2 + hstep, voffA);
            PG8_WAIT_V(8); PG8_WAIT_L(0); PG8_BAR; PG8_MMA(0, 0, At, B0); PG8_MMA(0, 1, At, B1); PG8_BAR; PG8_SCHED;
            PG8_LDA(At, 1, 1); PG8_STAGE(PG8_SB(1, 0), b3, voffB); PG8_STAGE(PG8_SB(1, 1), b3 + hstep, voffB); PG8_STAGE(PG8_SA(1, 0), a3, voffA);
            PG8_WAIT_V(8); PG8_WAIT_L(0); PG8_BAR; PG8_MMA(1, 0, At, B0); PG8_MMA(1, 1, At, B1); PG8_BAR; PG8_SCHED;
            } else {
            PG8_LDB(B0, 0, 0); PG8_SCHED; PG8_LDA(At, 0, 0); PG8_STAGE(PG8_SA(1, 1), a1 + hstep, voffA);
            PG8_WAIT_L(8); PG8_BAR; PG8_WAIT_L(0); PG8_MMA(0, 0, At, B0); PG8_BAR; PG8_SCHED;
            PG8_LDB(B1, 0, 1); PG8_STAGE(PG8_SB(0, 0), b2, voffB);
            PG8_BAR; PG8_WAIT_L(0); PG8_MMA(0, 1, At, B1); PG8_BAR;
            PG8_LDA(At, 0, 1); PG8_STAGE(PG8_SA(0, 0), a2, voffA);
            PG8_BAR; PG8_WAIT_L(0); PG8_MMA(1, 0, At, B0); PG8_BAR; PG8_SCHED;
            PG8_STAGE(PG8_SB(0, 1), b2 + hstep, voffB);
            PG8_WAIT_V(6); PG8_BAR; PG8_MMA(1, 1, At, B1); PG8_BAR;
            PG8_LDB(B0, 1, 0); PG8_SCHED; PG8_LDA(At, 1, 0); PG8_STAGE(PG8_SA(0, 1), a2 + hstep, voffA);
            PG8_WAIT_L(8); PG8_BAR; PG8_WAIT_L(0); PG8_MMA(0, 0, At, B0); PG8_BAR; PG8_SCHED;
            PG8_LDB(B1, 1, 1); PG8_STAGE(PG8_SB(1, 0), b3, voffB);
            PG8_BAR; PG8_WAIT_L(0); PG8_MMA(0, 1, At, B1); PG8_BAR;
            PG8_LDA(At, 1, 1); PG8_STAGE(PG8_SA(1, 0), a3, voffA);
            PG8_BAR; PG8_WAIT_L(0); PG8_MMA(1, 0, At, B0); PG8_BAR; PG8_SCHED;
            PG8_STAGE(PG8_SB(1, 1), b3 + hstep, voffB);
            PG8_WAIT_V(6); PG8_BAR; PG8_MMA(1, 1, At, B1); PG8_BAR;
            }
        }
        if constexpr (ALIGN_EPI) { if (wr == 0) PG8_BAR; }
        if constexpr (!Epi::AFTER_DRAIN) { E(acc, cur, wr, wc, fr, fq); S.done(cur); }
        if (!has_next) break;
        if (!S.keep(cur)) {
#pragma unroll
        for (int a = 0; a < 2; ++a)
#pragma unroll
            for (int b = 0; b < 2; ++b)
#pragma unroll
                for (int m = 0; m < 4; ++m)
#pragma unroll
                    for (int n = 0; n < 2; ++n) acc[a][b][m][n] = (f32x4){0.f, 0.f, 0.f, 0.f};
        }
        cur = nxt; cA = nA; cB = nB; nt = S.nt(cur); ++ui;
        if constexpr (ALIGN_EPI) { if (wr == 1) PG8_BAR; }
    }
    PG8_WAIT_V(0);
    if constexpr (!ALIGN_EPI) { if (wr == 0) PG8_BAR; }
    PG8_BAR;
    if constexpr (Epi::AFTER_DRAIN) { E.fused(acc, cur, wr, wc, fr, fq, lds, wid, lane); S.done(cur); }
#undef PG8_SA
#undef PG8_SB
#undef PG8_STAGE
#undef PG8_LDA
#undef PG8_LDB
#undef PG8_MMA
#undef PG8_WAIT_V
#undef PG8_WAIT_L
#undef PG8_BAR
#undef PG8_SCHED
}
}

constexpr int NB = 4, S = 4096, T = NB * S, D = 1024, NL = 4;
constexpr int NH = 8, DQK = 96, QR = 384, KVR = 256;
constexpr int NIN_SRC = 5792, NIN = 5888;
constexpr int NE = 16, FF = 1024, CAP = 512;
constexpr float EPS = 1e-6f;
constexpr int NWAVES = 8;

constexpr size_t MiB = 1u << 20;
constexpr size_t WS_CTL = 0, CTL_ZERO_BYTES = 64 * 1024;
constexpr size_t WS_MOD = 1 * MiB;
constexpr size_t WS_COS = 2 * MiB, WS_SIN = 3 * MiB;
constexpr size_t WS_PART = 4 * MiB;
constexpr size_t WS_AFF = 5 * MiB;
constexpr size_t WS_SLOT = 6 * MiB;
constexpr size_t WS_KMAX = 7 * MiB, WS_IDX = 7 * MiB + 512 * 1024;
constexpr size_t WS_W = 8 * MiB;
constexpr size_t WO_IN = 0, WO_UQ = WO_IN + (size_t)NIN * D * 2, WO_UKV = WO_UQ + (size_t)768 * QR * 2, WO_OA = WO_UKV + (size_t)1024 * KVR * 2,
                 WO_POOL = WO_OA + (size_t)D * 512 * 2, WO_OC = WO_POOL + (size_t)D * 512 * 2, WO_OUT = WO_OC + (size_t)D * 512 * 2,
                 WO_GU = WO_OUT + (size_t)D * D * 2, WO_DN = WO_GU + (size_t)NE * 2048 * D * 2, WL_BYTES = WO_DN + (size_t)NE * D * FF * 2;
static_assert(WS_W + NL * WL_BYTES <= 464 * MiB, "weights fit");
constexpr size_t WS_X = 464 * MiB, WS_H = 528 * MiB;
constexpr size_t WS_CQ = 560 * MiB, WS_CKV = 572 * MiB, WS_KR = 580 * MiB, WS_U = 581 * MiB, WS_CV = 597 * MiB, WS_GT = 645 * MiB, WS_Q = 741 * MiB,
                 WS_KV = 765 * MiB, WS_MIX = 797 * MiB, WS_CY = 813 * MiB, WS_O = 829 * MiB, WS_MG = 845 * MiB, WS_END = 877 * MiB;
constexpr size_t WS_XG = 560 * MiB, WS_ACT = 624 * MiB, WS_Y = 688 * MiB;
constexpr int CW_BAR = 4096;

constexpr int LDS_BYTES = 147456;
constexpr int MISC_OFF = 131072 + 1024;
constexpr int LDS_BIAS = 131072 + 2048;

#define GAS __attribute__((address_space(1)))
#define LAS __attribute__((address_space(3)))
typedef unsigned short bf16;
typedef unsigned v4u __attribute__((ext_vector_type(4)));
typedef unsigned v2u __attribute__((ext_vector_type(2)));
using pg8::f32x4;
using pg8::bf16x8;
#define LDS_WAIT() asm volatile("s_waitcnt lgkmcnt(0)" ::: "memory")
#define VM_WAIT() asm volatile("s_waitcnt vmcnt(0)" ::: "memory")
__device__ __forceinline__ unsigned pk2(float lo, float hi) { return pg8::cvt_pk_bf16(lo, hi); }
__device__ __forceinline__ float bflo(unsigned w) { return __uint_as_float(w << 16); }
__device__ __forceinline__ float bfhi(unsigned w) { return __uint_as_float(w & 0xffff0000u); }
__device__ __forceinline__ v4u pack8(const f32x4& a, const f32x4& b) { v4u w; w.x = pk2(a[0], a[1]); w.y = pk2(a[2], a[3]); w.z = pk2(b[0], b[1]); w.w = pk2(b[2], b[3]); return w; }
__device__ __forceinline__ void unpack8(const v4u& w, f32x4& a, f32x4& b) { a = (f32x4){bflo(w.x), bfhi(w.x), bflo(w.y), bfhi(w.y)}; b = (f32x4){bflo(w.z), bfhi(w.z), bflo(w.w), bfhi(w.w)}; }
__device__ __forceinline__ float wave_sum(float v) {
#pragma unroll
    for (int o = 1; o < 64; o <<= 1) v += __shfl_xor(v, o);
    return v;
}
__device__ __forceinline__ float wave_max(float v) {
#pragma unroll
    for (int o = 1; o < 64; o <<= 1) v = fmaxf(v, __shfl_xor(v, o));
    return v;
}
__device__ __forceinline__ unsigned char* opaque(unsigned char* p) { size_t z = 0; asm volatile("" : "+s"(z)); return p + z; }
constexpr float QSCALE = 0.10206207261596575f * 1.4426950408889634f;
__device__ __forceinline__ int otid() { int t = threadIdx.x; asm volatile("" : "+v"(t)); return t; }
__device__ __forceinline__ float sigmoidf_(float x) { return fmaxf(__builtin_amdgcn_rcpf(1.0f + __expf(-x)), 1e-30f); }

#ifndef EPI_REP
#define EPI_REP 1
#endif
struct NoCarry { };
template <class F, int FENCE = 1, bool KREP_SITE = true> struct Epi8 {
    static constexpr bool PERM = true, AFTER_DRAIN = false;
    F f;
    __device__ __forceinline__ void operator()(const f32x4 (&acc)[2][2][4][2], const pg8::Unit& u, int wr, int wc, int fr, int fq) const {
        const int row0 = u.pm * 256 + wr * 64 + fr, col = u.pn * 256 + wc * 32 + 8 * fq;
        typename F::Carry carry{};
#pragma unroll
        for (int g0 = 0; g0 < 8; g0 += FENCE) {
            typename F::L ld[FENCE];
#pragma unroll
            for (int k = 0; k < FENCE; ++k) { const int ai = (g0 + k) >> 2, m = (g0 + k) & 3; ld[k] = f.pre(u, row0 + ai * 128 + m * 16, col); }
#pragma unroll
            for (int k = 0; k < FENCE; ++k) { const int ai = (g0 + k) >> 2, m = (g0 + k) & 3; constexpr float kr = KREP_SITE ? 1.0f / PG8_KREP : 1.0f;
                f.post(u, row0 + ai * 128 + m * 16, col, ld[k], acc[ai][0][m][0] * kr, acc[ai][0][m][1] * kr, acc[ai][1][m][0] * kr, acc[ai][1][m][1] * kr, carry); }
            asm volatile("" ::: "memory");
        }
        f.finish(u, wr, wc, carry);
    }
};

template <class Epi, class Sched>
__device__ __forceinline__ void naive_gemm_phase(LAS unsigned char* lds, const pg8::Gemm g, const Sched& Sd, const Epi& E) {
    const int tid = otid(), wid = tid >> 6, lane = tid & 63, wr = wid >> 2, wc = wid & 3, fr = lane & 15, fq = lane >> 4;
    const int K = g.K;
    LAS bf16* As = (LAS bf16*)lds; LAS bf16* Bs = (LAS bf16*)(lds + 256 * 72 * 2);
    pg8::Unit u;
    for (int ui = 0; Sd.next(ui, u); ++ui) {
        f32x4 acc[2][2][4][2];
#pragma unroll
        for (int a = 0; a < 2; ++a)
#pragma unroll
            for (int b = 0; b < 2; ++b)
#pragma unroll
                for (int m = 0; m < 4; ++m)
#pragma unroll
                    for (int n = 0; n < 2; ++n) acc[a][b][m][n] = (f32x4){0.f, 0.f, 0.f, 0.f};
        for (int k0 = 0; k0 < K; k0 += 64) {
            __syncthreads();
#pragma unroll
            for (int i = 0; i < 4; ++i) { const int id = tid + 512 * i, r = id >> 3, c8 = id & 7;
                *(LAS v4u*)(As + r * 72 + c8 * 8) = *(const v4u*)(g.A + (size_t)(u.pm * 256 + r) * K + k0 + c8 * 8);
                *(LAS v4u*)(Bs + r * 72 + c8 * 8) = *(const v4u*)(g.Bt + (size_t)(u.pn * 256 + r) * K + k0 + c8 * 8); }
            __syncthreads();
#pragma unroll 1
            for (int kk = 0; kk < 64; kk += 8) {
                v4u af[2][4];
#pragma unroll
                for (int ai = 0; ai < 2; ++ai)
#pragma unroll
                    for (int m = 0; m < 4; ++m) af[ai][m] = *(const LAS v4u*)(As + (128 * ai + 64 * wr + 16 * m + fr) * 72 + kk);
#pragma unroll
                for (int bj = 0; bj < 2; ++bj)
#pragma unroll
                    for (int n = 0; n < 2; ++n)
#pragma unroll
                        for (int i = 0; i < 4; ++i) {
                            const v4u bw = *(const LAS v4u*)(Bs + (128 * bj + 32 * wc + 8 * fq + 4 * n + i) * 72 + kk);
                            f32x4 b0, b1; unpack8(bw, b0, b1);
#pragma unroll
                            for (int ai = 0; ai < 2; ++ai)
#pragma unroll
                                for (int m = 0; m < 4; ++m) { f32x4 a0, a1; unpack8(af[ai][m], a0, a1);
                                    float s = acc[ai][bj][m][n][i];
                                    s += a0[0] * b0[0]; s += a0[1] * b0[1]; s += a0[2] * b0[2]; s += a0[3] * b0[3];
                                    s += a1[0] * b1[0]; s += a1[1] * b1[1]; s += a1[2] * b1[2]; s += a1[3] * b1[3];
                                    acc[ai][bj][m][n][i] = s; }
                        }
            }
        }
        E(acc, u, wr, wc, fr, fq);
    }
    __syncthreads();
}
#ifndef PG8_ALIGN
#define PG8_ALIGN true
#endif
#ifndef PG8_SP2
#define PG8_SP2 true
#endif
template <int SITE, class Epi, class Sched>
__device__ __forceinline__ void run_gemm(LAS unsigned char* lds, const pg8::Gemm g, const Sched& Sd, const Epi& E) {
    if constexpr ((NAIVE_GEMM_MASK >> SITE) & 1) naive_gemm_phase<Epi, Sched>(lds, g, Sd, E);
    else pg8::gemm_phase<Epi, Sched, true, PG8_SP2>(lds, g, Sd, E);
}

namespace att {
using s16x4 = __attribute__((ext_vector_type(4))) short;
using f32x16 = __attribute__((ext_vector_type(16))) float;
constexpr int NW = 8, QBLK = 32, KVBLK = 64;
constexpr float SCALE = 0.10206207261596575f;
constexpr float THR = 8.f;
constexpr int LDQ = 768, LDKV = 1024, LDKR = 32, LDO = 512;
constexpr int SHM_V = KVBLK * 64 * 2, SHM_K = KVBLK * 256, SHM_ATTN = 2 * SHM_V + 2 * SHM_K + NW * 64 * 4;
#define KSWZ(row, colB) ((row) * 256 + ((colB) ^ (((row) & 7) << 4)))
#define SBAR() __builtin_amdgcn_sched_barrier(0)
__device__ __forceinline__ int crow(int r, int hi) { return (r & 3) + 8 * (r >> 2) + 4 * hi; }
__device__ __forceinline__ unsigned cvtpk(float lo, float hi) { unsigned r; asm volatile("v_cvt_pk_bf16_f32 %0, %1, %2" : "=v"(r) : "v"(lo), "v"(hi)); return r; }

constexpr float THR2 = THR * 1.4426950408889634f;
template <bool FAST> __device__ __forceinline__ void partialSM(f32x16& p0, f32x16& p1, float& m_reg, float& mn, float& alpha) {
  if constexpr (!FAST) {
    float pmax = p0[0];
#pragma unroll
    for (int r = 1; r < 16; ++r) pmax = fmaxf(pmax, p0[r]);
#pragma unroll
    for (int r = 0; r < 16; ++r) pmax = fmaxf(pmax, p1[r]);
    { auto rr = __builtin_amdgcn_permlane32_swap(__float_as_uint(pmax), __float_as_uint(pmax), false, false);
      pmax = fmaxf(__uint_as_float(rr[0]), __uint_as_float(rr[1])); }
    if (__builtin_expect(__all(pmax - m_reg <= THR2), 1)) { mn = m_reg; alpha = 1.f; }
    else { mn = fmaxf(m_reg, pmax); alpha = __builtin_amdgcn_exp2f(m_reg - mn); m_reg = mn; }
#pragma unroll
    for (int r = 0; r < 16; ++r) p0[r] -= mn;
#pragma unroll
    for (int r = 0; r < 16; ++r) p1[r] -= mn;
  } else { alpha = 1.f; mn = 0.f; }
#pragma unroll
  for (int r = 0; r < 16; ++r) p0[r] = __builtin_amdgcn_exp2f(p0[r]);
}
template <bool FAST> __device__ __forceinline__ void finishSM(f32x16& p0, f32x16& p1, float alpha, float& l_reg, bf16x8& pa0, bf16x8& pa1, bf16x8& pa2, bf16x8& pa3) {
#pragma unroll
  for (int r = 0; r < 16; ++r) p1[r] = __builtin_amdgcn_exp2f(p1[r]);
  float ps = 0;
#pragma unroll
  for (int r = 0; r < 16; ++r) ps += p0[r];
#pragma unroll
  for (int r = 0; r < 16; ++r) ps += p1[r];
  { auto rr = __builtin_amdgcn_permlane32_swap(__float_as_uint(ps), __float_as_uint(ps), false, false);
    ps = __uint_as_float(rr[0]) + __uint_as_float(rr[1]); }
  if constexpr (FAST) l_reg += ps; else l_reg = l_reg * alpha + ps;
#define PK4(P, BASE, OUT) do { unsigned a0 = cvtpk(P[BASE + 0], P[BASE + 1]), a1 = cvtpk(P[BASE + 2], P[BASE + 3]);   \
    unsigned b0 = cvtpk(P[BASE + 4], P[BASE + 5]), b1 = cvtpk(P[BASE + 6], P[BASE + 7]);                              \
    auto r0 = __builtin_amdgcn_permlane32_swap(a0, b0, false, false); auto r1 = __builtin_amdgcn_permlane32_swap(a1, b1, false, false); \
    v4u w = {r0[0], r1[0], r0[1], r1[1]}; OUT = *reinterpret_cast<bf16x8*>(&w); } while (0)
  PK4(p0, 0, pa0); PK4(p0, 8, pa1); PK4(p1, 0, pa2); PK4(p1, 8, pa3);
#undef PK4
}
__device__ __forceinline__ void qkt(f32x16& p0, f32x16& p1, const LAS char* Ks, const bf16x8* qr, int r32, int hi) {
  p0 = f32x16{}; p1 = f32x16{};
#if ATTN_KBATCH
  bf16x8 kb0[6], kb1[6];
#pragma unroll
  for (int d0 = 0; d0 < 6; ++d0) { const int cb = (d0 * 16 + hi * 8) * 2; kb0[d0] = *(const LAS bf16x8*)(Ks + KSWZ(r32, cb)); kb1[d0] = *(const LAS bf16x8*)(Ks + KSWZ(32 + r32, cb)); }
  asm volatile("s_waitcnt lgkmcnt(0)" ::: "memory"); SBAR();
#pragma unroll
  for (int d0 = 0; d0 < 6; ++d0) { p0 = __builtin_amdgcn_mfma_f32_32x32x16_bf16(kb0[d0], qr[d0], p0, 0, 0, 0); p1 = __builtin_amdgcn_mfma_f32_32x32x16_bf16(kb1[d0], qr[d0], p1, 0, 0, 0); }
  SBAR();
#else
#pragma unroll
  for (int d0 = 0; d0 < 6; ++d0) { const int cb = (d0 * 16 + hi * 8) * 2;
    const bf16x8 b0 = *(const LAS bf16x8*)(Ks + KSWZ(r32, cb));
    const bf16x8 b1 = *(const LAS bf16x8*)(Ks + KSWZ(32 + r32, cb));
    p0 = __builtin_amdgcn_mfma_f32_32x32x16_bf16(b0, qr[d0], p0, 0, 0, 0);
    p1 = __builtin_amdgcn_mfma_f32_32x32x16_bf16(b1, qr[d0], p1, 0, 0, 0); }
#endif
}
__device__ __forceinline__ int v_st(int k, int c) { const int kk = (k & ~0xC) | ((k & 4) << 1) | ((k & 8) >> 1); return ((kk >> 3) * 2 + (c >> 5)) * 512 + ((kk & 7) * 32 + (c & 31)) * 2; }
__device__ __forceinline__ int v_rd_base(int lane) { return ((lane & 3) << 3) | (((lane >> 2) & 3) << 6) | (((lane >> 4) & 1) << 5) | (((lane >> 5) & 1) << 8); }
constexpr int v_rd_off(int d0, int ks, int half) { return d0 * 512 + ks * 2048 + half * 1024; }
template <int OFF> __device__ __forceinline__ s16x4 tr_read(int vb) {
  s16x4 r; asm volatile("ds_read_b64_tr_b16 %0, %1 offset:%2" : "=&v"(r) : "v"(vb), "i"(OFF) : "memory"); return r;
}
template <int D0> __device__ __forceinline__ void pv_one(f32x16& od, int vb, bf16x8 pa0, bf16x8 pa1, bf16x8 pa2, bf16x8 pa3) {
  const s16x4 l0 = tr_read<v_rd_off(D0, 0, 0)>(vb), h0 = tr_read<v_rd_off(D0, 0, 1)>(vb), l1 = tr_read<v_rd_off(D0, 1, 0)>(vb), h1 = tr_read<v_rd_off(D0, 1, 1)>(vb);
  const s16x4 l2 = tr_read<v_rd_off(D0, 2, 0)>(vb), h2 = tr_read<v_rd_off(D0, 2, 1)>(vb), l3 = tr_read<v_rd_off(D0, 3, 0)>(vb), h3 = tr_read<v_rd_off(D0, 3, 1)>(vb);
  asm volatile("s_waitcnt lgkmcnt(0)" ::: "memory"); SBAR();
#define PK(L, H) (bf16x8){L[0], L[1], L[2], L[3], H[0], H[1], H[2], H[3]}
  od = __builtin_amdgcn_mfma_f32_32x32x16_bf16(pa0, PK(l0, h0), od, 0, 0, 0);
  od = __builtin_amdgcn_mfma_f32_32x32x16_bf16(pa1, PK(l1, h1), od, 0, 0, 0);
  od = __builtin_amdgcn_mfma_f32_32x32x16_bf16(pa2, PK(l2, h2), od, 0, 0, 0);
  od = __builtin_amdgcn_mfma_f32_32x32x16_bf16(pa3, PK(l3, h3), od, 0, 0, 0);
#undef PK
}
__device__ __forceinline__ void pv_d0(f32x16* o, int vb, bf16x8 pa0, bf16x8 pa1, bf16x8 pa2, bf16x8 pa3) {
  pv_one<0>(o[0], vb, pa0, pa1, pa2, pa3); pv_one<1>(o[1], vb, pa0, pa1, pa2, pa3);
}

__device__ __forceinline__ void istep(f32x16& A0, f32x16& A1, f32x16& C0, f32x16& C1, f32x16* o, float& l_reg, const bf16x8* qr, const LAS char* Ks, const LAS char* KsN, const LAS char* Vs,
                                      bf16x8 (&kn)[6], int r32, int hi) {
  bf16x8 kf[12]; const f32x16 z = {};
  float ps; unsigned a0, a1, b0, b1, c0, c1, e0, e1; bf16x8 pa0, pa1, pa2, pa3;
#define KADDR(B, i) ((B) + KSWZ(((i) & 1) * 32 + r32, (((i) >> 1) * 16 + hi * 8) * 2))
#define LDK(i) kf[i] = *(const LAS bf16x8*)KADDR(Ks, i)
#define EX(P, a) do { P[a] = __builtin_amdgcn_exp2f(P[a]); asm volatile("" :: "v"(P[a])); } while (0)
#define MF(X, Y, Z) __builtin_amdgcn_mfma_f32_32x32x16_bf16(X, Y, Z, 0, 0, 0)
  s16x4 l00, h00, l10, h10, l01, h01, l11, h11, l02, h02, l12, h12, l03, h03, l13, h13;
#define TRB(D0, KS, HF) __builtin_amdgcn_ds_read_tr16_b64_v4i16((LAS s16x4*)(Vs + v_rd_off(D0, KS, HF)))
#define VRD(KS) do { l0##KS = TRB(0, KS, 0); h0##KS = TRB(0, KS, 1); l1##KS = TRB(1, KS, 0); h1##KS = TRB(1, KS, 1); } while (0)
#define SWP(OUT, x0, y0, x1, y1) do { auto r0_ = __builtin_amdgcn_permlane32_swap(x0, y0, false, false); auto r1_ = __builtin_amdgcn_permlane32_swap(x1, y1, false, false); \
    v4u w_ = {r0_[0], r1_[0], r0_[1], r1_[1]}; OUT = *reinterpret_cast<bf16x8*>(&w_); } while (0)
#pragma unroll
  for (int i = 0; i < 6; ++i) kf[i] = kn[i];
  LDK(6);  C0 = MF(kf[0], qr[0], z);   ps = A0[0] + A0[1]; ps += A0[2]; ps += A0[3]; EX(A1, 0); EX(A1, 1); SBAR();
  LDK(7);  C1 = MF(kf[1], qr[0], z);   ps += A0[4]; ps += A0[5]; ps += A0[6]; ps += A0[7]; EX(A1, 2); EX(A1, 3); SBAR();
  LDK(8);  C0 = MF(kf[2], qr[1], C0);  ps += A0[8]; ps += A0[9]; ps += A0[10]; ps += A0[11]; EX(A1, 4); EX(A1, 5); SBAR();
  LDK(9);  C1 = MF(kf[3], qr[1], C1);  ps += A0[12]; ps += A0[13]; ps += A0[14]; ps += A0[15]; EX(A1, 6); EX(A1, 7); SBAR();
  LDK(10); C0 = MF(kf[4], qr[2], C0);  a0 = cvtpk(A0[0], A0[1]); a1 = cvtpk(A0[2], A0[3]); b0 = cvtpk(A0[4], A0[5]); b1 = cvtpk(A0[6], A0[7]); EX(A1, 8); EX(A1, 9); SBAR();
  LDK(11); C1 = MF(kf[5], qr[2], C1);  c0 = cvtpk(A0[8], A0[9]); c1 = cvtpk(A0[10], A0[11]); e0 = cvtpk(A0[12], A0[13]); e1 = cvtpk(A0[14], A0[15]); EX(A1, 10); EX(A1, 11); SBAR();
           C0 = MF(kf[6], qr[3], C0);  SWP(pa0, a0, b0, a1, b1); SWP(pa1, c0, e0, c1, e1); EX(A1, 12); EX(A1, 13); SBAR();
           C1 = MF(kf[7], qr[3], C1);  EX(A1, 14); EX(A1, 15); a0 = cvtpk(A1[0], A1[1]); a1 = cvtpk(A1[2], A1[3]); b0 = cvtpk(A1[4], A1[5]); b1 = cvtpk(A1[6], A1[7]); SBAR();
  VRD(0);  C0 = MF(kf[8], qr[4], C0);  c0 = cvtpk(A1[8], A1[9]); c1 = cvtpk(A1[10], A1[11]); e0 = cvtpk(A1[12], A1[13]); e1 = cvtpk(A1[14], A1[15]); SWP(pa2, a0, b0, a1, b1); SBAR();
  VRD(1);  C1 = MF(kf[9], qr[4], C1);  SWP(pa3, c0, e0, c1, e1); ps += A1[0]; ps += A1[1]; ps += A1[2]; ps += A1[3]; SBAR();
  VRD(2);  C0 = MF(kf[10], qr[5], C0); ps += A1[4]; ps += A1[5]; ps += A1[6]; ps += A1[7]; ps += A1[8]; ps += A1[9]; SBAR();
  VRD(3);  C1 = MF(kf[11], qr[5], C1); ps += A1[10]; ps += A1[11]; ps += A1[12]; ps += A1[13]; ps += A1[14]; ps += A1[15]; SBAR();
#define PK(L, H) (bf16x8){L[0], L[1], L[2], L[3], H[0], H[1], H[2], H[3]}
  kn[0] = *(const LAS bf16x8*)KADDR(KsN, 0);
  o[0] = MF(pa0, PK(l00, h00), o[0]); EX(C0, 0);  EX(C0, 1);  SBAR();
  kn[1] = *(const LAS bf16x8*)KADDR(KsN, 1);
  o[1] = MF(pa0, PK(l10, h10), o[1]); EX(C0, 2);  EX(C0, 3);  SBAR();
  kn[2] = *(const LAS bf16x8*)KADDR(KsN, 2);
  o[0] = MF(pa1, PK(l01, h01), o[0]); EX(C0, 4);  EX(C0, 5);  SBAR();
  kn[3] = *(const LAS bf16x8*)KADDR(KsN, 3);
  o[1] = MF(pa1, PK(l11, h11), o[1]); EX(C0, 6);  EX(C0, 7);  SBAR();
  kn[4] = *(const LAS bf16x8*)KADDR(KsN, 4);
  o[0] = MF(pa2, PK(l02, h02), o[0]); EX(C0, 8);  EX(C0, 9);  SBAR();
  kn[5] = *(const LAS bf16x8*)KADDR(KsN, 5);
  o[1] = MF(pa2, PK(l12, h12), o[1]); EX(C0, 10); EX(C0, 11); SBAR();
  o[0] = MF(pa3, PK(l03, h03), o[0]); EX(C0, 12); EX(C0, 13); SBAR();
  o[1] = MF(pa3, PK(l13, h13), o[1]); EX(C0, 14); EX(C0, 15);
  { auto rr = __builtin_amdgcn_permlane32_swap(__float_as_uint(ps), __float_as_uint(ps), false, false); l_reg += __uint_as_float(rr[0]) + __uint_as_float(rr[1]); }
  SBAR();
#undef PK
#undef KADDR
#undef LDK
#undef EX
#undef MF
#undef SWP
#undef TRB
#undef VRD
}

template <bool FAST> __device__ __forceinline__ void attn_unit_t(const bf16* __restrict__ KV, const bf16* __restrict__ KR, bf16* __restrict__ O,
                                          long t0, long kb0, int h, LAS char* lds, const bf16x8 (&qr)[6]) {
  const int tid = otid(), wid = tid >> 6, lane = tid & 63, r32 = lane & 31, hi = lane >> 5;
  LAS char* V_lds = lds; LAS char* K_lds = lds + 2 * SHM_V;
  LAS float* ws = (LAS float*)(lds + 2 * SHM_V + 2 * SHM_K) + wid * 64; LAS float* li_l = ws; LAS float* al_l = ws + 32;
  float m_reg = -1e30f, l_reg = 0; f32x16 o[2] = {};
  const int sr = tid >> 4, kc = tid & 15; const bool kact = kc < 12, krope = kc >= 8;
  const bf16* kptr = krope ? (KR + (kb0 + sr) * LDKR + (kc - 8) * 8) : (KV + (kb0 + sr) * LDKV + h * 128 + kc * 8);
  const long kstr = krope ? LDKR : LDKV;
  const int vr = tid >> 3, vc = (tid & 7) * 8;
  const bf16* vptr = KV + (kb0 + vr) * LDKV + h * 128 + 64 + vc;
  const int vst = v_st(vr, vc), kst0 = KSWZ(sr, kc * 16), kst1 = KSWZ(32 + sr, kc * 16);
  const int vb0 = (int)(uintptr_t)V_lds + v_rd_base(lane);
  struct { bf16x8 vs, ks0, ks1; } sr_[2];
#define SLOAD(i, k0) do { sr_[i].vs = *reinterpret_cast<const bf16x8*>(vptr + (long)(k0) * LDKV); \
    if (kact) { sr_[i].ks0 = *reinterpret_cast<const bf16x8*>(kptr + (long)(k0) * kstr); sr_[i].ks1 = *reinterpret_cast<const bf16x8*>(kptr + (long)((k0) + 32) * kstr); } } while (0)
#define SWRITE(b, i) do { *(LAS bf16x8*)(V_lds + (b) * SHM_V + vst) = sr_[i].vs; \
    if (kact) { *(LAS bf16x8*)(K_lds + (b) * SHM_K + kst0) = sr_[i].ks0; *(LAS bf16x8*)(K_lds + (b) * SHM_K + kst1) = sr_[i].ks1; } } while (0)
#define SWAIT() asm volatile("s_waitcnt vmcnt(3)" ::: "memory")
#define RESC(a) do { if constexpr (!FAST) { if (__any((a) < 1.f)) { if (hi == 0) al_l[r32] = (a); asm volatile("s_waitcnt lgkmcnt(0)" ::: "memory"); \
    _Pragma("unroll") for (int d = 0; d < 2; ++d) _Pragma("unroll") for (int r = 0; r < 16; ++r) o[d][r] *= al_l[crow(r, hi)]; } } } while (0)
  f32x16 pA0, pA1, pB0, pB1; float mnA, mnB, alA, alB; bf16x8 pa0, pa1, pa2, pa3; constexpr int NT = S / KVBLK;
  SLOAD(0, 0); asm volatile("s_waitcnt vmcnt(0)" ::: "memory"); SWRITE(0, 0); __syncthreads();
  qkt(pA0, pA1, K_lds, qr, r32, hi); partialSM<FAST>(pA0, pA1, m_reg, mnA, alA);
  SLOAD(1, KVBLK); SLOAD(0, 2 * KVBLK);
  SWAIT(); SWRITE(1, 1); __syncthreads();
  for (int j = 1; j + 1 < NT; j += 2) {
    SBAR(); qkt(pB0, pB1, K_lds + SHM_K, qr, r32, hi);
    finishSM<FAST>(pA0, pA1, alA, l_reg, pa0, pa1, pa2, pa3); SBAR();
    SLOAD(1, (j + 2) * KVBLK); SBAR();
    pv_d0(o, vb0, pa0, pa1, pa2, pa3); partialSM<FAST>(pB0, pB1, m_reg, mnB, alB);
    __syncthreads(); SWAIT(); SWRITE(0, 0);
    RESC(alB); __syncthreads();
    SBAR(); qkt(pA0, pA1, K_lds, qr, r32, hi);
    finishSM<FAST>(pB0, pB1, alB, l_reg, pa0, pa1, pa2, pa3); SBAR();
    if (j + 3 < NT) SLOAD(0, (j + 3) * KVBLK); SBAR();
    pv_d0(o, vb0 + SHM_V, pa0, pa1, pa2, pa3); partialSM<FAST>(pA0, pA1, m_reg, mnA, alA);
    __syncthreads(); SWAIT(); SWRITE(1, 1);
    RESC(alA); __syncthreads();
  }
  SBAR(); qkt(pB0, pB1, K_lds + SHM_K, qr, r32, hi);
  finishSM<FAST>(pA0, pA1, alA, l_reg, pa0, pa1, pa2, pa3); SBAR();
  pv_d0(o, vb0, pa0, pa1, pa2, pa3); partialSM<FAST>(pB0, pB1, m_reg, mnB, alB);
  __syncthreads(); RESC(alB);
  finishSM<FAST>(pB0, pB1, alB, l_reg, pa0, pa1, pa2, pa3); SBAR();
  pv_d0(o, vb0 + SHM_V, pa0, pa1, pa2, pa3);
  if (hi == 0) li_l[r32] = l_reg; asm volatile("s_waitcnt lgkmcnt(0)" ::: "memory");
  float rli[16];
#pragma unroll
  for (int r = 0; r < 16; ++r) rli[r] = __builtin_amdgcn_rcpf(li_l[crow(r, hi)]);
  bf16* Ow = O + (t0 + wid * QBLK) * LDO + h * 64;
  { LAS bf16* stg = (LAS bf16*)(lds + 53248) + wid * 2048;
#pragma unroll
    for (int r = 0; r < 16; ++r) { const int orow = crow(r, hi);
#pragma unroll
      for (int d0 = 0; d0 < 2; ++d0) stg[orow * 64 + d0 * 32 + r32] = (bf16)(cvtpk(o[d0][r] * rli[r], 0.f) & 0xffffu); }
    asm volatile("s_waitcnt lgkmcnt(0)" ::: "memory");
#pragma unroll
    for (int i = 0; i < 4; ++i) { const int row = i * 8 + (lane >> 3), ch = lane & 7; const v4u v = *(const LAS v4u*)(stg + row * 64 + ch * 8); *(v4u*)(Ow + (long)row * LDO + ch * 8) = v; } }
#undef SLOAD
#undef SWRITE
#undef SWAIT
#undef RESC
  __syncthreads();
}


template <bool FAST> __device__ __forceinline__ void attn_unit_1b(const bf16* __restrict__ KV, const bf16* __restrict__ KR, bf16* __restrict__ O,
                                          long t0, long kb0, int h, LAS char* lds, const bf16x8 (&qr)[6]) {
  const int tid = otid(), wid = tid >> 6, lane = tid & 63, r32 = lane & 31, hi = lane >> 5;
  constexpr int KOFF = 0, VOFF = 3 * SHM_K, WSOFF = 3 * SHM_K + 3 * SHM_V, STGOFF = WSOFF + NW * 256;
  LAS float* ws = (LAS float*)(lds + WSOFF) + wid * 64; LAS float* li_l = ws; LAS float* al_l = ws + 32;
  float m_reg = -1e30f, l_reg = 0; f32x16 o[2] = {};
  const int sr = tid >> 4, kc = tid & 15; const bool kact = kc < 12, krope = kc >= 8;
  const bf16* kptr = krope ? (KR + (kb0 + sr) * LDKR + (kc - 8) * 8) : (KV + (kb0 + sr) * LDKV + h * 128 + kc * 8);
  const long kstr = krope ? LDKR : LDKV;
  const int vr = tid >> 3, vc = (tid & 7) * 8;
  const bf16* vptr = KV + (kb0 + vr) * LDKV + h * 128 + 64 + vc;
  const int vst = VOFF + v_st(vr, vc), kst0 = KOFF + KSWZ(sr, kc * 16), kst1 = KOFF + KSWZ(32 + sr, kc * 16);
  const int vrb = v_rd_base(lane), vb0 = (int)(uintptr_t)lds + VOFF + vrb;
  bf16x8 svs, sk0, sk1;
#define LOADK(t) do { if (kact) { sk0 = *reinterpret_cast<const bf16x8*>(kptr + (long)((t) * KVBLK) * kstr); sk1 = *reinterpret_cast<const bf16x8*>(kptr + (long)((t) * KVBLK + 32) * kstr); } } while (0)
#define LOADV(t) do { svs = *reinterpret_cast<const bf16x8*>(vptr + (long)((t) * KVBLK) * LDKV); } while (0)
#define WRITEK(slot) do { if (kact) { *(LAS bf16x8*)(lds + (slot) * SHM_K + kst0) = sk0; *(LAS bf16x8*)(lds + (slot) * SHM_K + kst1) = sk1; } } while (0)
#define WRITEV(slot) do { *(LAS bf16x8*)(lds + (slot) * SHM_V + vst) = svs; } while (0)
#define OBAR() asm volatile("s_waitcnt lgkmcnt(0)\n\ts_barrier" ::: "memory")
#define RESC(a) do { if constexpr (!FAST) { if (__any((a) < 1.f)) { if (hi == 0) al_l[r32] = (a); asm volatile("s_waitcnt lgkmcnt(0)" ::: "memory"); \
    _Pragma("unroll") for (int d = 0; d < 2; ++d) _Pragma("unroll") for (int r = 0; r < 16; ++r) o[d][r] *= al_l[crow(r, hi)]; } } } while (0)
  f32x16 pA0, pA1, pB0, pB1; float mnA, mnB, alA, alB; bf16x8 pa0, pa1, pa2, pa3; constexpr int NT = S / KVBLK;
  LOADK(0); LOADV(0); asm volatile("s_waitcnt vmcnt(0)" ::: "memory"); WRITEK(0); WRITEV(0);
  LOADK(1); asm volatile("s_waitcnt vmcnt(0)" ::: "memory"); WRITEK(1);
  LOADK(2); LOADV(1); OBAR();
  int kc_ = 0, kn_ = 1, kw_ = 2, vp_ = 2, vc_ = 0, vw_ = 1;
#define ROT() do { const int a_ = kc_; kc_ = kn_; kn_ = kw_; kw_ = a_; const int b_ = vp_; vp_ = vc_; vc_ = vw_; vw_ = b_; } while (0)
  qkt(pA0, pA1, lds + KOFF + kc_ * SHM_K, qr, r32, hi); partialSM<FAST>(pA0, pA1, m_reg, mnA, alA);
  WRITEK(kw_); WRITEV(vw_); LOADK(3); LOADV(2); OBAR(); ROT();
#if ATTN_ISTEP
  if constexpr (FAST) {
#if ATTN_PRIO
    if (wid >= 4) __builtin_amdgcn_s_setprio(1);
#endif
    bf16x8 kn[6];
#pragma unroll
    for (int i = 0; i < 6; ++i) kn[i] = *(const LAS bf16x8*)(lds + KOFF + kc_ * SHM_K + KSWZ((i & 1) * 32 + r32, ((i >> 1) * 16 + hi * 8) * 2));
#pragma unroll 1
    for (int j = 1; j + 1 < NT; j += 2) {
      if (j + 2 < NT) WRITEK(kw_); WRITEV(vw_);
      if (j + 3 < NT) LOADK(j + 3); if (j + 2 < NT) LOADV(j + 2);
      SBAR(); istep(pA0, pA1, pB0, pB1, o, l_reg, qr, lds + KOFF + kc_ * SHM_K, lds + KOFF + kn_ * SHM_K, lds + VOFF + vp_ * SHM_V + vrb, kn, r32, hi);
      OBAR(); ROT();
      if (j + 3 < NT) WRITEK(kw_); if (j + 2 < NT) WRITEV(vw_);
      if (j + 4 < NT) LOADK(j + 4); if (j + 3 < NT) LOADV(j + 3);
      SBAR(); istep(pB0, pB1, pA0, pA1, o, l_reg, qr, lds + KOFF + kc_ * SHM_K, lds + KOFF + kn_ * SHM_K, lds + VOFF + vp_ * SHM_V + vrb, kn, r32, hi);
      OBAR(); ROT();
    }
#if ATTN_PRIO
    __builtin_amdgcn_s_setprio(0);
#endif
  } else
#endif
#pragma unroll 1
  for (int j = 1; j + 1 < NT; j += 2) {
    SBAR(); qkt(pB0, pB1, lds + KOFF + kc_ * SHM_K, qr, r32, hi);
    finishSM<FAST>(pA0, pA1, alA, l_reg, pa0, pa1, pa2, pa3); SBAR();
    pv_d0(o, vb0 + vp_ * SHM_V, pa0, pa1, pa2, pa3); partialSM<FAST>(pB0, pB1, m_reg, mnB, alB);
    if (j + 2 < NT) WRITEK(kw_); WRITEV(vw_);
    if (j + 3 < NT) LOADK(j + 3); if (j + 2 < NT) LOADV(j + 2);
    RESC(alB); OBAR(); ROT();
    SBAR(); qkt(pA0, pA1, lds + KOFF + kc_ * SHM_K, qr, r32, hi);
    finishSM<FAST>(pB0, pB1, alB, l_reg, pa0, pa1, pa2, pa3); SBAR();
    pv_d0(o, vb0 + vp_ * SHM_V, pa0, pa1, pa2, pa3); partialSM<FAST>(pA0, pA1, m_reg, mnA, alA);
    if (j + 3 < NT) WRITEK(kw_); if (j + 2 < NT) WRITEV(vw_);
    if (j + 4 < NT) LOADK(j + 4); if (j + 3 < NT) LOADV(j + 3);
    RESC(alA); OBAR(); ROT();
  }
  SBAR(); qkt(pB0, pB1, lds + KOFF + kc_ * SHM_K, qr, r32, hi);
  finishSM<FAST>(pA0, pA1, alA, l_reg, pa0, pa1, pa2, pa3); SBAR();
  pv_d0(o, vb0 + vp_ * SHM_V, pa0, pa1, pa2, pa3); partialSM<FAST>(pB0, pB1, m_reg, mnB, alB);
  RESC(alB); ROT();
  finishSM<FAST>(pB0, pB1, alB, l_reg, pa0, pa1, pa2, pa3); SBAR();
  pv_d0(o, vb0 + vp_ * SHM_V, pa0, pa1, pa2, pa3);
  if (hi == 0) li_l[r32] = l_reg; asm volatile("s_waitcnt lgkmcnt(0)" ::: "memory");
  float rli[16];
#pragma unroll
  for (int r = 0; r < 16; ++r) rli[r] = __builtin_amdgcn_rcpf(li_l[crow(r, hi)]);
  bf16* Ow = O + (t0 + wid * QBLK) * LDO + h * 64;
  { LAS bf16* stg = (LAS bf16*)(lds + STGOFF) + wid * 2048;
#pragma unroll
    for (int r = 0; r < 16; ++r) { const int orow = crow(r, hi);
#pragma unroll
      for (int d0 = 0; d0 < 2; ++d0) stg[orow * 64 + d0 * 32 + r32] = (bf16)(cvtpk(o[d0][r] * rli[r], 0.f) & 0xffffu); }
    asm volatile("s_waitcnt lgkmcnt(0)" ::: "memory");
#pragma unroll
    for (int i = 0; i < 4; ++i) { const int row = i * 8 + (lane >> 3), ch = lane & 7; const v4u v = *(const LAS v4u*)(stg + row * 64 + ch * 8); *(v4u*)(Ow + (long)row * LDO + ch * 8) = v; } }
#undef LOADK
#undef LOADV
#undef WRITEK
#undef WRITEV
#undef RESC
#undef ROT
  asm volatile("s_waitcnt vmcnt(0) lgkmcnt(0)\n\ts_barrier" ::: "memory");
#undef OBAR
}

__device__ __forceinline__ void attn_unit(const bf16* __restrict__ Q, const bf16* __restrict__ KV, const bf16* __restrict__ KR, bf16* __restrict__ O,
                                          long t0, long kb0, int h, LAS char* lds, float kmax2) {
  const int tid = otid(), wid = tid >> 6, lane = tid & 63, r32 = lane & 31, hi = lane >> 5;
  bf16x8 qr[6];
  const bf16* Qw = Q + (t0 + wid * QBLK + r32) * LDQ + h * DQK + hi * 8;
#pragma unroll
  for (int d0 = 0; d0 < 6; ++d0) qr[d0] = *reinterpret_cast<const bf16x8*>(Qw + d0 * 16);
  float qn2 = 0.f;
#pragma unroll
  for (int d0 = 0; d0 < 6; ++d0) { const v4u w = *reinterpret_cast<const v4u*>(&qr[d0]); f32x4 a, b; unpack8(w, a, b); qn2 += (a[0] * a[0] + a[1] * a[1]) + (a[2] * a[2] + a[3] * a[3]) + (b[0] * b[0] + b[1] * b[1]) + (b[2] * b[2] + b[3] * b[3]); }
  qn2 += __shfl_xor(qn2, 32);
  const bool fast = ATTN_FASTPATH && __all(qn2 * kmax2 * 1.1f < 100.0f * 100.0f);
#if ATTN_ONEBAR
  if (fast) attn_unit_1b<true>(KV, KR, O, t0, kb0, h, lds, qr); else attn_unit_1b<false>(KV, KR, O, t0, kb0, h, lds, qr);
#else
  if (fast) attn_unit_t<true>(KV, KR, O, t0, kb0, h, lds, qr); else attn_unit_t<false>(KV, KR, O, t0, kb0, h, lds, qr);
#endif
}
#undef KSWZ
#undef SBAR
}

struct Args { const float* in[24]; float* out; unsigned char* ws; int p_lo, p_hi; };
enum { I_X = 0, I_C, I_POS, I_WMOD, I_BMOD, I_N1G, I_WIN, I_BGATE, I_QNG, I_WUQ, I_KVNG, I_WUKV, I_WOA, I_WPOOL, I_PSCALE, I_CONVW, I_WOC, I_WOUT, I_N2G, I_WROUTER, I_WGATE, I_WUP, I_WDOWN, I_FINALG };

__device__ __forceinline__ void conv_item(const float* src, int ldsrc, int c0, bf16* dst, int ldd, int dk0, int nblk, int pm, const float* scale, LAS float* scr, int item, int lane, const float* nscale = nullptr) {
    const int kb = item / nblk, nb = item % nblk, k0 = 64 * kb, n0 = 32 * nb;
    float lv[32];
#pragma unroll
    for (int i = 0; i < 32; ++i) { const int kk = 2 * i + (lane >> 5); lv[i] = src[(size_t)(k0 + kk) * ldsrc + c0 + n0 + (lane & 31)]; }
    const float ns = nscale ? nscale[n0 + (lane & 31)] : 1.0f;
#pragma unroll
    for (int i = 0; i < 32; ++i) { const int kk = 2 * i + (lane >> 5); float v = lv[i] * ns; if (scale) v *= scale[k0 + kk]; scr[kk * 33 + (lane & 31)] = v; }
    LDS_WAIT(); asm volatile("" ::: "memory");
    const bool perm = (pm == 1) || (pm == 2 && (nb % 3) == 2);
    const int c = lane & 7;
#pragma unroll
    for (int j = 0; j < 4; ++j) { const int n = (lane >> 3) + 8 * j; const int q = n >> 3, r = n & 7; const int sn = perm ? ((r < 4) ? 4 * q + r : 16 + 4 * q + (r - 4)) : n;
        const LAS float* s = scr + (8 * c) * 33 + sn;
        v4u o; o.x = pk2(s[0 * 33], s[1 * 33]); o.y = pk2(s[2 * 33], s[3 * 33]); o.z = pk2(s[4 * 33], s[5 * 33]); o.w = pk2(s[6 * 33], s[7 * 33]);
        *(v4u*)(dst + (size_t)(n0 + n) * ldd + dk0 + k0 + 8 * c) = o; }
    LDS_WAIT(); asm volatile("" ::: "memory");
}
#define SEG(src, ldsrc, c0, K, dst, ldd, dk0, rows, pm, scale) do { const int nblk_ = (rows) / 32, nit_ = ((K) / 64) * nblk_; \
    for (int it_ = (gw + NGW - rot) % NGW; it_ < nit_; it_ += NGW) conv_item(src, ldsrc, c0, dst, ldd, dk0, nblk_, pm, scale, scr, it_, lane); rot = (rot + nit_) % NGW; } while (0)

constexpr int MOE_GU_ITEMS = 16 * (NE * 2048 / 32), MOE_DN_ITEMS = 16 * (NE * 1024 / 32), MOE_ITEMS = MOE_GU_ITEMS + MOE_DN_ITEMS;
#ifndef CONV_SLOT_A
#define CONV_SLOT_A 0
#endif
#ifndef CONV_SLOT_C
#define CONV_SLOT_C 0
#endif
#ifndef CONV_SLOT_B
#define CONV_SLOT_B 0
#endif
__device__ __forceinline__ void conv_moe_item(const Args& a, unsigned char* wl, int l, int idx, LAS float* scr, int lane) {
    if (idx < MOE_GU_ITEMS) { const int it = idx, kb = it / (NE * 64), nb = it % (NE * 64), e = nb >> 6, rb = nb & 63, pn = rb >> 3, half = (rb >> 2) & 1, sub = rb & 3;
        const float* src = (half ? a.in[I_WUP] : a.in[I_WGATE]) + ((size_t)l * NE + e) * D * FF;
        conv_item(src, FF, 128 * pn + 32 * sub, (bf16*)(wl + WO_GU) + ((size_t)e * 2048 + rb * 32) * D, D, 0, 1, 0, nullptr, scr, kb, lane); }
    else { const int it = idx - MOE_GU_ITEMS, kb = it / (NE * 32), nb = it % (NE * 32), e = nb >> 5, rb = nb & 31;
        conv_item(a.in[I_WDOWN] + ((size_t)l * NE + e) * FF * D, D, 32 * rb, (bf16*)(wl + WO_DN) + ((size_t)e * 1024 + rb * 32) * FF, FF, 0, 1, 0, nullptr, scr, kb, lane); }
}
struct ConvDesc { const float* src; bf16* dst; int ldsrc, ldd; };
__device__ __forceinline__ ConvDesc moe_desc(const Args& a, unsigned char* wl, int l, int idx) {
    ConvDesc d;
    if (idx < MOE_GU_ITEMS) { const int it = idx, kb = it / (NE * 64), nb = it % (NE * 64), e = nb >> 6, rb = nb & 63, pn = rb >> 3, half = (rb >> 2) & 1, sub = rb & 3;
        d.src = (half ? a.in[I_WUP] : a.in[I_WGATE]) + ((size_t)l * NE + e) * D * FF + (size_t)(64 * kb) * FF + 128 * pn + 32 * sub; d.ldsrc = FF;
        d.dst = (bf16*)(wl + WO_GU) + ((size_t)e * 2048 + rb * 32) * D + 64 * kb; d.ldd = D; }
    else { const int it = idx - MOE_GU_ITEMS, kb = it / (NE * 32), nb = it % (NE * 32), e = nb >> 5, rb = nb & 31;
        d.src = a.in[I_WDOWN] + ((size_t)l * NE + e) * FF * D + (size_t)(64 * kb) * D + 32 * rb; d.ldsrc = D;
        d.dst = (bf16*)(wl + WO_DN) + ((size_t)e * 1024 + rb * 32) * FF + 64 * kb; d.ldd = FF; }
    return d;
}
__device__ __forceinline__ void conv_load(const ConvDesc& d, float (&lv)[32], int lane) {
#pragma unroll
    for (int i = 0; i < 32; ++i) { const int kk = 2 * i + (lane >> 5); lv[i] = __builtin_nontemporal_load(d.src + (size_t)kk * d.ldsrc + (lane & 31)); }
}
__device__ __forceinline__ void conv_fin(const ConvDesc& d, const float (&lv)[32], LAS float* scr, int lane) {
#pragma unroll
    for (int i = 0; i < 32; ++i) { const int kk = 2 * i + (lane >> 5); scr[kk * 33 + (lane & 31)] = lv[i]; }
    LDS_WAIT(); asm volatile("" ::: "memory");
    const int c = lane & 7;
#pragma unroll
    for (int j = 0; j < 4; ++j) { const int n = (lane >> 3) + 8 * j; const LAS float* s = scr + (8 * c) * 33 + n;
        v4u o; o.x = pk2(s[0 * 33], s[1 * 33]); o.y = pk2(s[2 * 33], s[3 * 33]); o.z = pk2(s[4 * 33], s[5 * 33]); o.w = pk2(s[6 * 33], s[7 * 33]);
        __builtin_nontemporal_store(o, (v4u*)(d.dst + (size_t)n * d.ldd + 8 * c)); }
    LDS_WAIT(); asm volatile("" ::: "memory");
}
__device__ __forceinline__ void conv_moe_range(const Args& a, LAS unsigned char* lds, int l, int first, int count, int wg, int nwg) {
    const int tid = otid(), lane = tid & 63, wave = tid >> 6;
    LAS float* scr = (LAS float*)(lds + wave * 16384);
    unsigned char* ws = opaque(a.ws); unsigned char* wl = ws + WS_W + (size_t)l * WL_BYTES;
    const int stride = nwg * NWAVES; int i = wg * NWAVES + wave;
    if (i >= count) return;
    ConvDesc dc = moe_desc(a, wl, l, first + i); float lc[32]; conv_load(dc, lc, lane);
#pragma unroll 1
    for (;;) { const int in = i + stride; const bool more = in < count;
        ConvDesc dn = dc; float ln[32];
#pragma unroll
        for (int k = 0; k < 32; ++k) ln[k] = 0.f;
        if (more) { dn = moe_desc(a, wl, l, first + in); conv_load(dn, ln, lane); }
        conv_fin(dc, lc, scr, lane);
        if (!more) break;
        dc = dn; i = in;
#pragma unroll
        for (int k = 0; k < 32; ++k) lc[k] = ln[k]; }
}

constexpr int NONMOE_ITEMS = 192 + 16 + 128 + 2560 + 144 + 128 + 256 + 64 + 256 + 512;
__device__ __forceinline__ void nonmoe_item(const Args& a, unsigned char* ws, int l, int idx, LAS float* scr, int lane) {
    unsigned char* wl = ws + WS_W + (size_t)l * WL_BYTES;
    const float* win = a.in[I_WIN] + (size_t)l * D * NIN_SRC; bf16* WIN = (bf16*)(wl + WO_IN);
    const float* src; int ldsrc, c0, ldd, dk0 = 0, nblk, pm = 0, item; bf16* dst; const float* scale = nullptr; const float* nsc = nullptr;
    if (idx < 192)       { src = win; ldsrc = NIN_SRC; c0 = 0;   dst = WIN; ldd = D; nblk = 12; item = idx; }
    else if (idx < 208)  { src = win; ldsrc = NIN_SRC; c0 = 640; dst = WIN + (size_t)384 * D; ldd = D; nblk = 1; pm = 1; item = idx - 192; }
    else if (idx < 336)  { src = win; ldsrc = NIN_SRC; c0 = 384; dst = WIN + (size_t)512 * D; ldd = D; nblk = 8; item = idx - 208; }
    else if (idx < 2896) { src = win; ldsrc = NIN_SRC; c0 = 672; dst = WIN + (size_t)768 * D; ldd = D; nblk = 160; item = idx - 336; }
    else if (idx < 3040) { src = a.in[I_WUQ] + (size_t)l * QR * 768; ldsrc = 768; c0 = 0; dst = (bf16*)(wl + WO_UQ); ldd = QR; nblk = 24; pm = 2; scale = a.in[I_QNG] + l * QR; item = idx - 2896; }
    else if (idx < 3168) { src = a.in[I_WUKV] + (size_t)l * KVR * 1024; ldsrc = 1024; c0 = 0; dst = (bf16*)(wl + WO_UKV); ldd = KVR; nblk = 32; scale = a.in[I_KVNG] + l * KVR; item = idx - 3040; }
    else if (idx < 3424) { src = a.in[I_WOA] + (size_t)l * 512 * D; ldsrc = D; c0 = 0; dst = (bf16*)(wl + WO_OA); ldd = 512; nblk = 32; item = idx - 3168; }
    else if (idx < 3488) { const int g = (idx - 3424) >> 4; src = a.in[I_WPOOL] + ((size_t)l * 4 + g) * 128 * 256; ldsrc = 256; c0 = 0; dst = (bf16*)(wl + WO_POOL) + (size_t)(g * 256) * 512; ldd = 512; dk0 = g * 128; nblk = 8;
                           nsc = MERGE_FUSED ? a.in[I_PSCALE] + (size_t)l * D + g * 256 : (const float*)nullptr; item = (idx - 3424) & 15; }
    else if (idx < 3744) { src = a.in[I_WOC] + (size_t)l * 512 * D; ldsrc = D; c0 = 0; dst = (bf16*)(wl + WO_OC); ldd = 512; nblk = 32; item = idx - 3488; }
    else                 { src = a.in[I_WOUT] + (size_t)l * D * D; ldsrc = D; c0 = 0; dst = (bf16*)(wl + WO_OUT); ldd = D; nblk = 32; item = idx - 3744; }
    conv_item(src, ldsrc, c0, dst, ldd, dk0, nblk, pm, scale, scr, item, lane, nsc);
}
constexpr int NQ = 7, CW_Q = 8192;
#ifndef CONV_CLAIM
#define CONV_CLAIM 16
#endif
__device__ __forceinline__ int q_count(int q, int G) { return (q & 1) ? NONMOE_ITEMS : MOE_ITEMS - ((G == 256) ? CONV_SLOT_A + CONV_SLOT_C + CONV_SLOT_B : 0); }
__device__ __forceinline__ bool conv_steal(const Args& a, LAS unsigned char* lds, volatile LAS unsigned* mw, int& qcur, int qmax, int G) {
    const int tid = otid(), lane = tid & 63, wave = __builtin_amdgcn_readfirstlane(tid >> 6);
    unsigned char* ws = opaque(a.ws); unsigned* ctl = (unsigned*)(ws + WS_CTL);
    while (qcur < qmax) {
        const int cnt = q_count(qcur, G); const bool moe = (qcur & 1) == 0;
        if (threadIdx.x == 0) mw[3] = __hip_atomic_fetch_add(ctl + CW_Q + 64 * qcur, moe ? (unsigned)CONV_CLAIM : 8u, __ATOMIC_RELAXED, __HIP_MEMORY_SCOPE_AGENT);
        __syncthreads();
        const unsigned base = mw[3];
        __syncthreads();
        if (base < (unsigned)cnt) { LAS float* scr = (LAS float*)(lds + wave * 16384);
            if (moe) { const int l = qcur >> 1, first = MOE_ITEMS - cnt, i0 = (int)base + wave, i1 = i0 + 8, i2 = i0 + 16; unsigned char* wl = ws + WS_W + (size_t)l * WL_BYTES;
                if (i0 < cnt) { const ConvDesc d0 = moe_desc(a, wl, l, first + i0); float b0[32]; conv_load(d0, b0, lane);
                    if (i1 < cnt) { const ConvDesc d1 = moe_desc(a, wl, l, first + i1); float b1[32]; conv_load(d1, b1, lane);
                        if (CONV_CLAIM >= 24 && i2 < cnt) { const ConvDesc d2 = moe_desc(a, wl, l, first + i2); float b2[32]; conv_load(d2, b2, lane); conv_fin(d0, b0, scr, lane); conv_fin(d1, b1, scr, lane); conv_fin(d2, b2, scr, lane); }
                        else { conv_fin(d0, b0, scr, lane); conv_fin(d1, b1, scr, lane); } }
                    else conv_fin(d0, b0, scr, lane); } }
            else { const int idx = (int)base + wave; if (idx < cnt) nonmoe_item(a, ws, (qcur + 1) >> 1, idx, scr, lane); }
            return true; }
        ++qcur;
    }
    return false;
}
__device__ __forceinline__ void conv_drain(const Args& a, LAS unsigned char* lds, volatile LAS unsigned* mw, int& qcur, int qmax, int G) { while (conv_steal(a, lds, mw, qcur, qmax, G)) { } __syncthreads(); }

__device__ __forceinline__ void phase_prologue(const Args& a, LAS unsigned char* lds, int vcu, int G) {
    const int tid = otid(), lane = tid & 63, wave = tid >> 6;
    LAS float* scr = (LAS float*)(lds + wave * 16384);
    const int gw = vcu * NWAVES + wave, NGW = G * NWAVES; int rot = 0;
    unsigned char* ws = opaque(a.ws);
    for (int it = gw; it < NONMOE_ITEMS; it += NGW) nonmoe_item(a, ws, 0, it, scr, lane);
    const size_t gt = (size_t)vcu * 512 + tid, ngt = (size_t)G * 512;
    for (size_t i = gt; i < (size_t)NL * 96 * 128; i += ngt) { const int l = (int)(i / (96 * 128)), r = (int)(i % (96 * 128));
        *(v4u*)(ws + WS_W + (size_t)l * WL_BYTES + WO_IN + ((size_t)(416 + r / 128) * D + (r % 128) * 8) * 2) = (v4u){0u, 0u, 0u, 0u}; }
    for (size_t i = gt; i < (size_t)NL * 1024 * 64; i += ngt) { const int l = (int)(i / (1024 * 64)), r = (int)(i % (1024 * 64)), n = r >> 6, ch = r & 63;
        if ((ch >> 4) != (n >> 8)) *(v4u*)(ws + WS_W + (size_t)l * WL_BYTES + WO_POOL + ((size_t)n * 512 + ch * 8) * 2) = (v4u){0u, 0u, 0u, 0u}; }
    { float* COS = (float*)(ws + WS_COS); float* SIN = (float*)(ws + WS_SIN); const int* pos = (const int*)a.in[I_POS];
      for (size_t i = gt; i < (size_t)T * 16; i += ngt) { const int t = (int)(i >> 4), j = (int)(i & 15);
          const float freq = (float)pow(10000.0, -(double)(2 * j) / 32.0); const float ang = (float)pos[t] * freq;
          COS[i] = (float)cos((double)ang); SIN[i] = (float)sin((double)ang); } }
    __syncthreads();
    { LAS float* cact = (LAS float*)lds;
      LAS float* red = (LAS float*)(lds + 16384);
      for (int i = tid; i < NB * D; i += 512) { const float c = a.in[I_C][i]; cact[i] = c / (1.0f + __expf(-c)); }
      __syncthreads();
      for (int cb = blockIdx.x; cb < 256; cb += G) { const int l = cb >> 6, n0 = (cb & 63) * 96;
          const float* wm = a.in[I_WMOD] + (size_t)l * D * 6144 + n0;
          float acc0[4] = {0.f, 0.f, 0.f, 0.f}, acc1[4] = {0.f, 0.f, 0.f, 0.f};
          for (int k0 = wave * 128; k0 < wave * 128 + 128; k0 += 8) { float w0[8], w1[8];
#pragma unroll
              for (int kk = 0; kk < 8; ++kk) { w0[kk] = wm[(size_t)(k0 + kk) * 6144 + lane]; w1[kk] = lane < 32 ? wm[(size_t)(k0 + kk) * 6144 + 64 + lane] : 0.f; }
#pragma unroll
              for (int kk = 0; kk < 8; ++kk)
#pragma unroll
                  for (int b = 0; b < 4; ++b) { const float c = cact[b * D + k0 + kk]; acc0[b] += c * w0[kk]; acc1[b] += c * w1[kk]; } }
#pragma unroll
          for (int b = 0; b < 4; ++b) { red[(wave * 4 + b) * 96 + lane] = acc0[b]; if (lane < 32) red[(wave * 4 + b) * 96 + 64 + lane] = acc1[b]; }
          __syncthreads();
          if (tid < 384) { const int b = tid / 96, n = tid % 96; float s = a.in[I_BMOD][l * 6144 + n0 + n];
#pragma unroll
              for (int w = 0; w < 8; ++w) s += red[(w * 4 + b) * 96 + n];
              ((float*)(ws + WS_MOD))[((size_t)l * NB + b) * 6144 + n0 + n] = s; }
          __syncthreads(); } }
}
#undef SEG

__device__ __forceinline__ void phase_norm1(const Args& a, int l, int vcu, int G) {
    const int tid = otid(), lane = tid & 63, wave = tid >> 6;
    unsigned char* ws = opaque(a.ws);
    float* X = (float*)(ws + WS_X); bf16* H = (bf16*)(ws + WS_H); const bf16* Y = (const bf16*)(ws + WS_Y); const int* SLOT = (const int*)(ws + WS_SLOT); const float* AFF = (const float*)(ws + WS_AFF);
    const float* MOD = (const float*)(ws + WS_MOD);
    if (l < NL && blockIdx.x == 0 && tid < 128) __hip_atomic_store((unsigned*)(ws + WS_KMAX) + tid, 0u, __ATOMIC_RELAXED, __HIP_MEMORY_SCOPE_AGENT);
    const float* xsrc = (l == 0 ? a.in[I_X] : X);
    const int rpw = (T + G * NWAVES - 1) / (G * NWAVES);
    int t = (vcu * NWAVES + wave) * rpw; const int tend = min(t + rpw, T);
    f32x4 vn[4]; int svn = -1; float tvn = 0.f;
    f32x4 g2v[4], gg[4], s1v[4], h1v[4]; int bcur = -1;
    { const float* g = (l < NL) ? a.in[I_N1G] + l * D : a.in[I_FINALG];
#pragma unroll
      for (int j = 0; j < 4; ++j) gg[j] = ((const f32x4*)g)[lane + 64 * j]; }
    if (t < tend) {
#pragma unroll
        for (int j = 0; j < 4; ++j) vn[j] = ((const f32x4*)(xsrc + (size_t)t * D))[lane + 64 * j];
        if (l > 0 && lane < NE) { svn = SLOT[((t / S) * NE + lane) * S + t % S]; tvn = AFF[((t / S) * NE + lane) * S + t % S]; } }
    for (; t < tend; ++t) {
        const int b = t / S;
        f32x4 v[4]; const int sv = svn; const float tv = tvn;
#pragma unroll
        for (int j = 0; j < 4; ++j) v[j] = vn[j];
        unsigned long long mask = (l > 0) ? __ballot(sv >= 0) : 0ull;
        const bool any = mask != 0; bool two = false; v2u w0[4], w1[4]; float tv0 = 0.f, tv1 = 0.f;
        if (any) { const int e0 = __builtin_ctzll(mask); mask &= mask - 1; two = mask != 0; const int e1 = two ? __builtin_ctzll(mask) : e0; if (two) mask &= mask - 1;
            const int s0 = __shfl(sv, e0), s1 = __shfl(sv, e1); tv0 = __shfl(tv, e0); tv1 = __shfl(tv, e1);
            const bf16* y0 = Y + ((size_t)((b * NE + e0) * CAP + s0)) * D; const bf16* y1 = Y + ((size_t)((b * NE + e1) * CAP + s1)) * D;
#pragma unroll
            for (int j = 0; j < 4; ++j) { w0[j] = ((const v2u*)y0)[lane + 64 * j]; w1[j] = ((const v2u*)y1)[lane + 64 * j]; } }
        if (b != bcur) { bcur = b; const float* g2 = MOD + ((size_t)(l > 0 ? l - 1 : 0) * NB + b) * 6144 + 5 * D;
          const float* sh = MOD + ((size_t)(l < NL ? l : 0) * NB + b) * 6144; const float* sc = sh + D;
#pragma unroll
          for (int j = 0; j < 4; ++j) { g2v[j] = ((const f32x4*)g2)[lane + 64 * j]; s1v[j] = ((const f32x4*)sc)[lane + 64 * j] + 1.0f; h1v[j] = ((const f32x4*)sh)[lane + 64 * j]; } }
        asm volatile("" ::: "memory");
        if (t + 1 < tend) { const int tn = t + 1;
#pragma unroll
            for (int j = 0; j < 4; ++j) vn[j] = ((const f32x4*)(xsrc + (size_t)tn * D))[lane + 64 * j];
            if (l > 0 && lane < NE) { svn = SLOT[((tn / S) * NE + lane) * S + tn % S]; tvn = AFF[((tn / S) * NE + lane) * S + tn % S]; } }
        asm volatile("" ::: "memory");
        if (l > 0) {
            f32x4 acc[4];
#pragma unroll
            for (int j = 0; j < 4; ++j) acc[j] = (f32x4){0.f, 0.f, 0.f, 0.f};
            if (any) {
#pragma unroll
                for (int j = 0; j < 4; ++j) { acc[j] += (f32x4){bflo(w0[j].x), bfhi(w0[j].x), bflo(w0[j].y), bfhi(w0[j].y)} * tv0;
                    if (two) acc[j] += (f32x4){bflo(w1[j].x), bfhi(w1[j].x), bflo(w1[j].y), bfhi(w1[j].y)} * tv1; } }
            while (mask) {
                const int e0 = __builtin_ctzll(mask); mask &= mask - 1; const int s0 = __shfl(sv, e0); const float tve = __shfl(tv, e0);
                const bf16* y0 = Y + ((size_t)((b * NE + e0) * CAP + s0)) * D;
#pragma unroll
                for (int j = 0; j < 4; ++j) { const v2u w = ((const v2u*)y0)[lane + 64 * j]; acc[j] += (f32x4){bflo(w.x), bfhi(w.x), bflo(w.y), bfhi(w.y)} * tve; } }
#pragma unroll
            for (int j = 0; j < 4; ++j) v[j] += g2v[j] * acc[j];
            if (l < NL) {
#pragma unroll
                for (int j = 0; j < 4; ++j) ((f32x4*)(X + (size_t)t * D))[lane + 64 * j] = v[j]; }
        }
        float ssq = 0.f;
#pragma unroll
        for (int j = 0; j < 4; ++j) ssq += (v[j][0] * v[j][0] + v[j][1] * v[j][1]) + (v[j][2] * v[j][2] + v[j][3] * v[j][3]);
        const float rstd = 1.0f / sqrtf(wave_sum(ssq) * (1.0f / D) + EPS);
        if (l < NL) {
#pragma unroll
            for (int j = 0; j < 4; ++j) { const f32x4 o = v[j] * rstd * gg[j] * s1v[j] + h1v[j];
                ((v2u*)(H + (size_t)t * D))[lane + 64 * j] = (v2u){pk2(o[0], o[1]), pk2(o[2], o[3])}; }
        } else {
#pragma unroll
            for (int j = 0; j < 4; ++j) ((f32x4*)(a.out + (size_t)t * D))[lane + 64 * j] = v[j] * rstd * gg[j];
        }
    }
}

__device__ __forceinline__ void st8(bf16* p, const f32x4& x0, const f32x4& x1) { *(v4u*)p = pack8(x0, x1); }
__device__ __forceinline__ float ssq8(const f32x4& x0, const f32x4& x1) { return (x0[0] * x0[0] + x0[1] * x0[1]) + (x0[2] * x0[2] + x0[3] * x0[3]) + (x1[0] * x1[0] + x1[1] * x1[1]) + (x1[2] * x1[2] + x1[3] * x1[3]); }
__device__ __forceinline__ void row_part(float* p, float s) { s += __shfl_xor(s, 16); s += __shfl_xor(s, 32); if ((otid() & 63) < 16) *p = s; }
__device__ __forceinline__ void row_max_atomic(unsigned* p, float s) { if (!KMAX_ATOMICS) return; s += __shfl_xor(s, 16); s += __shfl_xor(s, 32); s = fmaxf(s, __shfl_xor(s, 1)); s = fmaxf(s, __shfl_xor(s, 2)); s = fmaxf(s, __shfl_xor(s, 4)); s = fmaxf(s, __shfl_xor(s, 8));
    if (KMAX_ATOMICS && (otid() & 63) == 0) atomicMax(p, __float_as_uint(s)); }
__device__ __forceinline__ void rope8(f32x4& x1, f32x4& x2, const float* cs, const float* sn, int qi) {
    const f32x4 c = *(const f32x4*)(cs + 4 * qi), s = *(const f32x4*)(sn + 4 * qi);
    const f32x4 o1 = x1 * c - x2 * s, o2 = x1 * s + x2 * c; x1 = o1; x2 = o2;
}
struct KCarry { float a = 0.f, b = 0.f; };
struct FProj { static constexpr bool IDEMPOTENT = true;
    bf16 *CQ, *CKV, *KR, *U, *CV, *GT; float* PART; const float *COS, *SIN; const LAS float* bgate; unsigned* KMAX;
    typedef KCarry Carry;
    struct L { f32x4 x0, x1, x2, x3; };
    __device__ __forceinline__ L pre(const pg8::Unit& u, int row, int col) const { L r; const f32x4 z = {0.f, 0.f, 0.f, 0.f}; r.x0 = z; r.x1 = z; r.x2 = z; r.x3 = z;
        if (u.pn >= 11) { const int c = col - 2816; r.x0 = *(const LAS f32x4*)(bgate + c); r.x1 = *(const LAS f32x4*)(bgate + c + 4); r.x2 = *(const LAS f32x4*)(bgate + c + 128); r.x3 = *(const LAS f32x4*)(bgate + c + 132); }
        else if (u.pn == 1 && col + 128 < 416) { const int qi = (col + 128 - 384) >> 3; r.x0 = *(const f32x4*)(COS + (size_t)row * 16 + 4 * qi); r.x1 = *(const f32x4*)(SIN + (size_t)row * 16 + 4 * qi); }
        return r; }
    __device__ __forceinline__ void post(const pg8::Unit& u, int row, int col, const L& ld, const f32x4& a0, const f32x4& a1, const f32x4& b0, const f32x4& b1, Carry& cy) const {
        const int pn = u.pn;
        if (pn >= 11) { const int c = col - 2816;
            f32x4 x0, x1, y0, y1;
#pragma unroll
            for (int i = 0; i < 4; ++i) { x0[i] = sigmoidf_(a0[i] + ld.x0[i]); x1[i] = sigmoidf_(a1[i] + ld.x1[i]); y0[i] = sigmoidf_(b0[i] + ld.x2[i]); y1[i] = sigmoidf_(b1[i] + ld.x3[i]); }
            st8(GT + (size_t)row * 3072 + c, x0, x1); st8(GT + (size_t)row * 3072 + c + 128, y0, y1);
        } else if (pn >= 5) { st8(CV + (size_t)row * 1536 + (col - 1280), a0, a1); st8(CV + (size_t)row * 1536 + (col - 1280) + 128, b0, b1);
        } else if (pn >= 3) { st8(U + (size_t)row * 512 + (col - 768), a0, a1); st8(U + (size_t)row * 512 + (col - 768) + 128, b0, b1);
        } else if (pn == 2) { st8(CKV + (size_t)row * KVR + (col - 512), a0, a1); st8(CKV + (size_t)row * KVR + (col - 512) + 128, b0, b1);
            row_part(PART + (size_t)row * 16 + 8 + ((col >> 5) & 3), ssq8(a0, a1) + ssq8(b0, b1));
        } else if (pn == 0) { st8(CQ + (size_t)row * QR + col, a0, a1); st8(CQ + (size_t)row * QR + col + 128, b0, b1);
            row_part(PART + (size_t)row * 16 + ((col >> 5) & 3), ssq8(a0, a1) + ssq8(b0, b1));
        } else { st8(CQ + (size_t)row * QR + col, a0, a1); row_part(PART + (size_t)row * 16 + 4 + ((col >> 5) & 3), ssq8(a0, a1));
            const int cb = col + 128;
            if (cb < 416) { const f32x4 o1 = b0 * ld.x0 - b1 * ld.x1, o2 = b0 * ld.x1 + b1 * ld.x0; st8(KR + (size_t)row * 32 + (cb - 384), o1, o2);
                float q = ssq8(b0, b1); q += __shfl_xor(q, 16); q += __shfl_xor(q, 32); cy.a = fmaxf(cy.a, q); }
        }
    }
    __device__ __forceinline__ void finish(const pg8::Unit& u, int wr, int wc, const Carry& cy) const {
        if (u.pn == 1 && wc == 0) { float q = cy.a; q = fmaxf(q, __shfl_xor(q, 1)); q = fmaxf(q, __shfl_xor(q, 2)); q = fmaxf(q, __shfl_xor(q, 4)); q = fmaxf(q, __shfl_xor(q, 8));
            if ((otid() & 63) == 0) ((float*)KMAX)[(((u.pm >> 4) * (NH * 2 + 1)) + NH * 2) * 32 + (u.pm & 15) * 2 + wr] = q; } }
};
struct FQ { static constexpr bool IDEMPOTENT = true;
    bf16* Q; const float *PART, *COS, *SIN;
    typedef NoCarry Carry;
    struct L { f32x4 p0, p1, c, s; };
    __device__ __forceinline__ L pre(const pg8::Unit& u, int row, int col) const { L r; r.p0 = *(const f32x4*)(PART + (size_t)row * 16); r.p1 = *(const f32x4*)(PART + (size_t)row * 16 + 4);
        const int qi = (col & 31) >> 3; r.c = *(const f32x4*)(COS + (size_t)row * 16 + 4 * qi); r.s = *(const f32x4*)(SIN + (size_t)row * 16 + 4 * qi); return r; }
    __device__ __forceinline__ void post(const pg8::Unit& u, int row, int col, const L& ld, const f32x4& a0, const f32x4& a1, const f32x4& b0, const f32x4& b1, Carry& cy) const {
        const float rstd = 1.0f / sqrtf((((ld.p0[0] + ld.p0[1]) + (ld.p0[2] + ld.p0[3])) + ((ld.p1[0] + ld.p1[1]) + (ld.p1[2] + ld.p1[3]))) * (1.0f / QR) + EPS);
        const float rq = rstd * QSCALE;
        f32x4 x0 = a0 * rq, x1 = a1 * rq, y0 = b0 * rq, y1 = b1 * rq;
        const int ga = col >> 5, gb = ga + 4;
        if (ga % 3 == 2) { const f32x4 o1 = x0 * ld.c - x1 * ld.s, o2 = x0 * ld.s + x1 * ld.c; x0 = o1; x1 = o2; }
        if (gb % 3 == 2) { const f32x4 o1 = y0 * ld.c - y1 * ld.s, o2 = y0 * ld.s + y1 * ld.c; y0 = o1; y1 = o2; }
        st8(Q + (size_t)row * 768 + col, x0, x1); st8(Q + (size_t)row * 768 + col + 128, y0, y1);
    }
    __device__ __forceinline__ void finish(const pg8::Unit&, int, int, const Carry&) const {}
};
struct FKV { static constexpr bool IDEMPOTENT = true;
    bf16* KV; const float* PART; unsigned* KMAX;
    typedef KCarry Carry;
    struct L { f32x4 p0; };
    __device__ __forceinline__ L pre(const pg8::Unit& u, int row, int col) const { L r; r.p0 = *(const f32x4*)(PART + (size_t)row * 16 + 8); return r; }
    __device__ __forceinline__ void post(const pg8::Unit& u, int row, int col, const L& ld, const f32x4& a0, const f32x4& a1, const f32x4& b0, const f32x4& b1, Carry& cy) const {
        const float rstd = 1.0f / sqrtf(((ld.p0[0] + ld.p0[1]) + (ld.p0[2] + ld.p0[3])) * (1.0f / KVR) + EPS);
        st8(KV + (size_t)row * 1024 + col, a0 * rstd, a1 * rstd); st8(KV + (size_t)row * 1024 + col + 128, b0 * rstd, b1 * rstd);
        const int wc = (col >> 5) & 7;
        if (wc < 2) { float qa = ssq8(a0, a1) * rstd * rstd, qb = ssq8(b0, b1) * rstd * rstd; qa += __shfl_xor(qa, 16); qa += __shfl_xor(qa, 32); qb += __shfl_xor(qb, 16); qb += __shfl_xor(qb, 32);
            cy.a = fmaxf(cy.a, qa); cy.b = fmaxf(cy.b, qb); }
    }
    __device__ __forceinline__ void finish(const pg8::Unit& u, int wr, int wc, const Carry& cy) const {
        if (wc < 2) { float qa = cy.a, qb = cy.b;
#pragma unroll
            for (int o = 1; o < 16; o <<= 1) { qa = fmaxf(qa, __shfl_xor(qa, o)); qb = fmaxf(qb, __shfl_xor(qb, o)); }
            if ((otid() & 63) == 0) { float* kn = (float*)KMAX + (size_t)(u.pm >> 4) * (NH * 2 + 1) * 32; const int sl = (u.pm & 15) * 2 + wr;
                kn[((u.pn * 2) * 2 + wc) * 32 + sl] = qa; kn[((u.pn * 2 + 1) * 2 + wc) * 32 + sl] = qb; } } }
};
template <int MODE> struct FMerge { static constexpr bool IDEMPOTENT = false;
    bf16* MG; const bf16* GT; const float* ps;
    static constexpr int goff = MODE == 0 ? 0 : (MODE == 1 ? 2048 : 1024);
    typedef NoCarry Carry;
    struct L { v4u ga, gb, ma, mb; };
    __device__ __forceinline__ L pre(const pg8::Unit& u, int row, int col) const { L r; r.ga = *(const v4u*)(GT + (size_t)row * 3072 + goff + col); r.gb = *(const v4u*)(GT + (size_t)row * 3072 + goff + col + 128);
        if (MODE != 0) { r.ma = *(const v4u*)(MG + (size_t)row * D + col); r.mb = *(const v4u*)(MG + (size_t)row * D + col + 128); } else { r.ma = r.ga; r.mb = r.gb; }
        return r; }
    __device__ __forceinline__ void one(int row, int c, const v4u& gw, const v4u& mw, const f32x4& v0, const f32x4& v1) const {
        f32x4 g0, g1; unpack8(gw, g0, g1);
        f32x4 r0 = g0 * v0, r1 = g1 * v1;
        if (MODE == 2) { r0 = r0 * *(const f32x4*)(ps + c); r1 = r1 * *(const f32x4*)(ps + c + 4); }
        if (MODE != 0) { f32x4 m0, m1; unpack8(mw, m0, m1); r0 += m0; r1 += m1; }
        st8(MG + (size_t)row * D + c, r0, r1);
    }
    __device__ __forceinline__ void post(const pg8::Unit& u, int row, int col, const L& ld, const f32x4& a0, const f32x4& a1, const f32x4& b0, const f32x4& b1, Carry& cy) const { one(row, col, ld.ga, ld.ma, a0, a1); one(row, col + 128, ld.gb, ld.mb, b0, b1); }
    __device__ __forceinline__ void finish(const pg8::Unit&, int, int, const Carry&) const {}
};
struct FOut { static constexpr bool IDEMPOTENT = false;
    const float* xin; float* X; const float* g1;
    typedef NoCarry Carry;
    struct L { f32x4 x0, x1, x2, x3; };
    __device__ __forceinline__ L pre(const pg8::Unit& u, int row, int col) const { L r; const float* xi = xin + (size_t)row * D + col;
        r.x0 = *(const f32x4*)xi; r.x1 = *(const f32x4*)(xi + 4); r.x2 = *(const f32x4*)(xi + 128); r.x3 = *(const f32x4*)(xi + 132); return r; }
    __device__ __forceinline__ void post(const pg8::Unit& u, int row, int col, const L& ld, const f32x4& a0, const f32x4& a1, const f32x4& b0, const f32x4& b1, Carry& cy) const {
        const float* g = g1 + (size_t)(row / S) * 6144 + col; float* xo = X + (size_t)row * D + col;
        *(f32x4*)xo = ld.x0 + *(const f32x4*)g * a0; *(f32x4*)(xo + 4) = ld.x1 + *(const f32x4*)(g + 4) * a1;
        *(f32x4*)(xo + 128) = ld.x2 + *(const f32x4*)(g + 128) * b0; *(f32x4*)(xo + 132) = ld.x3 + *(const f32x4*)(g + 132) * b1;
    }
    __device__ __forceinline__ void finish(const pg8::Unit&, int, int, const Carry&) const {}
};
struct FGu { static constexpr bool IDEMPOTENT = true;
    bf16* ACT;
    typedef NoCarry Carry;
    struct L { };
    __device__ __forceinline__ L pre(const pg8::Unit& u, int row, int col) const { return L{}; }
    __device__ __forceinline__ void post(const pg8::Unit& u, int row, int col, const L& ld, const f32x4& a0, const f32x4& a1, const f32x4& b0, const f32x4& b1, Carry& cy) const {
        const int oc = (u.pn & 7) * 128 + (col & 255);
        f32x4 r0, r1;
#pragma unroll
        for (int i = 0; i < 4; ++i) { r0[i] = a0[i] * __builtin_amdgcn_rcpf(1.0f + __expf(-a0[i])) * b0[i]; r1[i] = a1[i] * __builtin_amdgcn_rcpf(1.0f + __expf(-a1[i])) * b1[i]; }
        st8(ACT + (size_t)row * FF + oc, r0, r1);
    }
    __device__ __forceinline__ void finish(const pg8::Unit&, int, int, const Carry&) const {}
};
struct FDn { static constexpr bool IDEMPOTENT = true;
    bf16* Y;
    typedef NoCarry Carry;
    struct L { };
    __device__ __forceinline__ L pre(const pg8::Unit& u, int row, int col) const { return L{}; }
    __device__ __forceinline__ void post(const pg8::Unit& u, int row, int col, const L& ld, const f32x4& a0, const f32x4& a1, const f32x4& b0, const f32x4& b1, Carry& cy) const {
        const int oc = (u.pn & 3) * 256 + (col & 255);
        st8(Y + (size_t)row * D + oc, a0, a1); st8(Y + (size_t)row * D + oc + 128, b0, b1);
    }
    __device__ __forceinline__ void finish(const pg8::Unit&, int, int, const Carry&) const {}
};
struct MUnit { int pm, pn, seg; };
struct MergeSched {
    typedef MUnit U;
    pg8::StaticOrder so; const char *ws, *wl;
    __device__ __forceinline__ bool next(int i, MUnit& u) const { const int tile = i / 3; pg8::Unit t; if (!so.next(tile, t)) return false; u.pm = t.pm; u.pn = t.pn; u.seg = i - 3 * tile; return true; }
    __device__ __forceinline__ const char* baseA(const MUnit& u) const { const size_t off = u.seg == 0 ? WS_O : (u.seg == 1 ? WS_CY : WS_MIX); return ws + off + (size_t)u.pm * (256 * 512 * 2) + (u.seg == 2 ? u.pn * 256 : 0); }
    __device__ __forceinline__ const char* baseB(const MUnit& u) const { const size_t off = u.seg == 0 ? WO_OA : (u.seg == 1 ? WO_OC : WO_POOL); return wl + off + (size_t)u.pn * (256 * 512 * 2) + (u.seg == 2 ? u.pn * 256 : 0); }
    __device__ __forceinline__ int nt(const MUnit& u) const { return u.seg == 2 ? 2 : 8; }
    __device__ __forceinline__ bool keep(const MUnit& u) const { return u.seg != 2; }
    __device__ __forceinline__ void a_ready(const MUnit&) const {}
    __device__ __forceinline__ void done(const MUnit&) const {}
};
struct EMergeFused {
    static constexpr bool PERM = true, AFTER_DRAIN = false; static constexpr int MB = 2;
    bf16* MG; const bf16* GT;
    __device__ __forceinline__ static void ratio8(const v4u& nw, const v4u& dw, f32x4& r0, f32x4& r1) { f32x4 n0, n1, d0, d1; unpack8(nw, n0, n1); unpack8(dw, d0, d1);
#pragma unroll
        for (int i = 0; i < 4; ++i) { r0[i] = n0[i] * __builtin_amdgcn_rcpf(d0[i]); r1[i] = n1[i] * __builtin_amdgcn_rcpf(d1[i]); } }
    __device__ __forceinline__ void operator()(f32x4 (&acc)[2][2][4][2], const MUnit& u, int wr, int wc, int fr, int fq) const {
        const int row0 = u.pm * 256 + wr * 64 + fr, col = u.pn * 256 + wc * 32 + 8 * fq;
        const int noff = u.seg == 0 ? 0 : (u.seg == 1 ? 2048 : 1024), doff = u.seg == 0 ? 2048 : 1024;
#pragma unroll
        for (int g0 = 0; g0 < 8; g0 += MB) {
            v4u na[MB], nb[MB], da[MB], db[MB];
#pragma unroll
            for (int k = 0; k < MB; ++k) { const int ai = (g0 + k) >> 2, m = (g0 + k) & 3; const bf16* gp = GT + (size_t)(row0 + ai * 128 + m * 16) * 3072 + col;
                na[k] = *(const v4u*)(gp + noff); nb[k] = *(const v4u*)(gp + noff + 128);
                if (u.seg != 2) { da[k] = *(const v4u*)(gp + doff); db[k] = *(const v4u*)(gp + doff + 128); } else { da[k] = na[k]; db[k] = nb[k]; } }
#pragma unroll
            for (int k = 0; k < MB; ++k) { const int ai = (g0 + k) >> 2, m = (g0 + k) & 3;
                if (u.seg != 2) { f32x4 r0, r1; ratio8(na[k], da[k], r0, r1); acc[ai][0][m][0] *= r0; acc[ai][0][m][1] *= r1; ratio8(nb[k], db[k], r0, r1); acc[ai][1][m][0] *= r0; acc[ai][1][m][1] *= r1; }
                else { bf16* mp = MG + (size_t)(row0 + ai * 128 + m * 16) * D + col; f32x4 x0, x1; unpack8(na[k], x0, x1); st8(mp, acc[ai][0][m][0] * x0, acc[ai][0][m][1] * x1);
                    unpack8(nb[k], x0, x1); st8(mp + 128, acc[ai][1][m][0] * x0, acc[ai][1][m][1] * x1); } }
            asm volatile("" ::: "memory");
        }
    }
};
struct GuOrder { int G, c;
    __device__ __forceinline__ bool next(int i, pg8::Unit& u) const { const int L = i * G + c; if (L >= 1024) return false;
        const int x = L & 7, j = (L >> 3) & 31, r = L >> 8, sg = r * 8 + x, e = sg >> 1, bh = sg & 1, pmi = j & 3, pnl = j >> 2, b = 2 * bh + (pmi >> 1);
        u.pm = (b * NE + e) * 2 + (pmi & 1); u.pn = e * 8 + pnl; return true; }
    __device__ __forceinline__ void a_ready(const pg8::Unit&) const {}
    __device__ __forceinline__ void done(const pg8::Unit&) const {} };
struct DnOrder { int G, c;
    __device__ __forceinline__ bool next(int i, pg8::Unit& u) const { const int L = i * G + c; if (L >= 512) return false;
        const int x = L & 7, j = (L >> 3) & 31, r = L >> 8, e = r * 8 + x, pmi = j & 7, pnl = j >> 3;
        u.pm = ((pmi >> 1) * NE + e) * 2 + (pmi & 1); u.pn = e * 4 + pnl; return true; }
    __device__ __forceinline__ void a_ready(const pg8::Unit&) const {}
    __device__ __forceinline__ void done(const pg8::Unit&) const {} };

__device__ __forceinline__ void ld8f(const bf16* p, f32x4& x0, f32x4& x1) { unpack8(*(const v4u*)p, x0, x1); }
__device__ __forceinline__ void phase_prep_elem(const Args& a, int l, int vcu, int G) {
    unsigned char* ws = opaque(a.ws);
    const bf16* U = (const bf16*)(ws + WS_U); const bf16* CV = (const bf16*)(ws + WS_CV); bf16* MIX = (bf16*)(ws + WS_MIX); bf16* CY = (bf16*)(ws + WS_CY);
    const float* cw = a.in[I_CONVW] + (size_t)l * 3 * 512;
    const f32x4 z4 = {0.f, 0.f, 0.f, 0.f};
    for (size_t idx = (size_t)vcu * 512 + otid(); idx < (size_t)(T / 16) * 128; idx += (size_t)G * 512) {
        const int t0 = (int)(idx >> 7) * 16, ch = (int)(idx & 127), tt0 = t0 % S;
        if (ch < 64) {
            const int hw = 1 << (ch >> 4);
            const bf16* up = U + (size_t)(t0 - tt0) * 512 + ch * 8;
            f32x4 s0 = z4, s1 = z4;
#pragma unroll
            for (int k = 0; k < 16; ++k) { const int r = tt0 - hw + k; if (k < 2 * hw && r >= 0) { f32x4 x0, x1; ld8f(up + (size_t)r * 512, x0, x1); s0 += x0; s1 += x1; } }
#pragma unroll
            for (int i = 0; i < 16; ++i) { const int tt = tt0 + i;
                f32x4 c0, c1; ld8f(up + (size_t)tt * 512, c0, c1);
                const int lo = max(tt - hw, 0), hi = min(tt + hw - 1, S - 1); const float inv = 1.0f / (float)(hi - lo + 1);
                st8(MIX + (size_t)(t0 + i) * 512 + ch * 8, s0 * inv - c0, s1 * inv - c1);
                f32x4 p0 = z4, p1 = z4, m0 = z4, m1 = z4;
                if (tt + hw < S) ld8f(up + (size_t)(tt + hw) * 512, p0, p1);
                if (tt - hw >= 0) ld8f(up + (size_t)(tt - hw) * 512, m0, m1);
                s0 += p0 - m0; s1 += p1 - m1; }
        } else {
            const int c = (ch - 64) * 8; const bf16* p = CV + (size_t)t0 * 1536 + c;
            const f32x4 w00 = *(const f32x4*)(cw + c), w01 = *(const f32x4*)(cw + c + 4), w10 = *(const f32x4*)(cw + 512 + c), w11 = *(const f32x4*)(cw + 512 + c + 4),
                        w20 = *(const f32x4*)(cw + 1024 + c), w21 = *(const f32x4*)(cw + 1024 + c + 4);
            f32x4 zp0 = z4, zp1 = z4, zc0, zc1;
            if (tt0 > 0) { f32x4 x0, x1, y0, y1; ld8f(p - 1536, x0, x1); ld8f(p - 1536 + 1024, y0, y1); zp0 = x0 * y0; zp1 = x1 * y1; }
            { f32x4 x0, x1, y0, y1; ld8f(p, x0, x1); ld8f(p + 1024, y0, y1); zc0 = x0 * y0; zc1 = x1 * y1; }
#pragma unroll
            for (int i = 0; i < 16; ++i) { const bf16* pi = p + (size_t)i * 1536;
                f32x4 zn0 = z4, zn1 = z4;
                if (tt0 + i + 1 < S) { f32x4 x0, x1, y0, y1; ld8f(pi + 1536, x0, x1); ld8f(pi + 1536 + 1024, y0, y1); zn0 = x0 * y0; zn1 = x1 * y1; }
                f32x4 b0, b1; ld8f(pi + 512, b0, b1);
                st8(CY + (size_t)(t0 + i) * 512 + c, b0 * (w00 * zp0 + w10 * zc0 + w20 * zn0), b1 * (w01 * zp1 + w11 * zc1 + w21 * zn1));
                zp0 = zc0; zp1 = zc1; zc0 = zn0; zc1 = zn1; }
        }
    }
}

__device__ __forceinline__ float reduce16(const float (&p)[16], int lane) {
    float q8[8], q4[4], q2[2];
    { const bool up = lane & 32;
#pragma unroll
      for (int i = 0; i < 8; ++i) { float lo = p[i], hi = p[8 + i]; asm volatile("" : "+v"(lo), "+v"(hi)); const float keep = up ? hi : lo, send = up ? lo : hi; q8[i] = keep + __shfl_xor(send, 32); } }
    { const bool up = lane & 16;
#pragma unroll
      for (int i = 0; i < 4; ++i) { float lo = q8[i], hi = q8[4 + i]; asm volatile("" : "+v"(lo), "+v"(hi)); const float keep = up ? hi : lo, send = up ? lo : hi; q4[i] = keep + __shfl_xor(send, 16); } }
    { const bool up = lane & 8;
#pragma unroll
      for (int i = 0; i < 2; ++i) { float lo = q4[i], hi = q4[2 + i]; asm volatile("" : "+v"(lo), "+v"(hi)); const float keep = up ? hi : lo, send = up ? lo : hi; q2[i] = keep + __shfl_xor(send, 8); } }
    float lo = q2[0], hi = q2[1]; asm volatile("" : "+v"(lo), "+v"(hi));
    const bool up = lane & 4; const float keep = up ? hi : lo, send = up ? lo : hi;
    float q = keep + __shfl_xor(send, 4); q += __shfl_xor(q, 2); q += __shfl_xor(q, 1); return q;
}
__device__ __forceinline__ void phase_norm2(const Args& a, int l, LAS unsigned char* lds, int vcu, int G) {
    const int tid = otid(), lane = tid & 63, wave = tid >> 6;
    unsigned char* ws = opaque(a.ws);
    const float* X = (const float*)(ws + WS_X); bf16* H = (bf16*)(ws + WS_H); float* AFF = (float*)(ws + WS_AFF); const float* MOD = (const float*)(ws + WS_MOD);
    LAS float* wl = (LAS float*)lds;
    const float* wr = a.in[I_WROUTER] + (size_t)l * D * NE;
    { f32x4 wv[8];
#pragma unroll
      for (int k = 0; k < 8; ++k) wv[k] = ((const f32x4*)wr)[tid + 512 * k];
#pragma unroll
      for (int k = 0; k < 8; ++k) { const int i4 = tid + 512 * k, c = i4 >> 2, e0 = (i4 & 3) * 4;
#pragma unroll
          for (int q = 0; q < 4; ++q) wl[(e0 + q) * D + c] = wv[k][q]; } }
    __syncthreads();
    const float* g = a.in[I_N2G] + l * D;
    const int myexp = ((lane >> 5) & 1) * 8 + ((lane >> 4) & 1) * 4 + ((lane >> 3) & 1) * 2 + ((lane >> 2) & 1);
    const int rpw = (T + G * NWAVES - 1) / (G * NWAVES);
    int t = (vcu * NWAVES + wave) * rpw; const int tend = min(t + rpw, T);
    f32x4 gg[4], s1v[4], h1v[4]; int bcur = -1;
#pragma unroll
    for (int j = 0; j < 4; ++j) gg[j] = ((const f32x4*)g)[lane + 64 * j];
    f32x4 na[4], nb[4];
    if (t < tend) { const int tb = min(t + 1, tend - 1);
#pragma unroll
        for (int j = 0; j < 4; ++j) { na[j] = ((const f32x4*)(X + (size_t)t * D))[lane + 64 * j]; nb[j] = ((const f32x4*)(X + (size_t)tb * D))[lane + 64 * j]; } }
    for (; t < tend; t += 2) {
        const int b = t / S; const int t1 = min(t + 1, tend - 1);
        f32x4 va[4], vb[4];
#pragma unroll
        for (int j = 0; j < 4; ++j) { va[j] = na[j]; vb[j] = nb[j]; }
        if (b != bcur) { bcur = b; const float* sh = MOD + ((size_t)l * NB + b) * 6144 + 3 * D; const float* sc = sh + D;
#pragma unroll
            for (int j = 0; j < 4; ++j) { s1v[j] = ((const f32x4*)sc)[lane + 64 * j] + 1.0f; h1v[j] = ((const f32x4*)sh)[lane + 64 * j]; } }
        asm volatile("" ::: "memory");
        if (t + 2 < tend) { const int ta = t + 2, tb = min(t + 3, tend - 1);
#pragma unroll
            for (int j = 0; j < 4; ++j) { na[j] = ((const f32x4*)(X + (size_t)ta * D))[lane + 64 * j]; nb[j] = ((const f32x4*)(X + (size_t)tb * D))[lane + 64 * j]; } }
        asm volatile("" ::: "memory");
        float sa = 0.f, sb = 0.f;
#pragma unroll
        for (int j = 0; j < 4; ++j) { sa += (va[j][0] * va[j][0] + va[j][1] * va[j][1]) + (va[j][2] * va[j][2] + va[j][3] * va[j][3]); sb += (vb[j][0] * vb[j][0] + vb[j][1] * vb[j][1]) + (vb[j][2] * vb[j][2] + vb[j][3] * vb[j][3]); }
        const float ra = 1.0f / sqrtf(wave_sum(sa) * (1.0f / D) + EPS), rb = 1.0f / sqrtf(wave_sum(sb) * (1.0f / D) + EPS);
#pragma unroll
        for (int j = 0; j < 4; ++j) { va[j] = va[j] * ra * gg[j] * s1v[j] + h1v[j]; vb[j] = vb[j] * rb * gg[j] * s1v[j] + h1v[j];
            ((v2u*)(H + (size_t)t * D))[lane + 64 * j] = (v2u){pk2(va[j][0], va[j][1]), pk2(va[j][2], va[j][3])};
            ((v2u*)(H + (size_t)t1 * D))[lane + 64 * j] = (v2u){pk2(vb[j][0], vb[j][1]), pk2(vb[j][2], vb[j][3])}; }
        float pa[NE], pb[NE];
#pragma unroll
        for (int e = 0; e < NE; ++e) { float xa = 0.f, xb = 0.f;
#pragma unroll
            for (int j = 0; j < 4; ++j) { const f32x4 w = *(const LAS f32x4*)(wl + e * D + 4 * lane + 256 * j);
                xa += (va[j][0] * w[0] + va[j][1] * w[1]) + (va[j][2] * w[2] + va[j][3] * w[3]);
                xb += (vb[j][0] * w[0] + vb[j][1] * w[1]) + (vb[j][2] * w[2] + vb[j][3] * w[3]); }
            pa[e] = xa; pb[e] = xb;
            asm volatile("" : "+v"(pa[e]), "+v"(pb[e]) :: "memory"); }
        { const float lg = reduce16(pa, lane); float mx = lg;
#pragma unroll
          for (int o = 4; o < 64; o <<= 1) mx = fmaxf(mx, __shfl_xor(mx, o));
          const float ex = __expf(lg - mx); float sum = ex;
#pragma unroll
          for (int o = 4; o < 64; o <<= 1) sum += __shfl_xor(sum, o);
          if ((lane & 3) == 0) AFF[((size_t)b * NE + myexp) * S + t % S] = ex / sum; }
        { const float lg = reduce16(pb, lane); float mx = lg;
#pragma unroll
          for (int o = 4; o < 64; o <<= 1) mx = fmaxf(mx, __shfl_xor(mx, o));
          const float ex = __expf(lg - mx); float sum = ex;
#pragma unroll
          for (int o = 4; o < 64; o <<= 1) sum += __shfl_xor(sum, o);
          if ((lane & 3) == 0) AFF[((size_t)b * NE + myexp) * S + t1 % S] = ex / sum; }
    }
    __syncthreads();
}

__device__ __forceinline__ void phase_topk(const Args& a, LAS unsigned char* lds, int G) {
    const int tid = otid(), lane = tid & 63, wave = tid >> 6;
    unsigned char* ws = opaque(a.ws);
    const float* AFF = (const float*)(ws + WS_AFF); int* SLOT = (int*)(ws + WS_SLOT); int* IDXG = (int*)(ws + WS_IDX); const bf16* H = (const bf16*)(ws + WS_H); bf16* XG = (bf16*)(ws + WS_XG);
    LAS unsigned* hist = (LAS unsigned*)lds;
    LAS unsigned* sel = hist + 256;
    LAS unsigned* wtot = sel + 8;
    LAS int* idxl = (LAS int*)(wtot + 8);
    const int npart = GATHER_FUSED ? 1 : ((G % 4 == 0 && G >= 4) ? 4 : 1), part = blockIdx.x % npart;
    for (int pi = blockIdx.x / npart; pi < NB * NE; pi += G / npart) {
        const int b = pi / NE;
        const float* ap = AFF + (size_t)pi * S + tid * 8;
        const f32x4 v0 = *(const f32x4*)ap, v1 = *(const f32x4*)(ap + 4);
        unsigned key[8];
#pragma unroll
        for (int i = 0; i < 4; ++i) { key[i] = __float_as_uint(v0[i]); key[4 + i] = __float_as_uint(v1[i]); }
        unsigned prefix = 0, kk = CAP;
#pragma unroll 1
        for (int pass = 0; pass < 4; ++pass) { const int shift = 24 - 8 * pass;
            if (tid < 256) hist[tid] = 0u;
            __syncthreads();
#pragma unroll
            for (int i = 0; i < 8; ++i) { const bool m = (pass == 0) ? true : ((key[i] >> (shift + 8)) == prefix); if (m) __hip_atomic_fetch_add(&hist[(key[i] >> shift) & 255u], 1u, __ATOMIC_RELAXED, __HIP_MEMORY_SCOPE_WORKGROUP); }
            __syncthreads();
            if (wave == 0) { const unsigned c0 = hist[4 * lane], c1 = hist[4 * lane + 1], c2 = hist[4 * lane + 2], c3 = hist[4 * lane + 3]; const unsigned s = c0 + c1 + c2 + c3;
                unsigned suf = s;
#pragma unroll
                for (int o = 1; o < 64; o <<= 1) { const unsigned tv = __shfl_down(suf, o); if (lane + o < 64) suf += tv; }
                unsigned above = suf - s;
                const unsigned cs[4] = {c3, c2, c1, c0};
#pragma unroll
                for (int q = 0; q < 4; ++q) { if (above < kk && above + cs[q] >= kk) { sel[0] = (unsigned)(4 * lane + 3 - q); sel[1] = kk - above; } above += cs[q]; } }
            __syncthreads();
            prefix = (prefix << 8) | sel[0]; kk = sel[1];
            __syncthreads(); }
        unsigned ngt = 0, neq = 0;
#pragma unroll
        for (int i = 0; i < 8; ++i) { ngt += key[i] > prefix; neq += key[i] == prefix; }
        unsigned pk = ngt | (neq << 16), inc = pk;
#pragma unroll
        for (int o = 1; o < 64; o <<= 1) { const unsigned tv = __shfl_up(inc, o); if (lane >= o) inc += tv; }
        if (lane == 63) wtot[wave] = inc;
        __syncthreads();
        unsigned base = 0;
#pragma unroll
        for (int w = 0; w < 8; ++w) base += (w < wave) ? wtot[w] : 0u;
        const unsigned ex = base + inc - pk; unsigned gtb = ex & 0xffffu, eqb = ex >> 16;
#pragma unroll
        for (int i = 0; i < 8; ++i) { const bool gt = key[i] > prefix, eq = key[i] == prefix; const bool s = gt || (eq && eqb < kk);
            const int slot = (int)(gtb + (eqb < kk ? eqb : kk)); const int tt = tid * 8 + i;
            if (s) idxl[slot] = tt;
            if (part == 0) { SLOT[(size_t)pi * S + tt] = s ? slot : -1; if (s) IDXG[(size_t)pi * CAP + slot] = b * S + tt; }
            gtb += gt; eqb += eq; }
        __syncthreads();
#if !GATHER_FUSED
        const int per = CAP / npart;
        for (int si = wave * 4; si < per; si += NWAVES * 4) {
            v4u r0[4], r1[4];
#pragma unroll
            for (int k = 0; k < 4; ++k) { const int tt = idxl[part * per + si + k]; const v4u* src = (const v4u*)(H + ((size_t)b * S + tt) * D); r0[k] = src[lane]; r1[k] = src[lane + 64]; }
#pragma unroll
            for (int k = 0; k < 4; ++k) { v4u* dst = (v4u*)(XG + ((size_t)pi * CAP + part * per + si + k) * D); dst[lane] = r0[k]; dst[lane + 64] = r1[k]; } }
        __syncthreads();
#else
        (void)H; (void)XG; (void)lane;
#endif
    }
}

#if NAIVE_ATTN
__device__ __forceinline__ void phase_attn(const Args& a, LAS unsigned char* lds, int vcu, int G) {
    const int tid = otid(), lane = tid & 63, wave = tid >> 6;
    unsigned char* ws = opaque(a.ws);
    const bf16* Q = (const bf16*)(ws + WS_Q); const bf16* KV = (const bf16*)(ws + WS_KV); const bf16* KR = (const bf16*)(ws + WS_KR); bf16* O = (bf16*)(ws + WS_O);
    LAS float* pl = (LAS float*)(lds + wave * 16384);
    for (int row = vcu * NWAVES + wave; row < NB * NH * S; row += G * NWAVES) {
        const int b = row / (NH * S), h = (row / S) % NH, q = row % S; const size_t t = (size_t)b * S + q;
        float qf[DQK];
#pragma unroll
        for (int c = 0; c < 12; ++c) { f32x4 x0, x1; unpack8(*(const v4u*)(Q + t * 768 + h * 96 + c * 8), x0, x1);
#pragma unroll
            for (int i = 0; i < 4; ++i) { qf[c * 8 + i] = x0[i]; qf[c * 8 + 4 + i] = x1[i]; } }
        float mx = -1e30f;
        for (int jj = 0; jj < S / 64; ++jj) { const int key = jj * 64 + lane; const size_t kt = (size_t)b * S + key; float s = 0.f;
#pragma unroll
            for (int c = 0; c < 12; ++c) { f32x4 x0, x1; const bf16* kp = (c < 8) ? (KV + kt * 1024 + h * 128 + c * 8) : (KR + kt * 32 + (c - 8) * 8); unpack8(*(const v4u*)kp, x0, x1);
#pragma unroll
                for (int i = 0; i < 4; ++i) { s += qf[c * 8 + i] * x0[i]; s += qf[c * 8 + 4 + i] * x1[i]; } }
            pl[key] = s; mx = fmaxf(mx, s); }
        mx = wave_max(mx);
        float sum = 0.f;
        for (int jj = 0; jj < S / 64; ++jj) { const int key = jj * 64 + lane; const float e = exp2f(pl[key] - mx); pl[key] = e; sum += e; }
        sum = wave_sum(sum);
        LDS_WAIT();
        float o = 0.f; const bf16* vp = KV + (size_t)b * S * 1024 + h * 128 + 64 + lane;
        for (int key = 0; key < S; ++key) o += pl[key] * __uint_as_float((unsigned)vp[(size_t)key * 1024] << 16);
        O[t * 512 + h * 64 + lane] = (bf16)(pk2(o / sum, 0.f) & 0xffffu);
    }
    __syncthreads();
}
#else
__device__ __forceinline__ void phase_attn(const Args& a, LAS unsigned char* lds, int vcu, int G) {
    unsigned char* ws = opaque(a.ws);
    const bf16* Q = (const bf16*)(ws + WS_Q); const bf16* KV = (const bf16*)(ws + WS_KV); const bf16* KR = (const bf16*)(ws + WS_KR); bf16* O = (bf16*)(ws + WS_O);
    for (int i = 0;; ++i) { const int L = i * G + (int)blockIdx.x; if (L >= NB * NH * (S / 256)) break;
        const int x = L & 7, j = (L >> 3) & 31, r = L >> 8, bh = x * 4 + r * 2 + (j >> 4), qb = j & 15, b = bh >> 3, h = bh & 7;
        float kmax2;
        { const float* kn = (const float*)(ws + WS_KMAX) + (size_t)b * (NH * 2 + 1) * 32; const int ln = otid() & 31;
          float m0 = kn[(h * 2) * 32 + ln], m1 = kn[(h * 2 + 1) * 32 + ln], m2 = kn[(NH * 2) * 32 + ln];
#pragma unroll
          for (int o = 1; o < 32; o <<= 1) { m0 = fmaxf(m0, __shfl_xor(m0, o)); m1 = fmaxf(m1, __shfl_xor(m1, o)); m2 = fmaxf(m2, __shfl_xor(m2, o)); }
          kmax2 = m0 + m1 + m2; }
        att::attn_unit(Q, KV, KR, O, (long)b * S + qb * 256, (long)b * S, h, (LAS char*)lds, kmax2); }
}
#endif

#define L1_INV() do { VM_WAIT(); __builtin_amdgcn_fence(__ATOMIC_ACQUIRE, "agent"); VM_WAIT(); __syncthreads(); } while (0)
#define XB_TMO      128
#define XB_XCNT(j)  (256  + 64 * (j))
#define XB_XSUB(j)  (1280 + 64 * (j))
#define XB_XGEN(j)  (2304 + 64 * (j))
#define XB_TOP      3328
#define XB_TOPGEN   3392
#define XCD_BAR_WORDS 3456
#define XB_SPIN_CAP (1u << 20)

__device__ __forceinline__ unsigned xb_ld(unsigned* p)              { return __hip_atomic_load(p, __ATOMIC_RELAXED, __HIP_MEMORY_SCOPE_AGENT); }
__device__ __forceinline__ unsigned xb_add(unsigned* p, unsigned v) { return __hip_atomic_fetch_add(p, v, __ATOMIC_RELAXED, __HIP_MEMORY_SCOPE_AGENT); }
__device__ __forceinline__ unsigned xb_xcc_id() { return (unsigned)__builtin_amdgcn_s_getreg((3 << 11) | 20) & 0xFu; }
#define XB_SPIN(cond, bar) do { unsigned _sp = 0; while (cond) { __builtin_amdgcn_s_sleep(1); \
    if ((++_sp & 255u) == 0u) { if (xb_ld(&(bar)[XB_TMO])) break; if (_sp > XB_SPIN_CAP) { atomicAdd(&(bar)[XB_TMO], 1u); break; } } } } while (0)

struct XcdBarrier {
    unsigned* bar; unsigned x;
    volatile LAS unsigned* st;
};

__device__ __forceinline__ XcdBarrier xcd_barrier_post(unsigned* bar, volatile LAS unsigned* st) {
    XcdBarrier b; b.bar = bar; b.x = xb_xcc_id(); b.st = st;
    if (threadIdx.x == 0) (void)xb_add(&bar[XB_XCNT(b.x)], 1u);
    return b;
}
__device__ __forceinline__ void xcd_barrier_complete(unsigned* bar, unsigned x, unsigned& nloc, unsigned& nx) {
    const unsigned G = gridDim.x * gridDim.y * gridDim.z;
    unsigned sum, cnt, mine, sp = 0u;
    for (;;) {
        sum = 0u; cnt = 0u; mine = 0u;
#pragma unroll
        for (unsigned j = 0; j < 16; ++j) { const unsigned c = xb_ld(&bar[XB_XCNT(j)]); sum += c; cnt += (c > 0u) ? 1u : 0u; mine = (j == x) ? c : mine; }
        if (sum == G) break;
        __builtin_amdgcn_s_sleep(1);
        if ((++sp & 255u) == 0u) { if (xb_ld(&bar[XB_TMO])) break; if (sp > XB_SPIN_CAP) { atomicAdd(&bar[XB_TMO], 1u); break; } }
    }
    nloc = mine > 0u ? mine : 1u; nx = cnt > 0u ? cnt : 1u;
}

__device__ __forceinline__ void xcd_barrier(const XcdBarrier& b) {
    asm volatile("s_waitcnt vmcnt(0)" ::: "memory");
    __syncthreads();
    if (threadIdx.x == 0) {
        unsigned* bar = b.bar;
        __builtin_amdgcn_s_waitcnt(0);
        unsigned nloc = b.st[0], nx = b.st[1];
        if (nloc == 0u) { xcd_barrier_complete(bar, b.x, nloc, nx); b.st[0] = nloc; b.st[1] = nx; }
        const unsigned old = xb_add(&bar[XB_XSUB(b.x)], 1u);
        const unsigned gen = old / nloc;
        if (old + 1u == (gen + 1u) * nloc) {
            __builtin_amdgcn_fence(__ATOMIC_RELEASE, "agent");
            asm volatile("s_waitcnt vmcnt(0)" ::: "memory");
            const unsigned og = xb_add(&bar[XB_TOP], 1u);
            const unsigned tg = og / nx;
            if (og + 1u == (tg + 1u) * nx) xb_add(&bar[XB_TOPGEN], 1u);
            else XB_SPIN(xb_ld(&bar[XB_TOPGEN]) == tg, bar);
            __builtin_amdgcn_fence(__ATOMIC_ACQUIRE, "agent");
            xb_add(&bar[XB_XGEN(b.x)], 1u);
            asm volatile("s_waitcnt vmcnt(0)" ::: "memory");
        } else {
            XB_SPIN(xb_ld(&bar[XB_XGEN(b.x)]) == gen, bar);
            __builtin_amdgcn_fence(__ATOMIC_ACQUIRE, "agent");
            asm volatile("s_waitcnt vmcnt(0)" ::: "memory");
        }
    }
    __syncthreads();
}

template <class Work> __device__ __forceinline__ void xcd_barrier_work(const XcdBarrier& b, volatile LAS unsigned* mw, Work&& work) {
    asm volatile("s_waitcnt vmcnt(0)" ::: "memory");
    __syncthreads();
    if (threadIdx.x == 0) {
        unsigned* bar = b.bar;
        __builtin_amdgcn_s_waitcnt(0);
        unsigned nloc = b.st[0], nx = b.st[1];
        if (nloc == 0u) { xcd_barrier_complete(bar, b.x, nloc, nx); b.st[0] = nloc; b.st[1] = nx; }
        const unsigned old = xb_add(&bar[XB_XSUB(b.x)], 1u);
        const unsigned gen = old / nloc;
        if (old + 1u == (gen + 1u) * nloc) {
            __builtin_amdgcn_fence(__ATOMIC_RELEASE, "agent");
            asm volatile("s_waitcnt vmcnt(0)" ::: "memory");
            const unsigned og = xb_add(&bar[XB_TOP], 1u);
            const unsigned tg = og / nx;
            if (og + 1u == (tg + 1u) * nx) xb_add(&bar[XB_TOPGEN], 1u);
            else XB_SPIN(xb_ld(&bar[XB_TOPGEN]) == tg, bar);
            __builtin_amdgcn_fence(__ATOMIC_ACQUIRE, "agent");
            xb_add(&bar[XB_XGEN(b.x)], 1u);
            asm volatile("s_waitcnt vmcnt(0)" ::: "memory");
            mw[0] = 1u;
        } else { mw[0] = 0u; mw[1] = gen; }
    }
    __syncthreads();
    if (mw[0] == 0u) {
        const unsigned gen = mw[1]; unsigned sp = 0u;
        for (;;) {
            if (threadIdx.x == 0) { unsigned r = (xb_ld(&b.bar[XB_XGEN(b.x)]) != gen) ? 1u : 0u;
                if (!r && ((++sp & 255u) == 0u)) { if (xb_ld(&b.bar[XB_TMO])) r = 1u; else if (sp > XB_SPIN_CAP) { atomicAdd(&b.bar[XB_TMO], 1u); r = 1u; } }
                if (!r && XB_WORK_UNTIL_LOCAL && xb_ld(&b.bar[XB_XSUB(b.x)]) >= (gen + 1u) * b.st[0]) r = 2u;
                mw[2] = r; }
            __syncthreads();
            const unsigned rel = mw[2];
            __syncthreads();
            if (rel == 1u) break;
            if (rel == 2u || !work()) __builtin_amdgcn_s_sleep(1);
        }
        if (threadIdx.x == 0) { __builtin_amdgcn_fence(__ATOMIC_ACQUIRE, "agent"); asm volatile("s_waitcnt vmcnt(0)" ::: "memory"); }
    }
    __syncthreads();
}


__global__ void __launch_bounds__(NWAVES * 64, 2) fwd(Args args) {
    extern __shared__ __attribute__((aligned(16))) unsigned char lds_raw[];
    LAS unsigned char* lds = (LAS unsigned char*)lds_raw;
    volatile LAS unsigned* MISC = (volatile LAS unsigned*)(lds + MISC_OFF);
    const int tid = threadIdx.x;
    const int G = gridDim.x; const int bx = blockIdx.x; const int vcu = (G % 8 == 0) ? (bx % 8) * (G / 8) + bx / 8 : bx;
    if (tid < 32) MISC[tid] = 0u;
    __syncthreads();
    unsigned char* ws0 = args.ws;
    unsigned* ctl = (unsigned*)(ws0 + WS_CTL);
    XcdBarrier bar; bar.bar = ctl + CW_BAR; bar.x = 0; bar.st = nullptr;
#if !MK_PER_PHASE
    bar = xcd_barrier_post(ctl + CW_BAR, MISC + 8);
#endif
    const int lo = args.p_lo, hi = args.p_hi;
    int qcur = 0;
#ifndef EPF
#define EPF 4
#endif
#ifndef PHASE_MASK
#define PHASE_MASK 0xFFF
#endif
#define IN(k) (lo <= (k) && (k) < hi)
#define PM(b) ((PHASE_MASK >> (b)) & 1)
#ifndef REPEAT_MASK
#define REPEAT_MASK 0
#endif
#define NREP(b) (((REPEAT_MASK >> (b)) & 1) ? 2 : 1)
#define REPBAR(b) do { if (rep_ + 1 < NREP(b)) xcd_barrier(bar); } while (0)
#if MK_PER_PHASE
#define SEAM(k) do { } while (0)
#else
#ifndef EXTRA_BARRIERS
#define EXTRA_BARRIERS 0
#endif
#define SEAM(k) do { if (IN(k) && IN((k) + 1)) { xcd_barrier_work(bar, MISC + 16, [&]() { return conv_steal(args, lds, MISC + 16, qcur, NQ, G); }); _Pragma("unroll 1") for (int xb_ = 0; xb_ < EXTRA_BARRIERS; ++xb_) xcd_barrier(bar); } } while (0)
#endif
    if (PM(10) && IN(0)) { _Pragma("unroll 1") for (int rep_ = 0; rep_ < NREP(10); ++rep_) { phase_prologue(args, lds, vcu, G); REPBAR(10); } }
    SEAM(0);
#pragma unroll 1
    for (int l = 0; l < NL; ++l) {
        const int pb = 1 + 10 * l;
        if (PM(0) && IN(pb + 0)) phase_norm1(args, l, vcu, G);
        if (l > 0) conv_drain(args, lds, MISC + 16, qcur, 2 * l, G);
        SEAM(pb + 0);
        if (PM(1) && IN(pb + 1)) { _Pragma("unroll 1") for (int rep_ = 0; rep_ < NREP(1); ++rep_) {
            unsigned char* ws = opaque(args.ws); unsigned char* wl = ws + WS_W + (size_t)l * WL_BYTES;
            { const float* bg = args.in[I_BGATE] + (size_t)l * 3072; for (int i = otid(); i < 768; i += NWAVES * 64) *(LAS f32x4*)(lds + LDS_BIAS + i * 16) = ((const f32x4*)bg)[i]; }
            __syncthreads();
            pg8::Gemm g{(const bf16*)(ws + WS_H), (const bf16*)(wl + WO_IN), T, NIN, D}; pg8::StaticOrder So; So.init(T, NIN, G, bx);
            Epi8<FProj, EPF> E{FProj{(bf16*)(ws + WS_CQ), (bf16*)(ws + WS_CKV), (bf16*)(ws + WS_KR), (bf16*)(ws + WS_U), (bf16*)(ws + WS_CV), (bf16*)(ws + WS_GT),
                                (float*)(ws + WS_PART), (const float*)(ws + WS_COS), (const float*)(ws + WS_SIN), (const LAS float*)(lds + LDS_BIAS), (unsigned*)(ws + WS_KMAX)}};
            run_gemm<0>(lds, g, So, E);
            if (CONV_SLOT_A > 0 && bx >= 192 && G == 256) { __syncthreads(); conv_moe_range(args, lds, l, 0, CONV_SLOT_A, bx - 192, 64); }
         REPBAR(1); } }
        SEAM(pb + 1);
        if (PM(2) && IN(pb + 2)) { _Pragma("unroll 1") for (int rep_ = 0; rep_ < NREP(2); ++rep_) {
            unsigned char* ws = opaque(args.ws); unsigned char* wl = ws + WS_W + (size_t)l * WL_BYTES;
#ifndef PREP_PARTS
#define PREP_PARTS 7
#endif
            if (PREP_PARTS & 1) { pg8::Gemm g{(const bf16*)(ws + WS_CQ), (const bf16*)(wl + WO_UQ), T, 768, QR}; pg8::StaticOrder So; So.init(T, 768, G, bx);
              Epi8<FQ, EPF> E{FQ{(bf16*)(ws + WS_Q), (const float*)(ws + WS_PART), (const float*)(ws + WS_COS), (const float*)(ws + WS_SIN)}};
              run_gemm<1>(lds, g, So, E); }
            if (CONV_SLOT_C > 0 && bx >= 192 && G == 256) { __syncthreads(); conv_moe_range(args, lds, l, CONV_SLOT_A, CONV_SLOT_C, bx - 192, 64); __syncthreads(); }
            if (PREP_PARTS & 2) { pg8::Gemm g{(const bf16*)(ws + WS_CKV), (const bf16*)(wl + WO_UKV), T, 1024, KVR}; pg8::StaticOrder So; So.init(T, 1024, G, bx);
              Epi8<FKV, EPF> E{FKV{(bf16*)(ws + WS_KV), (const float*)(ws + WS_PART), (unsigned*)(ws + WS_KMAX)}};
              run_gemm<2>(lds, g, So, E); }
            if (PREP_PARTS & 4) phase_prep_elem(args, l, vcu, G);
         REPBAR(2); } }
        SEAM(pb + 2);
        if (PM(3) && IN(pb + 3)) { _Pragma("unroll 1") for (int rep_ = 0; rep_ < NREP(3); ++rep_) { phase_attn(args, lds, vcu, G); REPBAR(3); } }
        SEAM(pb + 3);
        if (PM(4) && IN(pb + 4)) { _Pragma("unroll 1") for (int rep_ = 0; rep_ < NREP(4); ++rep_) {
            unsigned char* ws = opaque(args.ws); unsigned char* wl = ws + WS_W + (size_t)l * WL_BYTES;
#if MERGE_FUSED
            { pg8::Gemm g{(const bf16*)(ws + WS_O), (const bf16*)(wl + WO_OA), T, D, 512};
              MergeSched Sm; Sm.so.init(T, D, G, bx); Sm.ws = (const char*)ws; Sm.wl = (const char*)wl;
              EMergeFused E{(bf16*)(ws + WS_MG), (const bf16*)(ws + WS_GT)};
              pg8::gemm_phase_seg<EMergeFused, MergeSched, true, true>(lds, g, Sm, E); }
#else
            pg8::StaticOrder So; So.init(T, D, G, bx);
            { pg8::Gemm g{(const bf16*)(ws + WS_O), (const bf16*)(wl + WO_OA), T, D, 512};
              Epi8<FMerge<0>, EPF> E{FMerge<0>{(bf16*)(ws + WS_MG), (const bf16*)(ws + WS_GT), nullptr}}; run_gemm<3>(lds, g, So, E); } L1_INV();
            { pg8::Gemm g{(const bf16*)(ws + WS_CY), (const bf16*)(wl + WO_OC), T, D, 512};
              Epi8<FMerge<1>, EPF> E{FMerge<1>{(bf16*)(ws + WS_MG), (const bf16*)(ws + WS_GT), nullptr}}; run_gemm<4>(lds, g, So, E); } L1_INV();
            { pg8::Gemm g{(const bf16*)(ws + WS_MIX), (const bf16*)(wl + WO_POOL), T, D, 512};
              Epi8<FMerge<2>, EPF> E{FMerge<2>{(bf16*)(ws + WS_MG), (const bf16*)(ws + WS_GT), args.in[I_PSCALE] + (size_t)l * D}}; run_gemm<5>(lds, g, So, E); }
#endif
         REPBAR(4); } }
        SEAM(pb + 4);
        if (PM(5) && IN(pb + 5)) {
            unsigned char* ws = opaque(args.ws); unsigned char* wl = ws + WS_W + (size_t)l * WL_BYTES; const float* MOD = (const float*)(ws + WS_MOD);
            pg8::Gemm g{(const bf16*)(ws + WS_MG), (const bf16*)(wl + WO_OUT), T, D, D}; pg8::StaticOrder So; So.init(T, D, G, bx);
            Epi8<FOut, EPF> E{FOut{l == 0 ? args.in[I_X] : (const float*)(ws + WS_X), (float*)(ws + WS_X), MOD + (size_t)l * NB * 6144 + 2 * D}};
            run_gemm<6>(lds, g, So, E);
        }
        SEAM(pb + 5);
        if (PM(6) && IN(pb + 6)) { _Pragma("unroll 1") for (int rep_ = 0; rep_ < NREP(6); ++rep_) { phase_norm2(args, l, lds, vcu, G); REPBAR(6); } }
        SEAM(pb + 6);
        if (PM(7) && IN(pb + 7)) { _Pragma("unroll 1") for (int rep_ = 0; rep_ < NREP(7); ++rep_) { phase_topk(args, lds, G);
            if (CONV_SLOT_B > 0 && bx >= 64 && G == 256) conv_moe_range(args, lds, l, CONV_SLOT_A + CONV_SLOT_C, CONV_SLOT_B, bx - 64, 192);
         REPBAR(7); } }
        conv_drain(args, lds, MISC + 16, qcur, 2 * l + 1, G);
        SEAM(pb + 7);
        if (PM(8) && IN(pb + 8)) { _Pragma("unroll 1") for (int rep_ = 0; rep_ < NREP(8); ++rep_) {
            unsigned char* ws = opaque(args.ws); unsigned char* wl = ws + WS_W + (size_t)l * WL_BYTES;
#if GATHER_FUSED
            pg8::Gemm g{(const bf16*)(ws + WS_H), (const bf16*)(wl + WO_GU), NB * NE * CAP, NE * 2048, D}; GuOrder So{G, bx};
            Epi8<FGu, EPF, false> E{FGu{(bf16*)(ws + WS_ACT)}}; pg8::gemm_phase_gather<Epi8<FGu, EPF, false>, GuOrder, true, true>(lds, g, So, E, (const int*)(ws + WS_IDX));
#else
            pg8::Gemm g{(const bf16*)(ws + WS_XG), (const bf16*)(wl + WO_GU), NB * NE * CAP, NE * 2048, D}; GuOrder So{G, bx};
            Epi8<FGu, EPF> E{FGu{(bf16*)(ws + WS_ACT)}}; run_gemm<7>(lds, g, So, E);
#endif
         REPBAR(8); } }
        SEAM(pb + 8);
        if (PM(9) && IN(pb + 9)) { _Pragma("unroll 1") for (int rep_ = 0; rep_ < NREP(9); ++rep_) {
            unsigned char* ws = opaque(args.ws); unsigned char* wl = ws + WS_W + (size_t)l * WL_BYTES;
            pg8::Gemm g{(const bf16*)(ws + WS_ACT), (const bf16*)(wl + WO_DN), NB * NE * CAP, NE * 1024, FF}; DnOrder So{G, bx};
            Epi8<FDn, EPF> E{FDn{(bf16*)(ws + WS_Y)}}; run_gemm<8>(lds, g, So, E);
         REPBAR(9); } }
        SEAM(pb + 9);
    }
    if (PM(11) && IN(41)) phase_norm1(args, NL, vcu, G);
#undef IN
#undef SEAM
}

extern "C" void kernel_launch(void* const* d_in, const int* in_sizes, int n_in, void* d_out, int out_size, void* d_ws, size_t ws_size, hipStream_t stream) {
    static int grid = 0;
    if (grid == 0) {
        if (n_in != 24 || out_size != T * D || ws_size < WS_END) { fprintf(stderr, "kernel_launch: unexpected shapes: n_in %d out %d ws %zu (need %zu)\n", n_in, out_size, ws_size, (size_t)WS_END); grid = -1; return; }
        int dev = 0, cus = 0, per_cu = 0;
        if (hipGetDevice(&dev) != hipSuccess || hipDeviceGetAttribute(&cus, hipDeviceAttributeMultiprocessorCount, dev) != hipSuccess) { grid = -1; return; }
        if (hipFuncSetAttribute((const void*)fwd, hipFuncAttributeMaxDynamicSharedMemorySize, LDS_BYTES) != hipSuccess) { fprintf(stderr, "kernel_launch: hipFuncSetAttribute failed\n"); grid = -1; return; }
        if (hipOccupancyMaxActiveBlocksPerMultiprocessor(&per_cu, (const void*)fwd, NWAVES * 64, LDS_BYTES) != hipSuccess || per_cu < 1) fprintf(stderr, "kernel_launch: occupancy query reports %d\n", per_cu);
        (void)hipGetLastError();
        grid = cus;
    }
    if (grid < 0) return;
    if (hipMemsetAsync((char*)d_ws + WS_CTL, 0, CTL_ZERO_BYTES, stream) != hipSuccess) return;
    Args a{};
    for (int i = 0; i < 24; ++i) a.in[i] = (const float*)d_in[i];
    a.out = (float*)d_out; a.ws = (unsigned char*)d_ws;
#if MK_PER_PHASE
    for (int p = 0; p < 42; ++p) { a.p_lo = p; a.p_hi = p + 1; hipLaunchKernelGGL(fwd, dim3(grid), dim3(NWAVES * 64), LDS_BYTES, stream, a); }
#else
    a.p_lo = 0; a.p_hi = 42;
    hipLaunchKernelGGL(fwd, dim3(grid), dim3(NWAVES * 64), LDS_BYTES, stream, a);
#endif
    const hipError_t le = hipPeekAtLastError();
    if (le != hipSuccess) fprintf(stderr, "kernel_launch: launch failed: %s\n", hipGetErrorName(le));
}
```
